# Optimizing an MI355X kernel written in HIP

```python
import math
import jax, jax.numpy as jnp
from jax import lax
import numpy as np

D_MODEL = 1024
BATCH = 8
SEQ = 8192
DEPTH = 1

HEAD_DIM = 64
CONV_WIDTH = D_MODEL // 2
CONV_K = 3
N_Q_HEADS = (D_MODEL // 2) // HEAD_DIM
N_KV_HEADS = 2
Q_PER_KV = N_Q_HEADS // N_KV_HEADS
ATTN_WIDTH = N_Q_HEADS * HEAD_DIM
KV_WIDTH = N_KV_HEADS * HEAD_DIM
MIX_WIDTH = CONV_WIDTH + ATTN_WIDTH
IN_WIDTH = 3 * CONV_WIDTH + ATTN_WIDTH + 2 * KV_WIDTH
WINDOW = 128
BLOCK = 128
N_BUCKETS = 32
MAX_DISTANCE = 128
N_EXPERTS = 32
TOP_K = 4
D_FF = D_MODEL
SWIGLU_LIMIT = 7.0
SWIGLU_ALPHA = 1.702
MOE_BLOCK = 128
EPS = 1e-5

kernel_name = "hymba_conv_swa_sink_t5_moe_block"


def rms_norm(x, g):
    xf = x.astype(jnp.float32)
    y = xf * lax.rsqrt(jnp.mean(xf * xf, axis=-1, keepdims=True) + EPS)
    return (y * g.astype(jnp.float32)).astype(x.dtype)


def t5_bucket(rel):
    n = jnp.maximum(rel, 0)
    max_exact = N_BUCKETS // 2
    nf = jnp.maximum(n, 1).astype(jnp.float32)
    large = max_exact + (jnp.log(nf / max_exact) / math.log(MAX_DISTANCE / max_exact)
                         * (N_BUCKETS - max_exact)).astype(jnp.int32)
    large = jnp.minimum(large, N_BUCKETS - 1)
    return jnp.where(n < max_exact, n, large)


def causal_short_conv(u, conv_w):
    S = u.shape[1]
    up = jnp.pad(u, ((0, 0), (CONV_K - 1, 0), (0, 0)))
    y = conv_w[CONV_K - 1] * up[:, CONV_K - 1:CONV_K - 1 + S]
    for j in range(CONV_K - 1):
        y = y + conv_w[j] * up[:, j:j + S]
    return y


def sliding_window_attention(q, k, v, sinks, rel_bias):
    B, S = q.shape[0], q.shape[1]
    nb = S // BLOCK
    qb = q.reshape(B, nb, BLOCK, N_KV_HEADS, Q_PER_KV, HEAD_DIM)

    def with_prev(t):
        tb = t.reshape(B, nb, BLOCK, N_KV_HEADS, HEAD_DIM)
        prev = jnp.pad(tb[:, :-1], ((0, 0), (1, 0), (0, 0), (0, 0), (0, 0)))
        return jnp.concatenate([prev, tb], axis=2)

    kw, vw = with_prev(k), with_prev(v)
    scores = jnp.einsum('bnqkgd,bnskd->bnkgqs', qb, kw,
                        preferred_element_type=jnp.float32) * (HEAD_DIM ** -0.5)

    qi = jnp.arange(BLOCK, dtype=jnp.int32)
    kj = jnp.arange(2 * BLOCK, dtype=jnp.int32)
    rel = qi[:, None] + BLOCK - kj[None, :]
    bias = rel_bias.astype(jnp.float32)[t5_bucket(rel)]
    bias = jnp.transpose(bias, (2, 0, 1)).reshape(N_KV_HEADS, Q_PER_KV, BLOCK, 2 * BLOCK)

    in_window = (rel >= 0) & (rel < WINDOW)
    key_pos = jnp.arange(nb, dtype=jnp.int32)[:, None] * BLOCK - BLOCK + kj[None, :]
    mask = in_window[None] & (key_pos >= 0)[:, None, :]

    logits = jnp.where(mask[None, :, None, None], scores + bias[None, None], -jnp.inf)
    sink = sinks.astype(jnp.float32).reshape(1, 1, N_KV_HEADS, Q_PER_KV, 1, 1)
    m = jnp.maximum(jnp.max(logits, axis=-1, keepdims=True), sink)
    p = jnp.exp(logits - m)
    denom = jnp.sum(p, axis=-1, keepdims=True) + jnp.exp(sink - m)
    out = jnp.einsum('bnkgqs,bnskd->bnqkgd', (p / denom).astype(v.dtype), vw)
    return out.reshape(B, S, ATTN_WIDTH)


def clamped_swiglu(hid):
    x_glu, x_lin = hid[..., ::2], hid[..., 1::2]
    x_glu = jnp.minimum(x_glu, SWIGLU_LIMIT)
    x_lin = jnp.clip(x_lin, -SWIGLU_LIMIT, SWIGLU_LIMIT)
    return x_glu * jax.nn.sigmoid(SWIGLU_ALPHA * x_glu) * (x_lin + 1.0)


def moe_ffn(h, w_router, b_router, w1, b1, w2, b2):
    T = h.shape[0]
    logits = jnp.matmul(h, w_router, preferred_element_type=jnp.float32) + b_router.astype(jnp.float32)
    top_vals, top_idx = lax.top_k(logits, TOP_K)
    gates = jax.nn.softmax(top_vals, axis=-1)

    e_flat = top_idx.reshape(-1).astype(jnp.int32)
    tok_flat = jnp.repeat(jnp.arange(T, dtype=jnp.int32), TOP_K)
    g_flat = gates.reshape(-1)
    order = jnp.argsort(e_flat, stable=True)
    e_s, tok_s, g_s = e_flat[order], tok_flat[order], g_flat[order]

    counts = jnp.bincount(e_flat, length=N_EXPERTS).astype(jnp.int32)
    starts = jnp.cumsum(counts) - counts
    padded = (counts + MOE_BLOCK - 1) // MOE_BLOCK * MOE_BLOCK
    pad_ends = jnp.cumsum(padded)
    pad_starts = pad_ends - padded
    dest = pad_starts[e_s] + (jnp.arange(T * TOP_K, dtype=jnp.int32) - starts[e_s])

    n_blocks = -(-(T * TOP_K + N_EXPERTS * MOE_BLOCK) // MOE_BLOCK)
    n_slots = n_blocks * MOE_BLOCK
    slot_tok = jnp.zeros((n_slots,), jnp.int32).at[dest].set(tok_s)
    slot_gate = jnp.zeros((n_slots,), jnp.float32).at[dest].set(g_s)
    block_start = jnp.arange(n_blocks, dtype=jnp.int32) * MOE_BLOCK
    block_expert = jnp.minimum(jnp.searchsorted(pad_ends, block_start, side='right'),
                               N_EXPERTS - 1).astype(jnp.int32)

    def expert_block(args):
        toks, gts, e = args
        xb = h[toks]
        hid = xb @ w1[e] + b1[e]
        yb = clamped_swiglu(hid) @ w2[e] + b2[e]
        return yb * gts[:, None].astype(yb.dtype)

    y_slots = lax.map(expert_block, (slot_tok.reshape(n_blocks, MOE_BLOCK),
                                     slot_gate.reshape(n_blocks, MOE_BLOCK), block_expert))
    y_slots = y_slots.reshape(n_slots, h.shape[-1])
    return jnp.zeros_like(h).at[slot_tok].add(y_slots.astype(h.dtype))


def setup_inputs(seed: int = 0) -> dict:
    key = jax.random.key(seed)
    ks = jax.random.split(key, 20)
    f32 = jnp.float32
    nrm = lambda k, shape, s: jax.random.normal(k, shape, f32) * s
    return {
        "x": nrm(ks[0], (BATCH, SEQ, D_MODEL), 1.0),
        "norm_mix": 1.0 + nrm(ks[1], (DEPTH, D_MODEL), 0.02),
        "w_in": nrm(ks[2], (DEPTH, D_MODEL, IN_WIDTH), D_MODEL ** -0.5),
        "b_in": nrm(ks[3], (DEPTH, IN_WIDTH), 0.02),
        "conv_w": nrm(ks[4], (DEPTH, CONV_K, CONV_WIDTH), CONV_K ** -0.5),
        "q_norm": 1.0 + nrm(ks[5], (DEPTH, HEAD_DIM), 0.02),
        "k_norm": 1.0 + nrm(ks[6], (DEPTH, HEAD_DIM), 0.02),
        "sinks": nrm(ks[7], (DEPTH, N_Q_HEADS), 1.0),
        "rel_bias": nrm(ks[8], (N_BUCKETS, N_Q_HEADS), 0.1),
        "out_norm_conv": 1.0 + nrm(ks[9], (DEPTH, CONV_WIDTH), 0.02),
        "out_norm_attn": 1.0 + nrm(ks[10], (DEPTH, ATTN_WIDTH), 0.02),
        "w_out": nrm(ks[11], (DEPTH, MIX_WIDTH, D_MODEL), MIX_WIDTH ** -0.5),
        "b_out": nrm(ks[12], (DEPTH, D_MODEL), 0.02),
        "norm_ffn": 1.0 + nrm(ks[13], (DEPTH, D_MODEL), 0.02),
        "w_router": nrm(ks[14], (DEPTH, D_MODEL, N_EXPERTS), D_MODEL ** -0.5),
        "b_router": nrm(ks[15], (DEPTH, N_EXPERTS), 0.01),
        "w1": nrm(ks[16], (DEPTH, N_EXPERTS, D_MODEL, 2 * D_FF), D_MODEL ** -0.5),
        "b1": nrm(ks[17], (DEPTH, N_EXPERTS, 2 * D_FF), 0.02),
        "w2": nrm(ks[18], (DEPTH, N_EXPERTS, D_FF, D_MODEL), D_FF ** -0.5),
        "b2": nrm(ks[19], (DEPTH, N_EXPERTS, D_MODEL), 0.02),
    }


def reference(x, norm_mix, w_in, b_in, conv_w, q_norm, k_norm, sinks, rel_bias,
              out_norm_conv, out_norm_attn, w_out, b_out, norm_ffn,
              w_router, b_router, w1, b1, w2, b2):
    B, S, D = x.shape
    cuts = [CONV_WIDTH, 2 * CONV_WIDTH, 3 * CONV_WIDTH, 3 * CONV_WIDTH + ATTN_WIDTH,
            3 * CONV_WIDTH + ATTN_WIDTH + KV_WIDTH]
    for l in range(DEPTH):
        h = rms_norm(x, norm_mix[l])
        proj = h @ w_in[l] + b_in[l]
        b_gate, c_gate, u, q, k, v = jnp.split(proj, cuts, axis=-1)

        y_conv = b_gate * causal_short_conv(c_gate * u, conv_w[l])

        q = rms_norm(q.reshape(B, S, N_Q_HEADS, HEAD_DIM), q_norm[l])
        k = rms_norm(k.reshape(B, S, N_KV_HEADS, HEAD_DIM), k_norm[l])
        v = v.reshape(B, S, N_KV_HEADS, HEAD_DIM)
        y_attn = sliding_window_attention(q, k, v, sinks[l], rel_bias)

        mix = jnp.concatenate([rms_norm(y_conv, out_norm_conv[l]),
                               rms_norm(y_attn, out_norm_attn[l])], axis=-1)
        x = x + mix @ w_out[l] + b_out[l]

        h2 = rms_norm(x, norm_ffn[l]).reshape(B * S, D)
        x = x + moe_ffn(h2, w_router[l], b_router[l], w1[l], b1[l], w2[l], b2[l]).reshape(B, S, D)
    return x
```

```cpp
#include <hip/hip_runtime.h>
#include <cstdio>
#include <cstdint>
#include <cmath>

constexpr int BATCH = 8, SEQ = 8192, D = 1024, T = BATCH * SEQ;
constexpr int HD = 64, CONVW = 512, NQH = 8, NKVH = 2, QPKV = 4, ATTNW = 512, KVW = 128, INW = 2304;
constexpr int NEXP = 32, TOPK = 4, DFF = 1024;
constexpr float EPS = 1e-5f;
constexpr int QOFF = 3 * CONVW, KOFF = QOFF + ATTNW, VOFF = KOFF + KVW;

constexpr size_t MiB = 1u << 20;
constexpr size_t WS_CTL = 0, CTL_ZERO_BYTES = 1 * MiB;
constexpr size_t WS_RSTD = 1 * MiB;
constexpr size_t WS_WR = 1 * MiB + 512 * 1024;
constexpr size_t WS_GATE = 2 * MiB;
constexpr size_t WS_DEST = 4 * MiB;
constexpr size_t WS_B1 = 12 * MiB;
constexpr size_t WS_W2T = 16 * MiB;
constexpr size_t WS_X1B = 80 * MiB;
constexpr size_t WS_XN = WS_X1B;
constexpr size_t WS_ACTHI = 208 * MiB;
constexpr size_t WS_MIX = WS_ACTHI;
constexpr size_t WS_YS = 480 * MiB;
constexpr size_t WS_W1T = 480 * MiB;
constexpr size_t WS_WINT = 608 * MiB;
constexpr size_t WS_WOUTT = 613 * MiB;
constexpr size_t WS_PROJ = 616 * MiB;
constexpr size_t WS_END = 1024 * MiB;
static_assert(WS_PROJ + (size_t)T * INW * 2 <= WS_END && WS_YS + (size_t)T * 4 * D * 2 <= WS_END && WS_ACTHI + 272 * MiB <= WS_YS, "ws map");
constexpr int ACT_LO_TILES = 512;
constexpr int CW_TMO = 0, CW_CODE = 1;
constexpr int CW_CNT = 64;
constexpr int CW_BAR = 4096;

typedef unsigned short bf16;
typedef unsigned v4u __attribute__((ext_vector_type(4)));
typedef unsigned v2u __attribute__((ext_vector_type(2)));
typedef float f32x4 __attribute__((ext_vector_type(4)));
typedef float f32x2 __attribute__((ext_vector_type(2)));
typedef short bf16x8 __attribute__((ext_vector_type(8)));

__device__ __forceinline__ unsigned f2bf(float f) { unsigned u = __builtin_bit_cast(unsigned, f); return (u + 0x7fffu + ((u >> 16) & 1u)) >> 16; }
__device__ __forceinline__ unsigned pk2(float lo, float hi) { return f2bf(lo) | (f2bf(hi) << 16); }
__device__ __forceinline__ float bf2f(bf16 b) { return __builtin_bit_cast(float, (unsigned)b << 16); }
__device__ __forceinline__ float bflo(unsigned w) { return __builtin_bit_cast(float, w << 16); }
__device__ __forceinline__ float bfhi(unsigned w) { return __builtin_bit_cast(float, w & 0xffff0000u); }
__device__ __forceinline__ float wave_sum(float v) {
#pragma unroll
    for (int o = 1; o < 64; o <<= 1) v += __shfl_xor(v, o);
    return v;
}
__device__ __forceinline__ float swiglu(float gl, float ln) {
    gl = fminf(gl, 7.0f); ln = fminf(fmaxf(ln, -7.0f), 7.0f);
    return gl * (1.0f / (1.0f + __expf(-1.702f * gl))) * (ln + 1.0f);
}
__device__ __forceinline__ bf16* act_row(bf16* lo, bf16* hi, int slot) { return slot < ACT_LO_TILES * 256 ? lo + (size_t)slot * DFF : hi + (size_t)(slot - ACT_LO_TILES * 256) * DFF; }
__device__ const unsigned char T5B[128] = {0, 1, 2, 3, 4, 5, 6, 7, 8, 9, 10, 11, 12, 13, 14, 15, 16, 16, 16, 17, 17, 18, 18, 18, 19, 19, 19, 20, 20, 20, 20, 21, 21, 21, 21, 22, 22, 22, 22, 22, 23, 23, 23, 23, 23, 23, 24, 24, 24, 24, 24, 24, 25, 25, 25, 25, 25, 25, 25, 26, 26, 26, 26, 26, 26, 26, 26, 27, 27, 27, 27, 27, 27, 27, 27, 27, 27, 28, 28, 28, 28, 28, 28, 28, 28, 28, 28, 29, 29, 29, 29, 29, 29, 29, 29, 29, 29, 29, 29, 30, 30, 30, 30, 30, 30, 30, 30, 30, 30, 30, 30, 30, 30, 31, 31, 31, 31, 31, 31, 31, 31, 31, 31, 31, 31, 31, 31, 31};
namespace nv {

__global__ void __launch_bounds__(256) k_rms_in(const float* __restrict__ x, const float* __restrict__ g, bf16* __restrict__ xn) {
    const int row = blockIdx.x * 4 + (threadIdx.x >> 6), lane = threadIdx.x & 63;
    const float* xr = x + (size_t)row * D;
    float v[16]; float ss = 0.f;
#pragma unroll
    for (int j = 0; j < 16; ++j) { v[j] = xr[lane + 64 * j]; ss += v[j] * v[j]; }
    ss = wave_sum(ss);
    const float rstd = 1.0f / sqrtf(ss * (1.0f / D) + EPS);
#pragma unroll
    for (int j = 0; j < 16; ++j) xn[(size_t)row * D + lane + 64 * j] = (bf16)f2bf(v[j] * rstd * g[lane + 64 * j]);
}

struct TileInfo { int valid; int e; int row0; int nrows; };

template <class Op>
__global__ void __launch_bounds__(256) k_gemm(Op op, int K) {
    __shared__ float As[16][132];
    __shared__ float Bs[16][132];
    const int tid = threadIdx.x, tx = tid & 15, ty = tid >> 4;
    if (!op.setup(blockIdx.y, blockIdx.x)) return;
    float acc[8][8];
#pragma unroll
    for (int i = 0; i < 8; ++i)
#pragma unroll
        for (int j = 0; j < 8; ++j) acc[i][j] = 0.f;
    const int ar = tid >> 1, ah = tid & 1;
    const bf16* arow = op.a_row(ar);
    const float* wcol = op.w_base() + (tid & 15) * 8;
    const int wk = tid >> 4;
    for (int k0 = 0; k0 < K; k0 += 16) {
        uint4 av = *(const uint4*)(arow + k0 + ah * 8);
        const unsigned aw[4] = {av.x, av.y, av.z, av.w};
#pragma unroll
        for (int j = 0; j < 4; ++j) {
            As[ah * 8 + 2 * j][ar] = bf2f((bf16)(aw[j] & 0xffff)) * op.a_scale(k0 + ah * 8 + 2 * j);
            As[ah * 8 + 2 * j + 1][ar] = bf2f((bf16)(aw[j] >> 16)) * op.a_scale(k0 + ah * 8 + 2 * j + 1);
        }
        const float4 w0 = *(const float4*)(wcol + (size_t)(k0 + wk) * op.ldw());
        const float4 w1 = *(const float4*)(wcol + (size_t)(k0 + wk) * op.ldw() + 4);
        *(float4*)&Bs[wk][(tid & 15) * 8] = w0; *(float4*)&Bs[wk][(tid & 15) * 8 + 4] = w1;
        __syncthreads();
#pragma unroll
        for (int kk = 0; kk < 16; ++kk) {
            float a[8], b[8];
#pragma unroll
            for (int i = 0; i < 8; ++i) a[i] = As[kk][ty * 8 + i];
#pragma unroll
            for (int j = 0; j < 8; ++j) b[j] = Bs[kk][tx * 8 + j];
#pragma unroll
            for (int i = 0; i < 8; ++i)
#pragma unroll
                for (int j = 0; j < 8; ++j) acc[i][j] += a[i] * b[j];
        }
        __syncthreads();
    }
#pragma unroll
    for (int i = 0; i < 8; ++i) op.epi(ty * 8 + i, tx * 8, acc[i]);
}

struct OpIn {
    const bf16* xn; const float* w; const float* b; bf16* proj; int by, bx;
    __device__ bool setup(int by_, int bx_) { by = by_; bx = bx_; return true; }
    __device__ const bf16* a_row(int r) const { return xn + (size_t)(by * 128 + r) * D; }
    __device__ const float* w_base() const { return w + bx * 128; }
    __device__ int ldw() const { return INW; }
    __device__ float a_scale(int) const { return 1.f; }
    __device__ void epi(int r, int c0, const float* v) const {
        const int row = by * 128 + r, col = bx * 128 + c0;
#pragma unroll
        for (int j = 0; j < 8; ++j) proj[(size_t)row * INW + col + j] = (bf16)f2bf(v[j] + b[col + j]);
    }
};
struct OpOut {
    const bf16* mix; const float* w; const float* b; const float* x; bf16* x1b; int by, bx;
    __device__ bool setup(int by_, int bx_) { by = by_; bx = bx_; return true; }
    __device__ const bf16* a_row(int r) const { return mix + (size_t)(by * 128 + r) * D; }
    __device__ const float* w_base() const { return w + bx * 128; }
    __device__ int ldw() const { return D; }
    __device__ float a_scale(int) const { return 1.f; }
    __device__ void epi(int r, int c0, const float* v) const {
        const int row = by * 128 + r, col = bx * 128 + c0;
#pragma unroll
        for (int j = 0; j < 8; ++j) x1b[(size_t)row * D + col + j] = (bf16)f2bf(x[(size_t)row * D + col + j] + v[j] + b[col + j]);
    }
};
__device__ inline bool moe_tile(const unsigned* cnt, int t128, int& e, int& pos0, int& slot0) {
    int base = 0;
    for (int i = 0; i < NEXP; ++i) { const int n128 = 2 * (((int)cnt[i] + 255) / 256); if (t128 < base + n128) { e = i; pos0 = (t128 - base) * 128; slot0 = base * 128 + pos0; return true; } base += n128; }
    return false;
}
struct OpW1 {
    const bf16* x1b; const float* w1; const float* b1; const float* g; const float* rstd; const unsigned* cnt; const unsigned* dest; bf16* act_lo; bf16* act_hi;
    int e, pos0, slot0, bx;
    __device__ bool setup(int by_, int bx_) { bx = bx_; return moe_tile(cnt, by_, e, pos0, slot0); }
    __device__ int tok(int r) const { const int pos = pos0 + r; return pos < (int)cnt[e] ? (int)(dest[(size_t)e * T + pos] >> 2) : 0; }
    __device__ const bf16* a_row(int r) const { return x1b + (size_t)tok(r) * D; }
    __device__ const float* w_base() const { return w1 + (size_t)e * D * 2 * DFF + bx * 128; }
    __device__ int ldw() const { return 2 * DFF; }
    __device__ float a_scale(int k) const { return g[k]; }
    __device__ void epi(int r, int c0, const float* v) const {
        const int slot = slot0 + r; const float rs = rstd[tok(r)];
        bf16* arow = act_row(act_lo, act_hi, slot);
        const int col = bx * 128 + c0;
#pragma unroll
        for (int j = 0; j < 4; ++j) {
            const float gl = v[2 * j] * rs + b1[(size_t)e * 2 * DFF + col + 2 * j], ln = v[2 * j + 1] * rs + b1[(size_t)e * 2 * DFF + col + 2 * j + 1];
            arow[(col >> 1) + j] = (bf16)f2bf(swiglu(gl, ln));
        }
    }
};
struct OpW2 {
    const bf16* act_lo; const bf16* act_hi; const float* w2; const float* b2; const unsigned* cnt; const unsigned* dest; bf16* ys;
    int e, pos0, slot0, bx;
    __device__ bool setup(int by_, int bx_) { bx = bx_; return moe_tile(cnt, by_, e, pos0, slot0); }
    __device__ const bf16* a_row(int r) const { return act_row((bf16*)act_lo, (bf16*)act_hi, slot0 + r); }
    __device__ const float* w_base() const { return w2 + (size_t)e * DFF * D + bx * 128; }
    __device__ int ldw() const { return D; }
    __device__ float a_scale(int) const { return 1.f; }
    __device__ void epi(int r, int c0, const float* v) const {
        const int pos = pos0 + r; if (pos >= (int)cnt[e]) return;
        const unsigned d = dest[(size_t)e * T + pos]; const int col = bx * 128 + c0;
#pragma unroll
        for (int j = 0; j < 8; ++j) ys[(size_t)d * D + col + j] = (bf16)f2bf(v[j] + b2[(size_t)e * D + col + j]);
    }
};

__global__ void __launch_bounds__(512) k_conv(const bf16* __restrict__ proj, const float* __restrict__ cw, const float* __restrict__ g, bf16* __restrict__ mix) {
    __shared__ float red[8];
    const int t = blockIdx.x, c = threadIdx.x, s = t % SEQ;
    const bf16* p = proj + (size_t)t * INW;
    float cu0 = bf2f(p[CONVW + c]) * bf2f(p[2 * CONVW + c]), cu1 = 0.f, cu2 = 0.f;
    if (s >= 1) cu1 = bf2f(p[CONVW + c - INW]) * bf2f(p[2 * CONVW + c - INW]);
    if (s >= 2) cu2 = bf2f(p[CONVW + c - 2 * INW]) * bf2f(p[2 * CONVW + c - 2 * INW]);
    const float y = bf2f(p[c]) * (cw[2 * CONVW + c] * cu0 + cw[CONVW + c] * cu1 + cw[c] * cu2);
    float ss = wave_sum(y * y);
    if ((c & 63) == 0) red[c >> 6] = ss;
    __syncthreads();
    ss = 0.f;
#pragma unroll
    for (int i = 0; i < 8; ++i) ss += red[i];
    const float rstd = 1.0f / sqrtf(ss * (1.0f / CONVW) + EPS);
    mix[(size_t)t * D + c] = (bf16)f2bf(y * rstd * g[c]);
}
__global__ void __launch_bounds__(512) k_attn(const bf16* __restrict__ proj, const float* __restrict__ qg, const float* __restrict__ kg, const float* __restrict__ sinks,
                                              const float* __restrict__ rel_bias, const float* __restrict__ g, bf16* __restrict__ mix) {
    __shared__ float qs[8][64];
    __shared__ float ps[8][128];
    __shared__ float red[8];
    const int t = blockIdx.x, h = threadIdx.x >> 6, lane = threadIdx.x & 63, s = t % SEQ, kv = h / QPKV;
    const bf16* p = proj + (size_t)t * INW;
    {
        const float q = bf2f(p[3 * CONVW + h * HD + lane]);
        const float ss = wave_sum(q * q);
        qs[h][lane] = q * (1.0f / sqrtf(ss * (1.0f / HD) + EPS)) * qg[lane] * 0.125f;
    }
    __syncthreads();
    float lg[2];
#pragma unroll
    for (int i = 0; i < 2; ++i) {
        const int rel = lane + 64 * i;
        lg[i] = -INFINITY;
        if (rel <= s) {
            const bf16* kr = p - (size_t)rel * INW + 3 * CONVW + ATTNW + kv * HD;
            float ss = 0.f, dot = 0.f;
            for (int d = 0; d < HD; ++d) { const float k = bf2f(kr[d]); ss += k * k; dot += k * kg[d] * qs[h][d]; }
            lg[i] = dot * (1.0f / sqrtf(ss * (1.0f / HD) + EPS)) + rel_bias[T5B[rel] * NQH + h];
        }
    }
    const float sk = sinks[h];
    float m = fmaxf(fmaxf(lg[0], lg[1]), sk);
#pragma unroll
    for (int o = 1; o < 64; o <<= 1) m = fmaxf(m, __shfl_xor(m, o));
    const float p0 = (lg[0] == -INFINITY) ? 0.f : expf(lg[0] - m), p1 = (lg[1] == -INFINITY) ? 0.f : expf(lg[1] - m);
    const float den = wave_sum(p0 + p1) + expf(sk - m);
    ps[h][lane] = p0 / den; ps[h][lane + 64] = p1 / den;
    __syncthreads();
    float o = 0.f;
    const int nk = s < 127 ? s + 1 : 128;
    for (int rel = 0; rel < nk; ++rel) o += ps[h][rel] * bf2f(p[-(ptrdiff_t)rel * INW + 3 * CONVW + ATTNW + KVW + kv * HD + lane]);
    float ss = wave_sum(o * o);
    if (lane == 0) red[h] = ss;
    __syncthreads();
    ss = 0.f;
#pragma unroll
    for (int i = 0; i < 8; ++i) ss += red[i];
    const float rstd = 1.0f / sqrtf(ss * (1.0f / ATTNW) + EPS);
    mix[(size_t)t * D + CONVW + h * HD + lane] = (bf16)f2bf(o * rstd * g[h * HD + lane]);
}
__global__ void __launch_bounds__(256) k_router(const bf16* __restrict__ x1b, const float* __restrict__ g, const float* __restrict__ wr, const float* __restrict__ br,
                                                float* __restrict__ rstd_o, float* __restrict__ gate_tk, unsigned* __restrict__ dest, unsigned* cnt) {
    const int t = blockIdx.x * 4 + (threadIdx.x >> 6), lane = threadIdx.x & 63;
    float h[16]; float ss = 0.f;
#pragma unroll
    for (int j = 0; j < 16; ++j) { const float v = bf2f(x1b[(size_t)t * D + lane + 64 * j]); ss += v * v; h[j] = v * g[lane + 64 * j]; }
    ss = wave_sum(ss);
    const float rstd = 1.0f / sqrtf(ss * (1.0f / D) + EPS);
    float lg[NEXP];
    for (int e = 0; e < NEXP; ++e) {
        float a = 0.f;
#pragma unroll
        for (int j = 0; j < 16; ++j) a += h[j] * wr[(size_t)(lane + 64 * j) * NEXP + e];
        lg[e] = wave_sum(a) * rstd + br[e];
    }
    if (lane == 0) {
        rstd_o[t] = rstd;
        int idx[4]; float val[4];
        unsigned used = 0u;
        for (int k = 0; k < 4; ++k) { int bi = -1; float bv = -INFINITY; for (int e = 0; e < NEXP; ++e) if (!((used >> e) & 1u) && lg[e] > bv) { bv = lg[e]; bi = e; } idx[k] = bi; val[k] = bv; used |= 1u << bi; }
        float den = 0.f, pe[4];
        for (int k = 0; k < 4; ++k) { pe[k] = expf(val[k] - val[0]); den += pe[k]; }
        for (int k = 0; k < 4; ++k) {
            gate_tk[t * 4 + k] = pe[k] / den;
            const unsigned pos = atomicAdd(&cnt[idx[k]], 1u);
            dest[(size_t)idx[k] * T + pos] = (unsigned)(t * 4 + k);
        }
    }
}
__global__ void __launch_bounds__(256) k_combine(const bf16* __restrict__ x1b, const bf16* __restrict__ ys, const float* __restrict__ gate_tk, float* __restrict__ out) {
    const size_t i = (size_t)blockIdx.x * 256 + threadIdx.x; const int t = (int)(i / D), c = (int)(i % D);
    float v = bf2f(x1b[i]);
#pragma unroll
    for (int k = 0; k < 4; ++k) v += gate_tk[t * 4 + k] * bf2f(ys[((size_t)t * 4 + k) * D + c]);
    out[i] = v;
}
}
extern "C" void kernel_launch(void* const* d_in, const int* in_sizes, int n_in, void* d_out, int out_size, void* d_ws, size_t ws_size, hipStream_t stream) {
    if (n_in != 20 || in_sizes[0] != T * D || out_size != T * D || ws_size < WS_END) { fprintf(stderr, "kernel_launch: unexpected shapes (n_in %d, in0 %d, out %d, ws %zu)\n", n_in, n_in > 0 ? in_sizes[0] : -1, out_size, ws_size); return; }
    const float* x = (const float*)d_in[0]; const float* norm_mix = (const float*)d_in[1]; const float* w_in = (const float*)d_in[2]; const float* b_in = (const float*)d_in[3];
    const float* conv_w = (const float*)d_in[4]; const float* q_norm = (const float*)d_in[5]; const float* k_norm = (const float*)d_in[6]; const float* sinks = (const float*)d_in[7];
    const float* rel_bias = (const float*)d_in[8]; const float* on_conv = (const float*)d_in[9]; const float* on_attn = (const float*)d_in[10]; const float* w_out = (const float*)d_in[11];
    const float* b_out = (const float*)d_in[12]; const float* norm_ffn = (const float*)d_in[13]; const float* w_router = (const float*)d_in[14]; const float* b_router = (const float*)d_in[15];
    const float* w1 = (const float*)d_in[16]; const float* b1 = (const float*)d_in[17]; const float* w2 = (const float*)d_in[18]; const float* b2 = (const float*)d_in[19];
    unsigned char* ws = (unsigned char*)d_ws; float* out = (float*)d_out;
    unsigned* ctl = (unsigned*)(ws + WS_CTL); unsigned* cnt = ctl + CW_CNT;
    bf16* xn = (bf16*)(ws + WS_XN); bf16* proj = (bf16*)(ws + WS_PROJ); bf16* mix = (bf16*)(ws + WS_MIX); bf16* x1b = (bf16*)(ws + WS_X1B);
    float* rstd = (float*)(ws + WS_RSTD); float* gate = (float*)(ws + WS_GATE); unsigned* dest = (unsigned*)(ws + WS_DEST);
    bf16* act_lo = (bf16*)d_out; bf16* act_hi = (bf16*)(ws + WS_ACTHI); bf16* ys = (bf16*)(ws + WS_YS);
    (void)hipMemsetAsync(ws + WS_CTL, 0, CTL_ZERO_BYTES, stream);
    hipLaunchKernelGGL(nv::k_rms_in, dim3(T / 4), dim3(256), 0, stream, x, norm_mix, xn);
    { nv::OpIn op{xn, w_in, b_in, proj, 0, 0}; hipLaunchKernelGGL((nv::k_gemm<nv::OpIn>), dim3(INW / 128, T / 128), dim3(256), 0, stream, op, D); }
    hipLaunchKernelGGL(nv::k_conv, dim3(T), dim3(512), 0, stream, proj, conv_w, on_conv, mix);
    hipLaunchKernelGGL(nv::k_attn, dim3(T), dim3(512), 0, stream, proj, q_norm, k_norm, sinks, rel_bias, on_attn, mix);
    { nv::OpOut op{mix, w_out, b_out, x, x1b, 0, 0}; hipLaunchKernelGGL((nv::k_gemm<nv::OpOut>), dim3(D / 128, T / 128), dim3(256), 0, stream, op, D); }
    hipLaunchKernelGGL(nv::k_router, dim3(T / 4), dim3(256), 0, stream, x1b, norm_ffn, w_router, b_router, rstd, gate, dest, cnt);
    { nv::OpW1 op{x1b, w1, b1, norm_ffn, rstd, cnt, dest, act_lo, act_hi, 0, 0, 0, 0}; hipLaunchKernelGGL((nv::k_gemm<nv::OpW1>), dim3(2 * DFF / 128, T * 4 / 128 + 64), dim3(256), 0, stream, op, D); }
    { nv::OpW2 op{act_lo, act_hi, w2, b2, cnt, dest, ys, 0, 0, 0, 0}; hipLaunchKernelGGL((nv::k_gemm<nv::OpW2>), dim3(D / 128, T * 4 / 128 + 64), dim3(256), 0, stream, op, DFF); }
    hipLaunchKernelGGL(nv::k_combine, dim3(T * D / 256), dim3(256), 0, stream, x1b, ys, gate, out);
}
```

```cpp
#include <hip/hip_runtime.h>
#include <cstdio>
#include <cstdint>
#include <cstddef>
#include <cmath>

constexpr int BATCH = 8, SEQ = 8192, D = 1024, T = BATCH * SEQ;
constexpr int HD = 64, CONVW = 512, NQH = 8, NKVH = 2, QPKV = 4, ATTNW = 512, KVW = 128, INW = 2304;
constexpr int NEXP = 32, TOPK = 4, DFF = 1024;
constexpr float EPS = 1e-5f;
constexpr int QOFF = 3 * CONVW, KOFF = QOFF + ATTNW, VOFF = KOFF + KVW;

constexpr size_t MiB = 1u << 20;
constexpr size_t WS_CTL = 0, CTL_ZERO_BYTES = 1 * MiB;
constexpr size_t WS_RSTD = 1 * MiB;
constexpr size_t WS_WR = 1 * MiB + 512 * 1024;
constexpr size_t WS_B1 = 1 * MiB + 768 * 1024;
constexpr size_t WS_GATE = 2 * MiB;
constexpr size_t WS_DEST = 4 * MiB;
constexpr size_t WS_RSL = 12 * MiB;
constexpr size_t WS_W2T = 20 * MiB;
constexpr size_t WS_X1B = 84 * MiB;
constexpr size_t WS_XN = WS_X1B;
constexpr size_t WS_ACTHI = 212 * MiB;
constexpr size_t WS_MIX = WS_ACTHI;
constexpr size_t WS_YS = 484 * MiB;
constexpr size_t WS_W1T = 484 * MiB;
constexpr size_t WS_WINT = 612 * MiB;
constexpr size_t WS_WOUTT = 617 * MiB;
constexpr size_t WS_PROJ = 620 * MiB;
constexpr size_t WS_END = 1024 * MiB;
static_assert(WS_PROJ + (size_t)T * INW * 2 <= WS_END && WS_YS + (size_t)T * 4 * D * 2 <= WS_END && WS_ACTHI + 272 * MiB <= WS_YS && WS_W1T + 128 * MiB <= WS_WINT && WS_W2T + 64 * MiB <= WS_X1B, "ws map");
constexpr int ACT_LO_TILES = 512;
constexpr int CW_TMO = 0, CW_CODE = 1;
constexpr int CW_CNT = 64;
constexpr int CW_BAR = 4096;

typedef unsigned short bf16;
typedef unsigned v4u __attribute__((ext_vector_type(4)));
typedef unsigned v2u __attribute__((ext_vector_type(2)));
typedef float f32x4 __attribute__((ext_vector_type(4)));
typedef float f32x2 __attribute__((ext_vector_type(2)));
typedef short bf16x8 __attribute__((ext_vector_type(8)));

__device__ __forceinline__ unsigned f2bf(float f) { unsigned u = __builtin_bit_cast(unsigned, f); return (u + 0x7fffu + ((u >> 16) & 1u)) >> 16; }
__device__ __forceinline__ unsigned pk2(float lo, float hi) { return f2bf(lo) | (f2bf(hi) << 16); }
__device__ __forceinline__ float bf2f(bf16 b) { return __builtin_bit_cast(float, (unsigned)b << 16); }
__device__ __forceinline__ float bflo(unsigned w) { return __builtin_bit_cast(float, w << 16); }
__device__ __forceinline__ float bfhi(unsigned w) { return __builtin_bit_cast(float, w & 0xffff0000u); }
__device__ __forceinline__ float wave_sum(float v) {
#pragma unroll
    for (int o = 1; o < 64; o <<= 1) v += __shfl_xor(v, o);
    return v;
}
__device__ __forceinline__ float swiglu(float gl, float ln) {
    gl = fminf(gl, 7.0f); ln = fminf(fmaxf(ln, -7.0f), 7.0f);
    return gl * (1.0f / (1.0f + __expf(-1.702f * gl))) * (ln + 1.0f);
}
__device__ __forceinline__ bf16* act_row(bf16* lo, bf16* hi, int slot) { return slot < ACT_LO_TILES * 256 ? lo + (size_t)slot * DFF : hi + (size_t)(slot - ACT_LO_TILES * 256) * DFF; }
__device__ const unsigned char T5B[128] = {0, 1, 2, 3, 4, 5, 6, 7, 8, 9, 10, 11, 12, 13, 14, 15, 16, 16, 16, 17, 17, 18, 18, 18, 19, 19, 19, 20, 20, 20, 20, 21, 21, 21, 21, 22, 22, 22, 22, 22, 23, 23, 23, 23, 23, 23, 24, 24, 24, 24, 24, 24, 25, 25, 25, 25, 25, 25, 25, 26, 26, 26, 26, 26, 26, 26, 26, 27, 27, 27, 27, 27, 27, 27, 27, 27, 27, 28, 28, 28, 28, 28, 28, 28, 28, 28, 28, 29, 29, 29, 29, 29, 29, 29, 29, 29, 29, 29, 29, 30, 30, 30, 30, 30, 30, 30, 30, 30, 30, 30, 30, 30, 30, 31, 31, 31, 31, 31, 31, 31, 31, 31, 31, 31, 31, 31, 31, 31};
#define FAST_MASK 0xFF
namespace nv {

__global__ void __launch_bounds__(256) k_rms_in(const float* __restrict__ x, const float* __restrict__ g, bf16* __restrict__ xn) {
    const int row = blockIdx.x * 4 + (threadIdx.x >> 6), lane = threadIdx.x & 63;
    const float* xr = x + (size_t)row * D;
    float v[16]; float ss = 0.f;
#pragma unroll
    for (int j = 0; j < 16; ++j) { v[j] = xr[lane + 64 * j]; ss += v[j] * v[j]; }
    ss = wave_sum(ss);
    const float rstd = 1.0f / sqrtf(ss * (1.0f / D) + EPS);
#pragma unroll
    for (int j = 0; j < 16; ++j) xn[(size_t)row * D + lane + 64 * j] = (bf16)f2bf(v[j] * rstd * g[lane + 64 * j]);
}

struct TileInfo { int valid; int e; int row0; int nrows; };

template <class Op>
__global__ void __launch_bounds__(256) k_gemm(Op op, int K) {
    __shared__ float As[16][132];
    __shared__ float Bs[16][132];
    const int tid = threadIdx.x, tx = tid & 15, ty = tid >> 4;
    if (!op.setup(blockIdx.y, blockIdx.x)) return;
    float acc[8][8];
#pragma unroll
    for (int i = 0; i < 8; ++i)
#pragma unroll
        for (int j = 0; j < 8; ++j) acc[i][j] = 0.f;
    const int ar = tid >> 1, ah = tid & 1;
    const bf16* arow = op.a_row(ar);
    const float* wcol = op.w_base() + (tid & 15) * 8;
    const int wk = tid >> 4;
    for (int k0 = 0; k0 < K; k0 += 16) {
        uint4 av = *(const uint4*)(arow + k0 + ah * 8);
        const unsigned aw[4] = {av.x, av.y, av.z, av.w};
#pragma unroll
        for (int j = 0; j < 4; ++j) {
            As[ah * 8 + 2 * j][ar] = bf2f((bf16)(aw[j] & 0xffff)) * op.a_scale(k0 + ah * 8 + 2 * j);
            As[ah * 8 + 2 * j + 1][ar] = bf2f((bf16)(aw[j] >> 16)) * op.a_scale(k0 + ah * 8 + 2 * j + 1);
        }
        const float4 w0 = *(const float4*)(wcol + (size_t)(k0 + wk) * op.ldw());
        const float4 w1 = *(const float4*)(wcol + (size_t)(k0 + wk) * op.ldw() + 4);
        *(float4*)&Bs[wk][(tid & 15) * 8] = w0; *(float4*)&Bs[wk][(tid & 15) * 8 + 4] = w1;
        __syncthreads();
#pragma unroll
        for (int kk = 0; kk < 16; ++kk) {
            float a[8], b[8];
#pragma unroll
            for (int i = 0; i < 8; ++i) a[i] = As[kk][ty * 8 + i];
#pragma unroll
            for (int j = 0; j < 8; ++j) b[j] = Bs[kk][tx * 8 + j];
#pragma unroll
            for (int i = 0; i < 8; ++i)
#pragma unroll
                for (int j = 0; j < 8; ++j) acc[i][j] += a[i] * b[j];
        }
        __syncthreads();
    }
#pragma unroll
    for (int i = 0; i < 8; ++i) op.epi(ty * 8 + i, tx * 8, acc[i]);
}

struct OpIn {
    const bf16* xn; const float* w; const float* b; bf16* proj; int by, bx;
    __device__ bool setup(int by_, int bx_) { by = by_; bx = bx_; return true; }
    __device__ const bf16* a_row(int r) const { return xn + (size_t)(by * 128 + r) * D; }
    __device__ const float* w_base() const { return w + bx * 128; }
    __device__ int ldw() const { return INW; }
    __device__ float a_scale(int) const { return 1.f; }
    __device__ void epi(int r, int c0, const float* v) const {
        const int row = by * 128 + r, col = bx * 128 + c0;
#pragma unroll
        for (int j = 0; j < 8; ++j) proj[(size_t)row * INW + col + j] = (bf16)f2bf(v[j] + b[col + j]);
    }
};
struct OpOut {
    const bf16* mix; const float* w; const float* b; const float* x; bf16* x1b; int by, bx;
    __device__ bool setup(int by_, int bx_) { by = by_; bx = bx_; return true; }
    __device__ const bf16* a_row(int r) const { return mix + (size_t)(by * 128 + r) * D; }
    __device__ const float* w_base() const { return w + bx * 128; }
    __device__ int ldw() const { return D; }
    __device__ float a_scale(int) const { return 1.f; }
    __device__ void epi(int r, int c0, const float* v) const {
        const int row = by * 128 + r, col = bx * 128 + c0;
#pragma unroll
        for (int j = 0; j < 8; ++j) x1b[(size_t)row * D + col + j] = (bf16)f2bf(x[(size_t)row * D + col + j] + v[j] + b[col + j]);
    }
};
__device__ inline bool moe_tile(const unsigned* cnt, int t128, int& e, int& pos0, int& slot0) {
    int base = 0;
    for (int i = 0; i < NEXP; ++i) { const int n128 = 2 * (((int)cnt[i] + 255) / 256); if (t128 < base + n128) { e = i; pos0 = (t128 - base) * 128; slot0 = base * 128 + pos0; return true; } base += n128; }
    return false;
}
struct OpW1 {
    const bf16* x1b; const float* w1; const float* b1; const float* g; const float* rstd; const unsigned* cnt; const unsigned* dest; bf16* act_lo; bf16* act_hi;
    int e, pos0, slot0, bx;
    __device__ bool setup(int by_, int bx_) { bx = bx_; return moe_tile(cnt, by_, e, pos0, slot0); }
    __device__ int tok(int r) const { const int pos = pos0 + r; return pos < (int)cnt[e] ? (int)(dest[(size_t)e * T + pos] >> 2) : 0; }
    __device__ const bf16* a_row(int r) const { return x1b + (size_t)tok(r) * D; }
    __device__ const float* w_base() const { return w1 + (size_t)e * D * 2 * DFF + bx * 128; }
    __device__ int ldw() const { return 2 * DFF; }
    __device__ float a_scale(int k) const { return g[k]; }
    __device__ void epi(int r, int c0, const float* v) const {
        const int slot = slot0 + r; const float rs = rstd[tok(r)];
        bf16* arow = act_row(act_lo, act_hi, slot);
        const int col = bx * 128 + c0;
#pragma unroll
        for (int j = 0; j < 4; ++j) {
            const float gl = v[2 * j] * rs + b1[(size_t)e * 2 * DFF + col + 2 * j], ln = v[2 * j + 1] * rs + b1[(size_t)e * 2 * DFF + col + 2 * j + 1];
            arow[(col >> 1) + j] = (bf16)f2bf(swiglu(gl, ln));
        }
    }
};
struct OpW2 {
    const bf16* act_lo; const bf16* act_hi; const float* w2; const float* b2; const unsigned* cnt; const unsigned* dest; bf16* ys;
    int e, pos0, slot0, bx;
    __device__ bool setup(int by_, int bx_) { bx = bx_; return moe_tile(cnt, by_, e, pos0, slot0); }
    __device__ const bf16* a_row(int r) const { return act_row((bf16*)act_lo, (bf16*)act_hi, slot0 + r); }
    __device__ const float* w_base() const { return w2 + (size_t)e * DFF * D + bx * 128; }
    __device__ int ldw() const { return D; }
    __device__ float a_scale(int) const { return 1.f; }
    __device__ void epi(int r, int c0, const float* v) const {
        const int pos = pos0 + r; if (pos >= (int)cnt[e]) return;
        const unsigned d = dest[(size_t)e * T + pos]; const int col = bx * 128 + c0;
#pragma unroll
        for (int j = 0; j < 8; ++j) ys[(size_t)d * D + col + j] = (bf16)f2bf(v[j] + b2[(size_t)e * D + col + j]);
    }
};

__global__ void __launch_bounds__(512) k_conv(const bf16* __restrict__ proj, const float* __restrict__ cw, const float* __restrict__ g, bf16* __restrict__ mix) {
    __shared__ float red[8];
    const int t = blockIdx.x, c = threadIdx.x, s = t % SEQ;
    const bf16* p = proj + (size_t)t * INW;
    float cu0 = bf2f(p[CONVW + c]) * bf2f(p[2 * CONVW + c]), cu1 = 0.f, cu2 = 0.f;
    if (s >= 1) cu1 = bf2f(p[CONVW + c - INW]) * bf2f(p[2 * CONVW + c - INW]);
    if (s >= 2) cu2 = bf2f(p[CONVW + c - 2 * INW]) * bf2f(p[2 * CONVW + c - 2 * INW]);
    const float y = bf2f(p[c]) * (cw[2 * CONVW + c] * cu0 + cw[CONVW + c] * cu1 + cw[c] * cu2);
    float ss = wave_sum(y * y);
    if ((c & 63) == 0) red[c >> 6] = ss;
    __syncthreads();
    ss = 0.f;
#pragma unroll
    for (int i = 0; i < 8; ++i) ss += red[i];
    const float rstd = 1.0f / sqrtf(ss * (1.0f / CONVW) + EPS);
    mix[(size_t)t * D + c] = (bf16)f2bf(y * rstd * g[c]);
}
__global__ void __launch_bounds__(512) k_attn(const bf16* __restrict__ proj, const float* __restrict__ qg, const float* __restrict__ kg, const float* __restrict__ sinks,
                                              const float* __restrict__ rel_bias, const float* __restrict__ g, bf16* __restrict__ mix) {
    __shared__ float qs[8][64];
    __shared__ float ps[8][128];
    __shared__ float red[8];
    const int t = blockIdx.x, h = threadIdx.x >> 6, lane = threadIdx.x & 63, s = t % SEQ, kv = h / QPKV;
    const bf16* p = proj + (size_t)t * INW;
    {
        const float q = bf2f(p[3 * CONVW + h * HD + lane]);
        const float ss = wave_sum(q * q);
        qs[h][lane] = q * (1.0f / sqrtf(ss * (1.0f / HD) + EPS)) * qg[lane] * 0.125f;
    }
    __syncthreads();
    float lg[2];
#pragma unroll
    for (int i = 0; i < 2; ++i) {
        const int rel = lane + 64 * i;
        lg[i] = -INFINITY;
        if (rel <= s) {
            const bf16* kr = p - (size_t)rel * INW + 3 * CONVW + ATTNW + kv * HD;
            float ss = 0.f, dot = 0.f;
            for (int d = 0; d < HD; ++d) { const float k = bf2f(kr[d]); ss += k * k; dot += k * kg[d] * qs[h][d]; }
            lg[i] = dot * (1.0f / sqrtf(ss * (1.0f / HD) + EPS)) + rel_bias[T5B[rel] * NQH + h];
        }
    }
    const float sk = sinks[h];
    float m = fmaxf(fmaxf(lg[0], lg[1]), sk);
#pragma unroll
    for (int o = 1; o < 64; o <<= 1) m = fmaxf(m, __shfl_xor(m, o));
    const float p0 = (lg[0] == -INFINITY) ? 0.f : expf(lg[0] - m), p1 = (lg[1] == -INFINITY) ? 0.f : expf(lg[1] - m);
    const float den = wave_sum(p0 + p1) + expf(sk - m);
    ps[h][lane] = p0 / den; ps[h][lane + 64] = p1 / den;
    __syncthreads();
    float o = 0.f;
    const int nk = s < 127 ? s + 1 : 128;
    for (int rel = 0; rel < nk; ++rel) o += ps[h][rel] * bf2f(p[-(ptrdiff_t)rel * INW + 3 * CONVW + ATTNW + KVW + kv * HD + lane]);
    float ss = wave_sum(o * o);
    if (lane == 0) red[h] = ss;
    __syncthreads();
    ss = 0.f;
#pragma unroll
    for (int i = 0; i < 8; ++i) ss += red[i];
    const float rstd = 1.0f / sqrtf(ss * (1.0f / ATTNW) + EPS);
    mix[(size_t)t * D + CONVW + h * HD + lane] = (bf16)f2bf(o * rstd * g[h * HD + lane]);
}
__global__ void __launch_bounds__(256) k_router(const bf16* __restrict__ x1b, const float* __restrict__ g, const float* __restrict__ wr, const float* __restrict__ br,
                                                float* __restrict__ rstd_o, float* __restrict__ gate_tk, unsigned* __restrict__ dest, float* __restrict__ rsl, unsigned* cnt) {
    const int t = blockIdx.x * 4 + (threadIdx.x >> 6), lane = threadIdx.x & 63;
    float h[16]; float ss = 0.f;
#pragma unroll
    for (int j = 0; j < 16; ++j) { const float v = bf2f(x1b[(size_t)t * D + lane + 64 * j]); ss += v * v; h[j] = v * g[lane + 64 * j]; }
    ss = wave_sum(ss);
    const float rstd = 1.0f / sqrtf(ss * (1.0f / D) + EPS);
    float lg[NEXP];
    for (int e = 0; e < NEXP; ++e) {
        float a = 0.f;
#pragma unroll
        for (int j = 0; j < 16; ++j) a += h[j] * wr[(size_t)(lane + 64 * j) * NEXP + e];
        lg[e] = wave_sum(a) * rstd + br[e];
    }
    if (lane == 0) {
        rstd_o[t] = rstd;
        int idx[4]; float val[4];
        unsigned used = 0u;
        for (int k = 0; k < 4; ++k) { int bi = -1; float bv = -INFINITY; for (int e = 0; e < NEXP; ++e) if (!((used >> e) & 1u) && lg[e] > bv) { bv = lg[e]; bi = e; } idx[k] = bi; val[k] = bv; used |= 1u << bi; }
        float den = 0.f, pe[4];
        for (int k = 0; k < 4; ++k) { pe[k] = expf(val[k] - val[0]); den += pe[k]; }
        for (int k = 0; k < 4; ++k) {
            gate_tk[t * 4 + k] = pe[k] / den;
            const unsigned pos = atomicAdd(&cnt[idx[k]], 1u);
            dest[(size_t)idx[k] * T + pos] = (unsigned)(t * 4 + k); rsl[(size_t)idx[k] * T + pos] = rstd;
        }
    }
}
__global__ void __launch_bounds__(256) k_combine(const bf16* __restrict__ x1b, const bf16* __restrict__ ys, const float* __restrict__ gate_tk, float* __restrict__ out) {
    const size_t i = (size_t)blockIdx.x * 256 + threadIdx.x; const int t = (int)(i / D), c = (int)(i % D);
    float v = bf2f(x1b[i]);
#pragma unroll
    for (int k = 0; k < 4; ++k) v += gate_tk[t * 4 + k] * bf2f(ys[((size_t)t * 4 + k) * D + c]);
    out[i] = v;
}
}
namespace pg8 {
#define PG8_LAS __attribute__((address_space(3)))
constexpr int BM = 256, BK = 64, HALF = 128, HTB = HALF * BK * 2  , STAGE_BYTES = 8 * HTB, NXCD = 8, WGM = 8;

__host__ __device__ __forceinline__ int lds_byte(int r, int c) { const int st = (r >> 4) * 2 + (c >> 5), rr = r & 15, cc = c & 31, ob = rr * 64 + cc * 2; return st * 1024 + (ob ^ (((ob >> 9) & 1) << 5)); }
__host__ __device__ __forceinline__ void stage_rc(int b, int& R, int& C) { const int st = b / 1024, sb = b % 1024, swz = sb ^ (((sb >> 9) & 1) << 5); R = (st >> 1) * 16 + swz / 64; C = (st & 1) * 32 + (swz % 64) / 2; }
__host__ __device__ __forceinline__ int perm32(int rho) { const int n = rho >> 4, i = rho & 15; return 8 * (i >> 2) + 4 * n + (i & 3); }

struct Unit { const char* A; const char* B; int pm, pn, e, pos0; };

__device__ __forceinline__ void tile_of(int L, int nM, int nN, int& pm, int& pn) {
    const int nwg = nM * nN; int wgid = L; { const int q = nwg / NXCD, r = nwg % NXCD, xcd = wgid % NXCD, off = wgid / NXCD; wgid = (xcd < r ? xcd * (q + 1) : r * (q + 1) + (xcd - r) * q) + off; }
    const int nig = WGM * nN, gid = wgid / nig, fm = gid * WGM, gsz = (nM - fm) < WGM ? (nM - fm) : WGM;
    pm = fm + ((wgid % nig) % gsz); pn = (wgid % nig) / gsz;
}
struct DenseOrder {
    const char* A; const char* Bt; int nM, nN, G, c; size_t tstep;
    __device__ __forceinline__ void init(const void* A_, const void* Bt_, int M, int N, int K, int G_, int c_) { A = (const char*)A_; Bt = (const char*)Bt_; nM = M / BM; nN = N / BM; G = G_; c = c_; tstep = (size_t)BM * K * 2; }
    __device__ __forceinline__ bool next(int i, Unit& u) const {
        const long L = (long)i * G + c; if (L >= (long)nM * nN) return false;
        tile_of((int)L, nM, nN, u.pm, u.pn); u.A = A + (size_t)u.pm * tstep; u.B = Bt + (size_t)u.pn * tstep; u.e = 0; u.pos0 = 0; return true;
    }
};

__device__ __forceinline__ unsigned cvt_pk_bf16(float lo, float hi) { unsigned r; asm volatile("v_cvt_pk_bf16_f32 %0, %1, %2" : "=v"(r) : "v"(lo), "v"(hi)); return r; }

typedef f32x4 Acc[2][2][4][2];

template <class Epi, class Sched, bool GATHER, bool ALIGN_EPI>
__device__ __forceinline__ void gemm_phase(PG8_LAS unsigned char* lds, const int K, const Sched& S, const Epi& E) {
    const int tid = threadIdx.x, wid = __builtin_amdgcn_readfirstlane(tid >> 6), lane = tid & 63, wr = wid >> 2, wc = wid & 3, fr = lane & 15, fq = lane >> 4;
    const int nt = K / BK;
    unsigned voffA[2][2], voffB[2];
    const size_t kstep = (size_t)(BK * 2);
    const size_t hstep = (size_t)HALF * K * 2;
#pragma unroll
    for (int i = 0; i < 2; ++i) { int R, C; stage_rc(tid * 16 + i * 8192, R, C); const int Rb = (R & ~31) + perm32(R & 31);
        voffB[i] = (unsigned)(Rb * K + C) * 2u;
        if (!GATHER) { voffA[0][i] = (unsigned)(R * K + C) * 2u; voffA[1][i] = voffA[0][i] + (unsigned)hstep; } }
    const unsigned ldsw = (unsigned)wid * 1024u;
    const int aoff = lds_byte(wr * 64 + fr, fq * 8), boff = lds_byte(wc * 32 + fr, fq * 8);
#define PG8_SA(b, h) (((b) * 2 + (h)) * HTB)
#define PG8_SB(b, h) ((4 + (b) * 2 + (h)) * HTB)
#define PG8_STAGE(bufoff, gbase, v0, v1) do { \
        __builtin_amdgcn_global_load_lds((const unsigned*)((const char*)(gbase) + (v0)), (PG8_LAS unsigned*)(lds + (bufoff) + ldsw), 16, 0, 0); \
        __builtin_amdgcn_global_load_lds((const unsigned*)((const char*)(gbase) + (v1)), (PG8_LAS unsigned*)(lds + (bufoff) + ldsw + 8192), 16, 0, 0); } while (0)
#define PG8_STAGE_B(bufoff, gbase) PG8_STAGE(bufoff, gbase, voffB[0], voffB[1])
#define PG8_STAGE_A(bufoff, gbase, h) PG8_STAGE(bufoff, gbase, voffA[h][0], voffA[h][1])
#define PG8_LDA(dst, b, h) do { _Pragma("unroll") for (int m = 0; m < 4; ++m) _Pragma("unroll") for (int k = 0; k < 2; ++k) dst[m][k] = *(const PG8_LAS bf16x8*)(lds + PG8_SA(b, h) + aoff + m * 2048 + k * 1024); } while (0)
#define PG8_LDB(dst, b, h) do { _Pragma("unroll") for (int n = 0; n < 2; ++n) _Pragma("unroll") for (int k = 0; k < 2; ++k) dst[n][k] = *(const PG8_LAS bf16x8*)(lds + PG8_SB(b, h) + boff + n * 2048 + k * 1024); } while (0)
#define PG8_MMA(ai, bj, At, Bt) do { __builtin_amdgcn_s_setprio(1); _Pragma("unroll") for (int m = 0; m < 4; ++m) _Pragma("unroll") for (int n = 0; n < 2; ++n) _Pragma("unroll") for (int k = 0; k < 2; ++k) \
        acc[ai][bj][m][n] = __builtin_amdgcn_mfma_f32_16x16x32_bf16(Bt[n][k], At[m][k], acc[ai][bj][m][n], 0, 0, 0); __builtin_amdgcn_s_setprio(0); } while (0)
#define PG8_WAIT_V(n) asm volatile("s_waitcnt vmcnt(" #n ")" ::: "memory")
#define PG8_WAIT_L(n) asm volatile("s_waitcnt lgkmcnt(" #n ")" ::: "memory")
#define PG8_BAR __builtin_amdgcn_s_barrier()
#define PG8_SCHED __builtin_amdgcn_sched_barrier(0)
    Unit cur, nxt; int ui = 0;
    if (!S.next(0, cur)) return;
    Acc acc;
#pragma unroll
    for (int a = 0; a < 2; ++a)
#pragma unroll
        for (int b = 0; b < 2; ++b)
#pragma unroll
            for (int m = 0; m < 4; ++m)
#pragma unroll
                for (int n = 0; n < 2; ++n) acc[a][b][m][n] = (f32x4){0.f, 0.f, 0.f, 0.f};
    bf16x8 At[4][2], B0[2][2], B1[2][2];
    const char* cA = cur.A; const char* cB = cur.B;
    if constexpr (GATHER) S.rows(cur, voffA);
    PG8_STAGE_B(PG8_SB(0, 0), cB); PG8_STAGE_B(PG8_SB(0, 1), cB + hstep); PG8_STAGE_A(PG8_SA(0, 0), cA, 0); PG8_STAGE_A(PG8_SA(0, 1), cA, 1);
    if (wr == 1) PG8_BAR;
    PG8_WAIT_V(2); PG8_BAR;
    PG8_STAGE_B(PG8_SB(1, 0), cB + kstep); PG8_STAGE_A(PG8_SA(1, 0), cA + kstep, 0); PG8_STAGE_B(PG8_SB(1, 1), cB + hstep + kstep);
    PG8_WAIT_V(6); PG8_BAR;
    for (;;) {
        const bool has_next = S.next(ui + 1, nxt);
        const char* nA = has_next ? nxt.A : cA; const char* nB = has_next ? nxt.B : cB;
        for (int t = 0; t < nt; t += 2) {
            const bool last = (t == nt - 2);
            const char* a1 = cA + (size_t)(t + 1) * kstep;
            const char* a2 = last ? nA : cA + (size_t)(t + 2) * kstep; const char* b2 = last ? nB : cB + (size_t)(t + 2) * kstep;
            const char* a3 = a2 + kstep; const char* b3 = b2 + kstep;
            PG8_LDB(B0, 0, 0); PG8_LDB(B1, 0, 1); PG8_SCHED; PG8_LDA(At, 0, 0); PG8_STAGE_A(PG8_SA(1, 1), a1, 1);
            if constexpr (GATHER) { if (last && has_next) S.rows(nxt, voffA); }
            PG8_WAIT_V(8); PG8_WAIT_L(0); PG8_BAR; PG8_MMA(0, 0, At, B0); PG8_MMA(0, 1, At, B1); PG8_BAR; PG8_SCHED;
            PG8_LDA(At, 0, 1); PG8_STAGE_B(PG8_SB(0, 0), b2); PG8_STAGE_B(PG8_SB(0, 1), b2 + hstep); PG8_STAGE_A(PG8_SA(0, 0), a2, 0);
            PG8_WAIT_V(8); PG8_WAIT_L(0); PG8_BAR; PG8_MMA(1, 0, At, B0); PG8_MMA(1, 1, At, B1); PG8_BAR; PG8_SCHED;
            PG8_LDB(B0, 1, 0); PG8_LDB(B1, 1, 1); PG8_SCHED; PG8_LDA(At, 1, 0); PG8_STAGE_A(PG8_SA(0, 1), a2, 1);
            PG8_WAIT_V(8); PG8_WAIT_L(0); PG8_BAR; PG8_MMA(0, 0, At, B0); PG8_MMA(0, 1, At, B1); PG8_BAR; PG8_SCHED;
            PG8_LDA(At, 1, 1); PG8_STAGE_B(PG8_SB(1, 0), b3); PG8_STAGE_B(PG8_SB(1, 1), b3 + hstep); PG8_STAGE_A(PG8_SA(1, 0), a3, 0);
            PG8_WAIT_V(8); PG8_WAIT_L(0); PG8_BAR; PG8_MMA(1, 0, At, B0); PG8_MMA(1, 1, At, B1); PG8_BAR; PG8_SCHED;
        }
        if constexpr (ALIGN_EPI) { if (wr == 0) PG8_BAR; }
        E(acc, cur, wr, wc, fr, fq);
        if (!has_next) break;
#pragma unroll
        for (int a = 0; a < 2; ++a)
#pragma unroll
            for (int b = 0; b < 2; ++b)
#pragma unroll
                for (int m = 0; m < 4; ++m)
#pragma unroll
                    for (int n = 0; n < 2; ++n) acc[a][b][m][n] = (f32x4){0.f, 0.f, 0.f, 0.f};
        cur = nxt; cA = nA; cB = nB; ++ui;
        if constexpr (ALIGN_EPI) { if (wr == 1) PG8_BAR; }
    }
    PG8_WAIT_V(0);
    if constexpr (!ALIGN_EPI) { if (wr == 0) PG8_BAR; }
    PG8_BAR;
#undef PG8_SA
#undef PG8_SB
#undef PG8_STAGE
#undef PG8_STAGE_A
#undef PG8_STAGE_B
#undef PG8_LDA
#undef PG8_LDB
#undef PG8_MMA
#undef PG8_WAIT_V
#undef PG8_WAIT_L
#undef PG8_BAR
#undef PG8_SCHED
}
}
constexpr int NWAVES = 8;
constexpr int RING_OFF = 0, RING_BYTES = 131072;
constexpr int MOE_OFF = RING_BYTES;
constexpr int LDSCTL_OFF = MOE_OFF + 512, MISC_OFF = LDSCTL_OFF + 320;
constexpr int LDS_BYTES = 163840;
static_assert(MISC_OFF + 128 <= LDS_BYTES, "LDS map");

#define GAS __attribute__((address_space(1)))
#define LAS __attribute__((address_space(3)))
typedef GAS unsigned gu32;
#define RLX_AGENT __ATOMIC_RELAXED, __HIP_MEMORY_SCOPE_AGENT
#define LDS_WAIT() asm volatile("s_waitcnt lgkmcnt(0)" ::: "memory")
#define VM_WAIT() asm volatile("s_waitcnt vmcnt(0)" ::: "memory")

#define XB_TMO      128
#define XB_XCNT(j)  (256  + 64 * (j))
#define XB_XSUB(j)  (1280 + 64 * (j))
#define XB_XGEN(j)  (2304 + 64 * (j))
#define XB_TOP      3328
#define XB_TOPGEN   3392
#define XCD_BAR_WORDS 3456
#define XB_SPIN_CAP (1u << 18)
__device__ __forceinline__ unsigned xb_ld(unsigned* p)              { return __hip_atomic_load(p, __ATOMIC_RELAXED, __HIP_MEMORY_SCOPE_AGENT); }
__device__ __forceinline__ unsigned xb_add(unsigned* p, unsigned v) { return __hip_atomic_fetch_add(p, v, __ATOMIC_RELAXED, __HIP_MEMORY_SCOPE_AGENT); }
__device__ __forceinline__ unsigned xb_xcc_id() { return (unsigned)__builtin_amdgcn_s_getreg((3 << 11) | 20) & 0xFu; }
#define XB_SPIN(cond, bar) do { unsigned _sp = 0; while (cond) { __builtin_amdgcn_s_sleep(1); \
    if ((++_sp & 255u) == 0u) { if (xb_ld(&(bar)[XB_TMO])) break; if (_sp > XB_SPIN_CAP) { atomicAdd(&(bar)[XB_TMO], 1u); break; } } } } while (0)
struct XcdBarrier { unsigned* bar; unsigned x; volatile LAS unsigned* st; };
__device__ __forceinline__ XcdBarrier xcd_barrier_post(unsigned* bar, volatile LAS unsigned* st) {
    XcdBarrier b; b.bar = bar; b.x = xb_xcc_id(); b.st = st;
    if (threadIdx.x == 0) (void)xb_add(&bar[XB_XCNT(b.x)], 1u);
    return b;
}
__device__ __forceinline__ void xcd_barrier_complete(unsigned* bar, unsigned x, unsigned& nloc, unsigned& nx) {
    const unsigned G = gridDim.x * gridDim.y * gridDim.z;
    unsigned sum, cnt, mine, sp = 0u;
    for (;;) {
        sum = 0u; cnt = 0u; mine = 0u;
#pragma unroll
        for (unsigned j = 0; j < 16; ++j) { const unsigned c = xb_ld(&bar[XB_XCNT(j)]); sum += c; cnt += (c > 0u) ? 1u : 0u; mine = (j == x) ? c : mine; }
        if (sum == G) break;
        __builtin_amdgcn_s_sleep(1);
        if ((++sp & 255u) == 0u) { if (xb_ld(&bar[XB_TMO])) break; if (sp > XB_SPIN_CAP) { atomicAdd(&bar[XB_TMO], 1u); break; } }
    }
    nloc = mine > 0u ? mine : 1u; nx = cnt > 0u ? cnt : 1u;
}
__device__ __forceinline__ void xcd_barrier(const XcdBarrier& b) {
    asm volatile("s_waitcnt vmcnt(0)" ::: "memory");
    __syncthreads();
    if (threadIdx.x == 0) {
        unsigned* bar = b.bar;
        __builtin_amdgcn_s_waitcnt(0);
        unsigned nloc = b.st[0], nx = b.st[1];
        if (nloc == 0u) { xcd_barrier_complete(bar, b.x, nloc, nx); b.st[0] = nloc; b.st[1] = nx; }
        const unsigned old = xb_add(&bar[XB_XSUB(b.x)], 1u);
        const unsigned gen = old / nloc;
        if (old + 1u == (gen + 1u) * nloc) {
            __builtin_amdgcn_fence(__ATOMIC_RELEASE, "agent");
            asm volatile("s_waitcnt vmcnt(0)" ::: "memory");
            const unsigned og = xb_add(&bar[XB_TOP], 1u);
            const unsigned tg = og / nx;
            if (og + 1u == (tg + 1u) * nx) xb_add(&bar[XB_TOPGEN], 1u);
            else XB_SPIN(xb_ld(&bar[XB_TOPGEN]) == tg, bar);
            __builtin_amdgcn_fence(__ATOMIC_ACQUIRE, "agent");
            xb_add(&bar[XB_XGEN(b.x)], 1u);
            asm volatile("s_waitcnt vmcnt(0)" ::: "memory");
        } else {
            XB_SPIN(xb_ld(&bar[XB_XGEN(b.x)]) == gen, bar);
            __builtin_amdgcn_fence(__ATOMIC_ACQUIRE, "agent");
            asm volatile("s_waitcnt vmcnt(0)" ::: "memory");
        }
    }
    __syncthreads();
}

struct Frame {
    LAS unsigned char* lds;
    volatile LAS unsigned* MISC;
    gu32* ctl;
    int tid, lane, wave;
    int vcu, G;
    const float *x, *norm_mix, *w_in, *b_in, *conv_w, *q_norm, *k_norm, *sinks, *rel_bias, *on_conv, *on_attn, *w_out, *b_out, *norm_ffn, *w_router, *b_router, *w1, *b1, *w2, *b2;
    float* out;
    bf16 *WinT, *WoutT, *W1T, *W2T, *WR;
    float *B1S, *rstd, *gate, *rsl;
    unsigned* dest;
    bf16 *xn, *proj, *mix, *x1b, *act_lo, *act_hi, *ys;
};

struct EpiIn {
    bf16* O; const float* bias;
    __device__ __forceinline__ void operator()(const pg8::Acc& acc, const pg8::Unit& u, int wr, int wc, int fr, int fq) const {
        const int row0 = u.pm * 256 + wr * 64 + fr, col0 = u.pn * 256 + wc * 32 + 8 * fq;
        f32x4 bv[2][2];
#pragma unroll
        for (int bj = 0; bj < 2; ++bj)
#pragma unroll
            for (int n = 0; n < 2; ++n) bv[bj][n] = *(const f32x4*)(bias + col0 + bj * 128 + 4 * n);
#pragma unroll
        for (int ai = 0; ai < 2; ++ai)
#pragma unroll
            for (int m = 0; m < 4; ++m) { bf16* rowp = O + (size_t)(row0 + ai * 128 + m * 16) * INW + col0;
#pragma unroll
                for (int bj = 0; bj < 2; ++bj) { const f32x4 v0 = acc[ai][bj][m][0] + bv[bj][0], v1 = acc[ai][bj][m][1] + bv[bj][1];
                    v4u w; w.x = pg8::cvt_pk_bf16(v0[0], v0[1]); w.y = pg8::cvt_pk_bf16(v0[2], v0[3]); w.z = pg8::cvt_pk_bf16(v1[0], v1[1]); w.w = pg8::cvt_pk_bf16(v1[2], v1[3]);
                    *(v4u*)(rowp + bj * 128) = w; } }
    }
};
struct EpiOut {
    bf16* O; const float* bias; const float* x;
    __device__ __forceinline__ void operator()(const pg8::Acc& acc, const pg8::Unit& u, int wr, int wc, int fr, int fq) const {
        const int row0 = u.pm * 256 + wr * 64 + fr, col0 = u.pn * 256 + wc * 32 + 8 * fq;
        f32x4 bv[2][2];
#pragma unroll
        for (int bj = 0; bj < 2; ++bj)
#pragma unroll
            for (int n = 0; n < 2; ++n) bv[bj][n] = *(const f32x4*)(bias + col0 + bj * 128 + 4 * n);
#pragma unroll
        for (int ai = 0; ai < 2; ++ai)
#pragma unroll
            for (int m = 0; m < 4; ++m) { const size_t off = (size_t)(row0 + ai * 128 + m * 16) * D + col0;
#pragma unroll
                for (int bj = 0; bj < 2; ++bj) { const f32x4 x0 = *(const f32x4*)(x + off + bj * 128), x1 = *(const f32x4*)(x + off + bj * 128 + 4);
                    const f32x4 v0 = acc[ai][bj][m][0] + bv[bj][0] + x0, v1 = acc[ai][bj][m][1] + bv[bj][1] + x1;
                    v4u w; w.x = pg8::cvt_pk_bf16(v0[0], v0[1]); w.y = pg8::cvt_pk_bf16(v0[2], v0[3]); w.z = pg8::cvt_pk_bf16(v1[0], v1[1]); w.w = pg8::cvt_pk_bf16(v1[2], v1[3]);
                    *(v4u*)(O + off + bj * 128) = w; }
                asm volatile("" ::: "memory"); }
    }
};
template <bool GATHER> struct MoeOrder {
    const char* Abase; const char* act_lo; const char* act_hi; const char* Bt; size_t bstride_e, tstepB;
    int nN, G, c, NT; const LAS int* tile0; const LAS int* ecnt; const unsigned* dest;
    __device__ __forceinline__ bool next(int i, pg8::Unit& u) const {
        const long L = (long)i * G + c; if (L >= (long)NT * nN) return false;
        pg8::tile_of((int)L, NT, nN, u.pm, u.pn);
        int e = 0;
#pragma unroll
        for (int st = 16; st >= 1; st >>= 1) if (tile0[e + st] <= u.pm) e += st;
        u.e = e; u.pos0 = (u.pm - tile0[e]) * 256;
        u.B = Bt + (size_t)e * bstride_e + (size_t)u.pn * tstepB;
        u.A = GATHER ? Abase : (u.pm < ACT_LO_TILES ? act_lo + (size_t)u.pm * (256 * DFF * 2) : act_hi + (size_t)(u.pm - ACT_LO_TILES) * (256 * DFF * 2));
        return true;
    }
    __device__ __forceinline__ void rows(const pg8::Unit& u, unsigned (&voff)[2][2]) const {
        const int n = ecnt[u.e];
        int tz = threadIdx.x; asm volatile("" : "+v"(tz));
#pragma unroll
        for (int i = 0; i < 2; ++i) { int R, C; pg8::stage_rc(tz * 16 + i * 8192, R, C);
#pragma unroll
            for (int h = 0; h < 2; ++h) { const int pos = u.pos0 + h * 128 + R; unsigned tok = 0u; if (pos < n) tok = dest[(size_t)u.e * T + pos] >> 2; voff[h][i] = tok * (unsigned)(D * 2) + (unsigned)(C * 2); } }
    }
};
struct EpiW1 {
    bf16* act_lo; bf16* act_hi; const float* b1s; const float* rsl; const LAS int* ecnt;
    __device__ __forceinline__ void operator()(const pg8::Acc& acc, const pg8::Unit& u, int wr, int wc, int fr, int fq) const {
        const int n = ecnt[u.e]; const int acol = u.pn * 128 + wc * 32 + 8 * fq;
        bf16* const abase = (u.pm < ACT_LO_TILES ? act_lo + (size_t)u.pm * (256 * DFF) : act_hi + (size_t)(u.pm - ACT_LO_TILES) * (256 * DFF)) + acol;
        const float* bg = b1s + (size_t)u.e * 2 * DFF + acol; const float* bl = bg + DFF;
        const f32x4 bg0 = *(const f32x4*)bg, bg1 = *(const f32x4*)(bg + 4), bl0 = *(const f32x4*)bl, bl1 = *(const f32x4*)(bl + 4);
#pragma unroll
        for (int ai = 0; ai < 2; ++ai)
#pragma unroll
            for (int m = 0; m < 4; ++m) { const int r = ai * 128 + wr * 64 + m * 16 + fr; const float s = (u.pos0 + r) < n ? rsl[(size_t)u.e * T + u.pos0 + r] : 0.f;
                const f32x4 g0 = acc[ai][0][m][0] * s + bg0, g1 = acc[ai][0][m][1] * s + bg1, l0 = acc[ai][1][m][0] * s + bl0, l1 = acc[ai][1][m][1] * s + bl1;
                v4u w; w.x = pg8::cvt_pk_bf16(swiglu(g0[0], l0[0]), swiglu(g0[1], l0[1])); w.y = pg8::cvt_pk_bf16(swiglu(g0[2], l0[2]), swiglu(g0[3], l0[3]));
                w.z = pg8::cvt_pk_bf16(swiglu(g1[0], l1[0]), swiglu(g1[1], l1[1])); w.w = pg8::cvt_pk_bf16(swiglu(g1[2], l1[2]), swiglu(g1[3], l1[3]));
                *(v4u*)(abase + (size_t)r * DFF) = w; }
    }
};
struct EpiW2 {
    bf16* ys; const float* b2; const unsigned* dest; const LAS int* ecnt;
    __device__ __forceinline__ void operator()(const pg8::Acc& acc, const pg8::Unit& u, int wr, int wc, int fr, int fq) const {
        const int n = ecnt[u.e]; const int col0 = u.pn * 256 + wc * 32 + 8 * fq;
        f32x4 bv[2][2];
#pragma unroll
        for (int bj = 0; bj < 2; ++bj)
#pragma unroll
            for (int nn = 0; nn < 2; ++nn) bv[bj][nn] = *(const f32x4*)(b2 + (size_t)u.e * D + col0 + bj * 128 + 4 * nn);
        int dd[2][4];
#pragma unroll
        for (int ai = 0; ai < 2; ++ai)
#pragma unroll
            for (int m = 0; m < 4; ++m) { const int pos = u.pos0 + ai * 128 + wr * 64 + m * 16 + fr; dd[ai][m] = pos < n ? (int)dest[(size_t)u.e * T + pos] : -1; }
#pragma unroll
        for (int ai = 0; ai < 2; ++ai)
#pragma unroll
            for (int m = 0; m < 4; ++m) { if (dd[ai][m] >= 0) { bf16* rowp = ys + (size_t)dd[ai][m] * D + col0;
#pragma unroll
                for (int bj = 0; bj < 2; ++bj) { const f32x4 v0 = acc[ai][bj][m][0] + bv[bj][0], v1 = acc[ai][bj][m][1] + bv[bj][1];
                    v4u w; w.x = pg8::cvt_pk_bf16(v0[0], v0[1]); w.y = pg8::cvt_pk_bf16(v0[2], v0[3]); w.z = pg8::cvt_pk_bf16(v1[0], v1[1]); w.w = pg8::cvt_pk_bf16(v1[2], v1[3]);
                    *(v4u*)(rowp + bj * 128) = w; } } }
    }
};

template <bool MAP1>
__device__ __forceinline__ void p0_transpose_item(const float* W, int K, int N, bf16* WT, const float* gain, LAS float* scr, int item, int lane) {
    const int nblk = N / 32, kb = item / nblk, nb = item % nblk, k0 = 64 * kb, n0 = 32 * nb;
#pragma unroll 8
    for (int i = 0; i < 32; ++i) { const int kk = 2 * i + (lane >> 5); scr[kk * 33 + (lane & 31)] = W[(size_t)(k0 + kk) * N + n0 + (lane & 31)]; }
    LDS_WAIT(); asm volatile("" ::: "memory");
    const int c = lane & 7;
    float gk[8];
#pragma unroll
    for (int j = 0; j < 8; ++j) gk[j] = gain ? gain[k0 + 8 * c + j] : 1.0f;
#pragma unroll
    for (int j = 0; j < 4; ++j) { const int nl = (lane >> 3) + 8 * j; const LAS float* s = scr + (8 * c) * 33 + nl;
        int n = n0 + nl; if (MAP1) { const int a = n >> 1; n = 256 * (a >> 7) + 128 * (n & 1) + (a & 127); }
        v4u o; o.x = pk2(s[0 * 33] * gk[0], s[1 * 33] * gk[1]); o.y = pk2(s[2 * 33] * gk[2], s[3 * 33] * gk[3]); o.z = pk2(s[4 * 33] * gk[4], s[5 * 33] * gk[5]); o.w = pk2(s[6 * 33] * gk[6], s[7 * 33] * gk[7]);
        *(GAS v4u*)(WT + (size_t)n * K + k0 + 8 * c) = o; }
    LDS_WAIT(); asm volatile("" ::: "memory");
}
__device__ __forceinline__ void p0_prologue(Frame& F) {
    LAS float* scr = (LAS float*)(F.lds + RING_OFF + F.wave * 16384);
    const int gw = F.vcu * NWAVES + F.wave, NGW = F.G * NWAVES;
    constexpr int I_IN = (D / 64) * (INW / 32), I_OUT = (D / 64) * (D / 32), I_1 = (D / 64) * (2 * DFF / 32), I_2 = (DFF / 64) * (D / 32);
    constexpr int NITEMS = I_IN + I_OUT + NEXP * (I_1 + I_2);
    for (int it = gw; it < NITEMS; it += NGW) {
        int r = it;
        if (r < I_IN) { p0_transpose_item<false>(F.w_in, D, INW, F.WinT, nullptr, scr, r, F.lane); continue; } r -= I_IN;
        if (r < I_OUT) { p0_transpose_item<false>(F.w_out, D, D, F.WoutT, nullptr, scr, r, F.lane); continue; } r -= I_OUT;
        if (r < NEXP * I_1) { const int e = r / I_1; p0_transpose_item<true>(F.w1 + (size_t)e * D * 2 * DFF, D, 2 * DFF, F.W1T + (size_t)e * 2 * DFF * D, F.norm_ffn, scr, r % I_1, F.lane); continue; } r -= NEXP * I_1;
        { const int e = r / I_2; p0_transpose_item<false>(F.w2 + (size_t)e * DFF * D, DFF, D, F.W2T + (size_t)e * D * DFF, nullptr, scr, r % I_2, F.lane); }
    }
    const int gt = F.vcu * (NWAVES * 64) + F.tid, NGT = F.G * NWAVES * 64;
    for (int i = gt; i < NEXP * D; i += NGT) { const int e = i / D, k = i % D; const float v = F.norm_ffn[k] * F.w_router[(size_t)k * NEXP + e]; const unsigned hi = f2bf(v); const float lo = v - bf2f((bf16)hi);
        F.WR[i] = (bf16)hi; F.WR[NEXP * D + i] = (bf16)f2bf(lo); }
    for (int i = gt; i < NEXP * 2 * DFF; i += NGT) { const int e = i / (2 * DFF), c = i % (2 * DFF); F.B1S[(size_t)e * 2 * DFF + (c & 1) * DFF + (c >> 1)] = F.b1[i]; }
    {
        f32x4 gv[4];
#pragma unroll
        for (int j = 0; j < 4; ++j) gv[j] = *((const f32x4*)F.norm_mix + F.lane + 64 * j);
        for (int m = gw; m < T; m += NGW) {
            const GAS f32x4* xr = (const GAS f32x4*)(F.x + (size_t)m * D) + F.lane;
            f32x4 v[4]; float s = 0.f;
#pragma unroll
            for (int j = 0; j < 4; ++j) { v[j] = xr[64 * j]; s += (v[j].x * v[j].x + v[j].y * v[j].y) + (v[j].z * v[j].z + v[j].w * v[j].w); }
            const float rstd = 1.f / sqrtf(wave_sum(s) * (1.f / D) + EPS);
            GAS unsigned long long* o8 = (GAS unsigned long long*)(F.xn + (size_t)m * D) + F.lane;
#pragma unroll
            for (int j = 0; j < 4; ++j) o8[64 * j] = (unsigned long long)pk2(v[j].x * rstd * gv[j].x, v[j].y * rstd * gv[j].y) | ((unsigned long long)pk2(v[j].z * rstd * gv[j].z, v[j].w * rstd * gv[j].w) << 32);
        }
    }
}
__device__ __forceinline__ int moe_tables(Frame& F) {
    LAS int* tile0 = (LAS int*)(F.lds + MOE_OFF); LAS int* ecnt = tile0 + 40;
    if (F.tid < NEXP) ecnt[F.tid] = (int)__hip_atomic_load(F.ctl + CW_CNT + F.tid, RLX_AGENT);
    __syncthreads();
    if (F.tid == 0) { int a = 0; for (int e = 0; e < NEXP; ++e) { tile0[e] = a; a += (ecnt[e] + 255) >> 8; } tile0[NEXP] = a; }
    __syncthreads();
    return tile0[NEXP];
}
constexpr float LOG2E = 1.4426950408889634f;
__device__ __forceinline__ void unpack8(const v4u& w, float (&f)[8]) {
    f[0] = bflo(w.x); f[1] = bfhi(w.x); f[2] = bflo(w.y); f[3] = bfhi(w.y); f[4] = bflo(w.z); f[5] = bfhi(w.z); f[6] = bflo(w.w); f[7] = bfhi(w.w);
}
__device__ __forceinline__ v4u pack8(const float (&f)[8]) {
    v4u w; w.x = pg8::cvt_pk_bf16(f[0], f[1]); w.y = pg8::cvt_pk_bf16(f[2], f[3]); w.z = pg8::cvt_pk_bf16(f[4], f[5]); w.w = pg8::cvt_pk_bf16(f[6], f[7]); return w;
}

__device__ __forceinline__ void p2_conv(Frame& F) {
    const int gw = F.vcu * NWAVES + F.wave, NGW = F.G * NWAVES, c0 = 8 * F.lane;
    float w0[8], w1[8], w2[8], gg[8];
#pragma unroll
    for (int j = 0; j < 8; ++j) { w0[j] = F.conv_w[c0 + j]; w1[j] = F.conv_w[CONVW + c0 + j]; w2[j] = F.conv_w[2 * CONVW + c0 + j]; gg[j] = F.on_conv[c0 + j]; }
    for (int item = gw; item < T / 16; item += NGW) {
        const int t0 = item * 16, s0 = t0 % SEQ;
        float cu1[8], cu2[8];
#pragma unroll
        for (int j = 0; j < 8; ++j) { cu1[j] = 0.f; cu2[j] = 0.f; }
        if (s0 > 0) {
            const bf16* p = F.proj + (size_t)(t0 - 2) * INW + c0;
            const v4u ca = *(const v4u*)(p + CONVW), ua = *(const v4u*)(p + 2 * CONVW), cb = *(const v4u*)(p + INW + CONVW), ub = *(const v4u*)(p + INW + 2 * CONVW);
            float a[8], b[8]; unpack8(ca, a); unpack8(ua, b);
#pragma unroll
            for (int j = 0; j < 8; ++j) cu2[j] = a[j] * b[j];
            unpack8(cb, a); unpack8(ub, b);
#pragma unroll
            for (int j = 0; j < 8; ++j) cu1[j] = a[j] * b[j];
        }
#pragma unroll 1
        for (int tt = 0; tt < 16; tt += 4) {
            v4u bb[4], cc[4], uu[4];
#pragma unroll
            for (int q = 0; q < 4; ++q) { const bf16* p = F.proj + (size_t)(t0 + tt + q) * INW + c0; bb[q] = *(const v4u*)p; cc[q] = *(const v4u*)(p + CONVW); uu[q] = *(const v4u*)(p + 2 * CONVW); }
#pragma unroll
            for (int q = 0; q < 4; ++q) {
                float b[8], c[8], u[8], y[8]; unpack8(bb[q], b); unpack8(cc[q], c); unpack8(uu[q], u);
                float ss = 0.f;
#pragma unroll
                for (int j = 0; j < 8; ++j) { const float cu0 = c[j] * u[j]; y[j] = b[j] * (w2[j] * cu0 + w1[j] * cu1[j] + w0[j] * cu2[j]); ss += y[j] * y[j]; cu2[j] = cu1[j]; cu1[j] = cu0; }
                const float rstd = 1.f / sqrtf(wave_sum(ss) * (1.f / CONVW) + EPS);
#pragma unroll
                for (int j = 0; j < 8; ++j) y[j] = y[j] * rstd * gg[j];
                *(v4u*)(F.mix + (size_t)(t0 + tt + q) * D + c0) = pack8(y);
            }
        }
    }
}

constexpr int KS_STRIDE = 144, VT_STRIDE = 528, KS_OFF = 0, VT_OFF = 256 * KS_STRIDE, BT_OFF = VT_OFF + 64 * VT_STRIDE, ATTN_LDS = BT_OFF + 8 * 128 * 4;
static_assert(ATTN_LDS <= RING_BYTES, "attention LDS");
__device__ __forceinline__ void p2_attn(Frame& F) {
    LAS unsigned char* KS = F.lds + KS_OFF; LAS unsigned char* VT = F.lds + VT_OFF; LAS float* BT = (LAS float*)(F.lds + BT_OFF);
    const int lane = F.lane, c = lane & 15, g = lane >> 4, w = F.wave, sub = lane & 7, grp = lane >> 3;
    for (int i = F.tid; i < 8 * 128; i += NWAVES * 64) BT[i] = F.rel_bias[T5B[i & 127] * NQH + (i >> 7)] * LOG2E;
    float kg8[8];
#pragma unroll
    for (int j = 0; j < 8; ++j) kg8[j] = F.k_norm[8 * sub + j];
    float qg0[8], qg1[8];
#pragma unroll
    for (int j = 0; j < 8; ++j) { qg0[j] = F.q_norm[8 * g + j]; qg1[j] = F.q_norm[32 + 8 * g + j]; }
    __syncthreads();
    for (int unit = blockIdx.x; unit < T / 128; unit += F.G) {
        const int blk = unit % (SEQ / 128), t0 = unit * 128, tq = t0 + 16 * w + c;
        float ssq = 0.f;
#pragma unroll
        for (int kv = 0; kv < 2; ++kv) {
            __syncthreads();
            {
                v4u kr[4], vr[4];
#pragma unroll
                for (int i = 0; i < 4; ++i) {
                    const int keyk = 32 * w + 8 * i + grp, keyv = 32 * w + 2 * grp + (i & 1) + 16 * (i >> 1);
                    const bool okk = !(blk == 0 && keyk < 128), okv = !(blk == 0 && keyv < 128);
                    kr[i] = (v4u){0u, 0u, 0u, 0u}; vr[i] = (v4u){0u, 0u, 0u, 0u};
                    if (okk) kr[i] = *(const v4u*)(F.proj + (size_t)(t0 - 128 + keyk) * INW + KOFF + 64 * kv + 8 * sub);
                    if (okv) vr[i] = *(const v4u*)(F.proj + (size_t)(t0 - 128 + keyv) * INW + VOFF + 64 * kv + 8 * sub);
                }
#pragma unroll
                for (int i = 0; i < 4; ++i) {
                    float k[8]; unpack8(kr[i], k); float ss = 0.f;
#pragma unroll
                    for (int j = 0; j < 8; ++j) ss += k[j] * k[j];
                    ss += __shfl_xor(ss, 1); ss += __shfl_xor(ss, 2); ss += __shfl_xor(ss, 4);
                    const float r = 1.f / sqrtf(ss * (1.f / HD) + EPS);
#pragma unroll
                    for (int j = 0; j < 8; ++j) k[j] = k[j] * r * kg8[j];
                    *(LAS v4u*)(KS + (32 * w + 8 * i + grp) * KS_STRIDE + sub * 16) = pack8(k);
                }
#pragma unroll
                for (int pp = 0; pp < 2; ++pp) {
                    const v4u a = vr[2 * pp], b = vr[2 * pp + 1]; const unsigned aw[4] = {a.x, a.y, a.z, a.w}, bw[4] = {b.x, b.y, b.z, b.w};
                    const int key0 = 32 * w + 2 * grp + 16 * pp;
#pragma unroll
                    for (int jj = 0; jj < 8; ++jj) {
                        const unsigned word = (jj & 1) ? ((aw[jj >> 1] >> 16) | (bw[jj >> 1] & 0xffff0000u)) : ((aw[jj >> 1] & 0xffffu) | (bw[jj >> 1] << 16));
                        *(LAS unsigned*)(VT + (8 * sub + jj) * VT_STRIDE + key0 * 2) = word;
                    }
                }
            }
            __syncthreads();
#pragma unroll 1
            for (int hh = 0; hh < 4; ++hh) {
                const int h = 4 * kv + hh;
                bf16x8 Q0, Q1;
                {
                    const bf16* qp = F.proj + (size_t)tq * INW + QOFF + 64 * h + 8 * g;
                    const v4u r0 = *(const v4u*)qp, r1 = *(const v4u*)(qp + 32);
                    float a[8], b[8]; unpack8(r0, a); unpack8(r1, b); float ss = 0.f;
#pragma unroll
                    for (int j = 0; j < 8; ++j) ss += a[j] * a[j] + b[j] * b[j];
                    ss += __shfl_xor(ss, 16); ss += __shfl_xor(ss, 32);
                    const float r = (1.f / sqrtf(ss * (1.f / HD) + EPS)) * (0.125f * LOG2E);
#pragma unroll
                    for (int j = 0; j < 8; ++j) { a[j] = a[j] * r * qg0[j]; b[j] = b[j] * r * qg1[j]; }
                    const v4u p0 = pack8(a), p1 = pack8(b); Q0 = __builtin_bit_cast(bf16x8, p0); Q1 = __builtin_bit_cast(bf16x8, p1);
                }
                f32x4 st[9];
#pragma unroll
                for (int kt = 0; kt < 9; ++kt) {
                    const LAS unsigned char* kp = KS + (16 * (w + kt) + c) * KS_STRIDE + g * 16;
                    const bf16x8 k0 = *(const LAS bf16x8*)kp, k1 = *(const LAS bf16x8*)(kp + 64);
                    f32x4 z = (f32x4){0.f, 0.f, 0.f, 0.f};
                    z = __builtin_amdgcn_mfma_f32_16x16x32_bf16(k0, Q0, z, 0, 0, 0);
                    st[kt] = __builtin_amdgcn_mfma_f32_16x16x32_bf16(k1, Q1, z, 0, 0, 0);
                }
                const int relbase = 128 + c - 4 * g;
                const float sk = F.sinks[h] * LOG2E;
                float m = sk;
#pragma unroll
                for (int kt = 0; kt < 9; ++kt)
#pragma unroll
                    for (int j = 0; j < 4; ++j) {
                        const int rel = relbase - 16 * kt - j;
                        bool ok = (rel >= 0) && (rel < 128);
                        if (blk == 0) ok = ok && (16 * (w + kt) + 4 * g + j >= 128);
                        const float v = st[kt][j] + BT[h * 128 + (rel & 127)];
                        st[kt][j] = ok ? v : -INFINITY;
                        m = fmaxf(m, st[kt][j]);
                    }
                m = fmaxf(m, __shfl_xor(m, 16)); m = fmaxf(m, __shfl_xor(m, 32));
                float l = 0.f;
#pragma unroll
                for (int kt = 0; kt < 9; ++kt)
#pragma unroll
                    for (int j = 0; j < 4; ++j) { const float p = __builtin_amdgcn_exp2f(st[kt][j] - m); st[kt][j] = p; l += p; }
                l += __shfl_xor(l, 16); l += __shfl_xor(l, 32);
                l += __builtin_amdgcn_exp2f(sk - m);
                const float inv = 1.f / l;
                bf16x8 P[5];
#pragma unroll
                for (int u = 0; u < 5; ++u) {
                    v4u pw; pw.x = pg8::cvt_pk_bf16(st[2 * u][0], st[2 * u][1]); pw.y = pg8::cvt_pk_bf16(st[2 * u][2], st[2 * u][3]);
                    if (u < 4) { pw.z = pg8::cvt_pk_bf16(st[2 * u + 1][0], st[2 * u + 1][1]); pw.w = pg8::cvt_pk_bf16(st[2 * u + 1][2], st[2 * u + 1][3]); } else { pw.z = 0u; pw.w = 0u; }
                    P[u] = __builtin_bit_cast(bf16x8, pw);
                }
#pragma unroll
                for (int dt = 0; dt < 4; ++dt) {
                    f32x4 o = (f32x4){0.f, 0.f, 0.f, 0.f};
#pragma unroll
                    for (int u = 0; u < 5; ++u) {
                        const LAS unsigned char* vp = VT + (16 * dt + c) * VT_STRIDE + (16 * (w + 2 * u) + 4 * g) * 2;
                        const v2u lo = *(const LAS v2u*)vp; const v2u hi = (u < 4) ? *(const LAS v2u*)(vp + 32) : lo;
                        const v4u vv = (v4u){lo.x, lo.y, hi.x, hi.y};
                        o = __builtin_amdgcn_mfma_f32_16x16x32_bf16(__builtin_bit_cast(bf16x8, vv), P[u], o, 0, 0, 0);
                    }
                    o = o * inv;
                    ssq += (o[0] * o[0] + o[1] * o[1]) + (o[2] * o[2] + o[3] * o[3]);
                    v2u ow; ow.x = pg8::cvt_pk_bf16(o[0], o[1]); ow.y = pg8::cvt_pk_bf16(o[2], o[3]);
                    *(v2u*)(F.mix + (size_t)tq * D + CONVW + 64 * h + 16 * dt + 4 * g) = ow;
                }
            }
        }
        ssq += __shfl_xor(ssq, 16); ssq += __shfl_xor(ssq, 32);
        const float rstd = 1.f / sqrtf(ssq * (1.f / ATTNW) + EPS);
#pragma unroll 1
        for (int h = 0; h < 8; ++h)
#pragma unroll
            for (int dt = 0; dt < 4; ++dt) {
                const f32x4 gv = *(const f32x4*)(F.on_attn + 64 * h + 16 * dt + 4 * g);
                v2u* op = (v2u*)(F.mix + (size_t)tq * D + CONVW + 64 * h + 16 * dt + 4 * g);
                const v2u ow = *op;
                v2u o; o.x = pg8::cvt_pk_bf16(bflo(ow.x) * rstd * gv[0], bfhi(ow.x) * rstd * gv[1]); o.y = pg8::cvt_pk_bf16(bflo(ow.y) * rstd * gv[2], bfhi(ow.y) * rstd * gv[3]);
                *op = o;
            }
    }
    __syncthreads();
}

constexpr int RT_SCR_OFF = 133120, RT_CNT_OFF = RT_SCR_OFF + 8 * 16 * 33 * 4;
static_assert(RT_CNT_OFF + 256 <= LDS_BYTES && RT_SCR_OFF >= MISC_OFF + 128, "router LDS");
__device__ __forceinline__ void p3b_router(Frame& F) {
    const int lane = F.lane, fr = lane & 15, fq = lane >> 4, w = F.wave;
    LAS unsigned char* WL = F.lds;
    LAS float* scr = (LAS float*)(F.lds + RT_SCR_OFF) + w * (16 * 33);
    LAS unsigned* lcnt = (LAS unsigned*)(F.lds + RT_CNT_OFF); LAS unsigned* lbase = lcnt + 32;
    for (int ci = F.tid; ci < 2 * NEXP * 128; ci += NWAVES * 64) { const int row = ci >> 7, ch = ci & 127;
        *(LAS v4u*)(WL + row * 2048 + ((ch ^ (row & 15)) << 4)) = *(const v4u*)(F.WR + (size_t)row * D + ch * 8); }
    for (int chunk = F.vcu; chunk < T / 256; chunk += F.G) {
    if (F.tid < 32) lcnt[F.tid] = 0u;
    __syncthreads();
    int re[2][4]; unsigned rrank[2][4]; float rrs[2];
#pragma unroll
    for (int it = 0; it < 2; ++it) {
        const int tok0 = chunk * 256 + w * 32 + it * 16;
        f32x4 a0 = (f32x4){0.f, 0.f, 0.f, 0.f}, a1 = a0; float ss = 0.f;
        const bf16* xp = F.x1b + (size_t)(tok0 + fr) * D + 8 * fq;
#pragma unroll 1
        for (int s0 = 0; s0 < 32; s0 += 8) {
            v4u xa[8];
#pragma unroll
            for (int s = 0; s < 8; ++s) xa[s] = *(const v4u*)(xp + 32 * (s0 + s));
#pragma unroll
            for (int s = 0; s < 8; ++s) {
                float f[8]; unpack8(xa[s], f);
#pragma unroll
                for (int j = 0; j < 8; ++j) ss += f[j] * f[j];
                const int ch = 4 * (s0 + s) + fq; const bf16x8 av = __builtin_bit_cast(bf16x8, xa[s]);
                const bf16x8 h0 = *(const LAS bf16x8*)(WL + fr * 2048 + ((ch ^ fr) << 4)), h1 = *(const LAS bf16x8*)(WL + (16 + fr) * 2048 + ((ch ^ fr) << 4));
                const bf16x8 l0 = *(const LAS bf16x8*)(WL + (32 + fr) * 2048 + ((ch ^ fr) << 4)), l1 = *(const LAS bf16x8*)(WL + (48 + fr) * 2048 + ((ch ^ fr) << 4));
                a0 = __builtin_amdgcn_mfma_f32_16x16x32_bf16(av, h0, a0, 0, 0, 0); a1 = __builtin_amdgcn_mfma_f32_16x16x32_bf16(av, h1, a1, 0, 0, 0);
                a0 = __builtin_amdgcn_mfma_f32_16x16x32_bf16(av, l0, a0, 0, 0, 0); a1 = __builtin_amdgcn_mfma_f32_16x16x32_bf16(av, l1, a1, 0, 0, 0);
            }
        }
        ss += __shfl_xor(ss, 16); ss += __shfl_xor(ss, 32);
        const float rstd = 1.f / sqrtf(ss * (1.f / D) + EPS);
#pragma unroll
        for (int j = 0; j < 4; ++j) { scr[(4 * fq + j) * 33 + fr] = a0[j]; scr[(4 * fq + j) * 33 + 16 + fr] = a1[j]; }
        LDS_WAIT(); asm volatile("" ::: "memory");
        rrs[it] = rstd;
#pragma unroll
        for (int k = 0; k < 4; ++k) { re[it][k] = 0; rrank[it][k] = 0u; }
        if (lane < 16) {
            const int t = tok0 + lane;
            float lg[NEXP];
#pragma unroll
            for (int e = 0; e < NEXP; ++e) lg[e] = scr[lane * 33 + e] * rstd + F.b_router[e];
            float val[4]; unsigned used = 0u;
#pragma unroll
            for (int k = 0; k < 4; ++k) { int bi = 0; float bv = -INFINITY;
#pragma unroll
                for (int e = 0; e < NEXP; ++e) { const bool tk = !((used >> e) & 1u) && (lg[e] > bv); bv = tk ? lg[e] : bv; bi = tk ? e : bi; }
                re[it][k] = bi; val[k] = bv; used |= 1u << bi; }
            float pe[4], den = 0.f;
#pragma unroll
            for (int k = 0; k < 4; ++k) { pe[k] = __expf(val[k] - val[0]); den += pe[k]; }
            const float id = 1.f / den;
            *(f32x4*)(F.gate + (size_t)t * 4) = (f32x4){pe[0] * id, pe[1] * id, pe[2] * id, pe[3] * id};
            F.rstd[t] = rstd;
#pragma unroll
            for (int k = 0; k < 4; ++k) rrank[it][k] = __hip_atomic_fetch_add(lcnt + re[it][k], 1u, __ATOMIC_RELAXED, __HIP_MEMORY_SCOPE_WORKGROUP);
        }
        LDS_WAIT(); asm volatile("" ::: "memory");
    }
    __syncthreads();
    if (F.tid < 32) lbase[F.tid] = __hip_atomic_fetch_add(F.ctl + CW_CNT + F.tid, lcnt[F.tid], RLX_AGENT);
    __syncthreads();
    if (lane < 16) {
#pragma unroll
        for (int it = 0; it < 2; ++it) { const int t = chunk * 256 + w * 32 + it * 16 + lane;
#pragma unroll
            for (int k = 0; k < 4; ++k) { const size_t p = (size_t)re[it][k] * T + lbase[re[it][k]] + rrank[it][k]; F.dest[p] = (unsigned)(t * 4 + k); F.rsl[p] = rrs[it]; } }
    }
    __syncthreads();
    }
}

__device__ __forceinline__ void p6_combine(Frame& F) {
    const int gw = F.vcu * NWAVES + F.wave, NGW = F.G * NWAVES, lane = F.lane;
    for (int t = gw * 2; t < T; t += NGW * 2) {
        v4u xb[2][2], yv[2][4][2]; f32x4 gt[2];
#pragma unroll
        for (int q = 0; q < 2; ++q) {
            const bf16* xp = F.x1b + (size_t)(t + q) * D + 8 * lane; xb[q][0] = *(const v4u*)xp; xb[q][1] = *(const v4u*)(xp + 512);
            gt[q] = *(const f32x4*)(F.gate + (size_t)(t + q) * 4);
#pragma unroll
            for (int k = 0; k < 4; ++k) { const bf16* yp = F.ys + ((size_t)(t + q) * 4 + k) * D + 8 * lane; yv[q][k][0] = *(const v4u*)yp; yv[q][k][1] = *(const v4u*)(yp + 512); }
        }
#pragma unroll
        for (int q = 0; q < 2; ++q)
#pragma unroll
            for (int hf = 0; hf < 2; ++hf) {
                float o[8]; unpack8(xb[q][hf], o);
#pragma unroll
                for (int k = 0; k < 4; ++k) { float y[8]; unpack8(yv[q][k][hf], y);
#pragma unroll
                    for (int j = 0; j < 8; ++j) o[j] += gt[q][k] * y[j]; }
                float* op = F.out + (size_t)(t + q) * D + 512 * hf + 8 * lane;
                *(f32x4*)op = (f32x4){o[0], o[1], o[2], o[3]}; *(f32x4*)(op + 4) = (f32x4){o[4], o[5], o[6], o[7]};
            }
    }
}
constexpr int N_PHASES = 8;
struct Args { const float* in[20]; float* out; unsigned char* ws; int ph_lo, ph_hi, li, pad; };
__global__ void __launch_bounds__(NWAVES * 64, 2) mega_fwd(Args) {
    extern __shared__ __attribute__((aligned(16))) unsigned char lds[];
    Frame F;
    F.lds = (LAS unsigned char*)lds;
    F.MISC = (volatile LAS unsigned*)(F.lds + MISC_OFF);
    F.tid = threadIdx.x; F.lane = F.tid & 63; F.wave = __builtin_amdgcn_readfirstlane(F.tid >> 6);
    F.G = gridDim.x; { const int bx = blockIdx.x; F.vcu = (F.G % 8 == 0) ? (bx % 8) * (F.G / 8) + bx / 8 : bx; }
    typedef const __attribute__((address_space(4))) unsigned char* kptr_t;
    const kptr_t ka = (kptr_t)__builtin_amdgcn_kernarg_segment_ptr();
#define KIN(k) (*(const float* const __attribute__((address_space(4)))*)(ka + 8 * (k)))
#define KWS() (*(unsigned char* const __attribute__((address_space(4)))*)(ka + 168))
#define KOUT() (*(float* const __attribute__((address_space(4)))*)(ka + 160))
#define KINT(off) (*(const int __attribute__((address_space(4)))*)(ka + (off)))
#define FRAME_PTRS() do { unsigned char* ws = KWS(); \
    F.x = KIN(0); F.norm_mix = KIN(1); F.w_in = KIN(2); F.b_in = KIN(3); F.conv_w = KIN(4); F.q_norm = KIN(5); F.k_norm = KIN(6); F.sinks = KIN(7); \
    F.rel_bias = KIN(8); F.on_conv = KIN(9); F.on_attn = KIN(10); F.w_out = KIN(11); F.b_out = KIN(12); F.norm_ffn = KIN(13); F.w_router = KIN(14); F.b_router = KIN(15); \
    F.w1 = KIN(16); F.b1 = KIN(17); F.w2 = KIN(18); F.b2 = KIN(19); F.out = KOUT(); \
    F.WinT = (bf16*)(ws + WS_WINT); F.WoutT = (bf16*)(ws + WS_WOUTT); F.W1T = (bf16*)(ws + WS_W1T); F.W2T = (bf16*)(ws + WS_W2T); F.WR = (bf16*)(ws + WS_WR); \
    F.B1S = (float*)(ws + WS_B1); F.rstd = (float*)(ws + WS_RSTD); F.gate = (float*)(ws + WS_GATE); F.rsl = (float*)(ws + WS_RSL); F.dest = (unsigned*)(ws + WS_DEST); \
    F.xn = (bf16*)(ws + WS_XN); F.proj = (bf16*)(ws + WS_PROJ); F.mix = (bf16*)(ws + WS_MIX); F.x1b = (bf16*)(ws + WS_X1B); F.act_lo = (bf16*)KOUT(); F.act_hi = (bf16*)(ws + WS_ACTHI); F.ys = (bf16*)(ws + WS_YS); } while (0)
    static_assert(sizeof(Args) == 192 && offsetof(Args, out) == 160 && offsetof(Args, ws) == 168 && offsetof(Args, ph_lo) == 176 && offsetof(Args, li) == 184, "kernarg layout");
    F.ctl = (gu32*)(KWS() + WS_CTL);
    for (int u = F.tid; u < (MISC_OFF + 128 - MOE_OFF) / 4; u += NWAVES * 64) ((LAS unsigned*)(F.lds + MOE_OFF))[u] = 0u;
    __syncthreads();
    XcdBarrier bar = xcd_barrier_post((unsigned*)(F.ctl + CW_BAR) + KINT(184) * XCD_BAR_WORDS, F.MISC + 8);
    const int lo = KINT(176), hi = KINT(180);
#ifndef COMPILE_MASK
#define COMPILE_MASK 0xFF
#endif
#define IN(k) (((COMPILE_MASK >> (k)) & 1) && lo <= (k) && (k) < hi)
#define SEAM(k) do { if (IN(k) && IN((k) + 1)) xcd_barrier(bar); } while (0)

    if (IN(0)) { FRAME_PTRS(); p0_prologue(F); } SEAM(0);
    if (IN(1)) {
        FRAME_PTRS();
        pg8::DenseOrder S; S.init(F.xn, F.WinT, T, INW, D, F.G, (int)blockIdx.x);
        EpiIn E{F.proj, F.b_in};
        pg8::gemm_phase<EpiIn, pg8::DenseOrder, false, true>(F.lds + RING_OFF, D, S, E);
    } SEAM(1);
    if (IN(2)) { FRAME_PTRS(); p2_conv(F); p2_attn(F); } SEAM(2);
    if (IN(3)) {
        FRAME_PTRS();
        pg8::DenseOrder S; S.init(F.mix, F.WoutT, T, D, D, F.G, (int)blockIdx.x);
        EpiOut E{F.x1b, F.b_out, F.x};
        pg8::gemm_phase<EpiOut, pg8::DenseOrder, false, true>(F.lds + RING_OFF, D, S, E);
    } SEAM(3);
    if (IN(4)) { FRAME_PTRS(); p3b_router(F); } SEAM(4);
    if (IN(5)) {
        FRAME_PTRS();
        const int NT = moe_tables(F);
        const LAS int* tile0 = (const LAS int*)(F.lds + MOE_OFF); const LAS int* ecnt = tile0 + 40;
        MoeOrder<true> S{(const char*)F.x1b, nullptr, nullptr, (const char*)F.W1T, (size_t)2 * DFF * D * 2, (size_t)256 * D * 2, 2 * DFF / 256, F.G, (int)blockIdx.x, NT, tile0, ecnt, F.dest};
        EpiW1 E{F.act_lo, F.act_hi, F.B1S, F.rsl, ecnt};
        pg8::gemm_phase<EpiW1, MoeOrder<true>, true, true>(F.lds + RING_OFF, D, S, E);
    } SEAM(5);
    if (IN(6)) {
        FRAME_PTRS();
        const int NT = moe_tables(F);
        const LAS int* tile0 = (const LAS int*)(F.lds + MOE_OFF); const LAS int* ecnt = tile0 + 40;
        MoeOrder<false> S{nullptr, (const char*)F.act_lo, (const char*)F.act_hi, (const char*)F.W2T, (size_t)D * DFF * 2, (size_t)256 * DFF * 2, D / 256, F.G, (int)blockIdx.x, NT, tile0, ecnt, F.dest};
        EpiW2 E{F.ys, F.b2, F.dest, ecnt};
        pg8::gemm_phase<EpiW2, MoeOrder<false>, false, true>(F.lds + RING_OFF, DFF, S, E);
    } SEAM(6);
    if (IN(7)) { FRAME_PTRS(); p6_combine(F); }
#undef IN
#undef SEAM
}

#ifndef FAST_MASK
#define FAST_MASK 0xFF
#endif
extern "C" void kernel_launch(void* const* d_in, const int* in_sizes, int n_in, void* d_out, int out_size, void* d_ws, size_t ws_size, hipStream_t stream) {
    static int grid = 0;
    if (grid == 0) {
        if (n_in != 20 || in_sizes[0] != T * D || out_size != T * D || ws_size < WS_END) { fprintf(stderr, "kernel_launch: unexpected shapes (n_in %d, in0 %d, out %d, ws %zu); nothing launched\n", n_in, n_in > 0 ? in_sizes[0] : -1, out_size, ws_size); grid = -1; return; }
        int dev = 0, cus = 0, per_cu = 0;
        if (hipGetDevice(&dev) != hipSuccess || hipDeviceGetAttribute(&cus, hipDeviceAttributeMultiprocessorCount, dev) != hipSuccess) { grid = -1; return; }
        if (hipFuncSetAttribute((const void*)mega_fwd, hipFuncAttributeMaxDynamicSharedMemorySize, LDS_BYTES) != hipSuccess) { fprintf(stderr, "kernel_launch: hipFuncSetAttribute failed\n"); grid = -1; return; }
        if (hipOccupancyMaxActiveBlocksPerMultiprocessor(&per_cu, (const void*)mega_fwd, NWAVES * 64, LDS_BYTES) != hipSuccess || per_cu < 1) fprintf(stderr, "kernel_launch: note: occupancy query reports %d\n", per_cu);
        (void)hipGetLastError();
        grid = cus;
        if (grid != 256) fprintf(stderr, "kernel_launch: %d CUs (built for 256)\n", grid);
    }
    if (grid < 0) return;
    const float* const* in = (const float* const*)d_in;
    unsigned char* ws = (unsigned char*)d_ws; float* out = (float*)d_out;
    (void)hipMemsetAsync(ws + WS_CTL, 0, CTL_ZERO_BYTES, stream);
    Args a{};
    for (int i = 0; i < 20; ++i) a.in[i] = in[i];
    a.out = out; a.ws = ws;
    unsigned* cnt = (unsigned*)(ws + WS_CTL) + CW_CNT;
    bf16* xn = (bf16*)(ws + WS_XN); bf16* proj = (bf16*)(ws + WS_PROJ); bf16* mix = (bf16*)(ws + WS_MIX); bf16* x1b = (bf16*)(ws + WS_X1B);
    float* rstd = (float*)(ws + WS_RSTD); float* gate = (float*)(ws + WS_GATE); float* rsl = (float*)(ws + WS_RSL); unsigned* dest = (unsigned*)(ws + WS_DEST);
    bf16* act_lo = (bf16*)d_out; bf16* act_hi = (bf16*)(ws + WS_ACTHI); bf16* ys = (bf16*)(ws + WS_YS);
    int li = 0;
    for (int p = 0; p < N_PHASES;) {
        if ((FAST_MASK >> p) & 1) {
            int q = p; while (q < N_PHASES && ((FAST_MASK >> q) & 1)) ++q;
            a.ph_lo = p; a.ph_hi = q; a.li = li++;
            hipLaunchKernelGGL(mega_fwd, dim3(grid), dim3(NWAVES * 64), LDS_BYTES, stream, a);
            p = q; continue;
        }
        switch (p) {
        case 0: a.ph_lo = 0; a.ph_hi = 1; a.li = li++; hipLaunchKernelGGL(mega_fwd, dim3(grid), dim3(NWAVES * 64), LDS_BYTES, stream, a);
                hipLaunchKernelGGL(nv::k_rms_in, dim3(T / 4), dim3(256), 0, stream, in[0], in[1], xn); break;
        case 1: { nv::OpIn op{xn, in[2], in[3], proj, 0, 0}; hipLaunchKernelGGL((nv::k_gemm<nv::OpIn>), dim3(INW / 128, T / 128), dim3(256), 0, stream, op, D); } break;
        case 2: hipLaunchKernelGGL(nv::k_conv, dim3(T), dim3(512), 0, stream, proj, in[4], in[9], mix);
                hipLaunchKernelGGL(nv::k_attn, dim3(T), dim3(512), 0, stream, proj, in[5], in[6], in[7], in[8], in[10], mix); break;
        case 3: { nv::OpOut op{mix, in[11], in[12], in[0], x1b, 0, 0}; hipLaunchKernelGGL((nv::k_gemm<nv::OpOut>), dim3(D / 128, T / 128), dim3(256), 0, stream, op, D); } break;
        case 4: hipLaunchKernelGGL(nv::k_router, dim3(T / 4), dim3(256), 0, stream, x1b, in[13], in[14], in[15], rstd, gate, dest, rsl, cnt); break;
        case 5: { nv::OpW1 op{x1b, in[16], in[17], in[13], rstd, cnt, dest, act_lo, act_hi, 0, 0, 0, 0}; hipLaunchKernelGGL((nv::k_gemm<nv::OpW1>), dim3(2 * DFF / 128, T * 4 / 128 + 64), dim3(256), 0, stream, op, D); } break;
        case 6: { nv::OpW2 op{act_lo, act_hi, in[18], in[19], cnt, dest, ys, 0, 0, 0, 0}; hipLaunchKernelGGL((nv::k_gemm<nv::OpW2>), dim3(D / 128, T * 4 / 128 + 64), dim3(256), 0, stream, op, DFF); } break;
        case 7: hipLaunchKernelGGL(nv::k_combine, dim3(T * D / 256), dim3(256), 0, stream, x1b, ys, gate, out); break;
        }
        ++p;
    }
}
```

```cpp
#include <hip/hip_runtime.h>
#include <cstdio>
#include <cstdint>
#include <cstddef>
#include <cmath>

constexpr int BATCH = 8, SEQ = 8192, D = 1024, T = BATCH * SEQ;
constexpr int HD = 64, CONVW = 512, NQH = 8, NKVH = 2, QPKV = 4, ATTNW = 512, KVW = 128, INW = 2304;
constexpr int NEXP = 32, TOPK = 4, DFF = 1024;
constexpr float EPS = 1e-5f;
constexpr int QOFF = 3 * CONVW, KOFF = QOFF + ATTNW, VOFF = KOFF + KVW;

constexpr size_t MiB = 1u << 20;
constexpr size_t WS_CTL = 0, CTL_ZERO_BYTES = 1 * MiB;
constexpr size_t WS_RSTD = 1 * MiB;
constexpr size_t WS_WR = 1 * MiB + 512 * 1024;
constexpr size_t WS_B1 = 1 * MiB + 768 * 1024;
constexpr size_t WS_GATE = 2 * MiB;
constexpr size_t WS_DEST = 4 * MiB;
constexpr size_t WS_RSL = 12 * MiB;
constexpr size_t WS_W2T = 20 * MiB;
constexpr size_t WS_W1T = 52 * MiB;
constexpr size_t WS_DUMMY = 116 * MiB;
constexpr size_t WS_X1B = 120 * MiB;
constexpr size_t WS_XN = WS_X1B;
constexpr size_t WS_ACT = 248 * MiB;
constexpr size_t WS_MIX = WS_ACT;
constexpr size_t WS_YS = 512 * MiB;
constexpr size_t WS_PROJ = 512 * MiB;
constexpr size_t WS_WINT = 800 * MiB;
constexpr size_t WS_WOUTT = 805 * MiB;
constexpr size_t WS_X1Q = 808 * MiB;
constexpr size_t WS_END = 1024 * MiB;
static_assert(WS_PROJ + (size_t)T * INW * 2 <= WS_WINT && WS_YS + (size_t)T * 4 * D * 2 <= WS_END && WS_ACT + 264 * MiB <= WS_YS && WS_W1T + 64 * MiB <= WS_X1B && WS_W2T + 32 * MiB <= WS_W1T && WS_X1B + 128 * MiB <= WS_ACT && WS_X1Q + 64 * MiB <= WS_END, "ws map");
constexpr float W_SCALE = 32.0f, ACT_SCALE = 4.0f;
constexpr int ACT_LO_TILES = 0;
constexpr int CW_TMO = 0, CW_CODE = 1;
constexpr int CW_CNT = 64;
constexpr int CW_BAR = 4096;

typedef unsigned short bf16;
typedef unsigned v4u __attribute__((ext_vector_type(4)));
typedef unsigned v2u __attribute__((ext_vector_type(2)));
typedef float f32x4 __attribute__((ext_vector_type(4)));
typedef float f32x2 __attribute__((ext_vector_type(2)));
typedef short bf16x8 __attribute__((ext_vector_type(8)));
typedef int i32x4 __attribute__((ext_vector_type(4)));
typedef int i32x8 __attribute__((ext_vector_type(8)));

__device__ __forceinline__ unsigned f2bf(float f) { unsigned u = __builtin_bit_cast(unsigned, f); return (u + 0x7fffu + ((u >> 16) & 1u)) >> 16; }
__device__ __forceinline__ unsigned pk2(float lo, float hi) { return f2bf(lo) | (f2bf(hi) << 16); }
__device__ __forceinline__ float bf2f(bf16 b) { return __builtin_bit_cast(float, (unsigned)b << 16); }
__device__ __forceinline__ float bflo(unsigned w) { return __builtin_bit_cast(float, w << 16); }
__device__ __forceinline__ float bfhi(unsigned w) { return __builtin_bit_cast(float, w & 0xffff0000u); }
__device__ __forceinline__ unsigned pk4_fp8(float a, float b, float c, float d) { int w = 0; w = __builtin_amdgcn_cvt_pk_fp8_f32(a, b, w, false); w = __builtin_amdgcn_cvt_pk_fp8_f32(c, d, w, true); return (unsigned)w; }
__device__ __forceinline__ float wave_sum(float v) {
#pragma unroll
    for (int o = 1; o < 64; o <<= 1) v += __shfl_xor(v, o);
    return v;
}
__device__ __forceinline__ float swiglu(float gl, float ln) {
    gl = fminf(gl, 7.0f); ln = fminf(fmaxf(ln, -7.0f), 7.0f);
    return gl * (1.0f / (1.0f + __expf(-1.702f * gl))) * (ln + 1.0f);
}
__device__ __forceinline__ bf16* act_row(bf16* lo, bf16* hi, int slot) { return slot < ACT_LO_TILES * 256 ? lo + (size_t)slot * DFF : hi + (size_t)(slot - ACT_LO_TILES * 256) * DFF; }
__device__ const unsigned char T5B[128] = {0, 1, 2, 3, 4, 5, 6, 7, 8, 9, 10, 11, 12, 13, 14, 15, 16, 16, 16, 17, 17, 18, 18, 18, 19, 19, 19, 20, 20, 20, 20, 21, 21, 21, 21, 22, 22, 22, 22, 22, 23, 23, 23, 23, 23, 23, 24, 24, 24, 24, 24, 24, 25, 25, 25, 25, 25, 25, 25, 26, 26, 26, 26, 26, 26, 26, 26, 27, 27, 27, 27, 27, 27, 27, 27, 27, 27, 28, 28, 28, 28, 28, 28, 28, 28, 28, 28, 29, 29, 29, 29, 29, 29, 29, 29, 29, 29, 29, 29, 30, 30, 30, 30, 30, 30, 30, 30, 30, 30, 30, 30, 30, 30, 31, 31, 31, 31, 31, 31, 31, 31, 31, 31, 31, 31, 31, 31, 31};
#define FAST_MASK 0xFF
#define REPEAT_MASK 0

namespace nv {

__global__ void __launch_bounds__(256) k_rms_in(const float* __restrict__ x, const float* __restrict__ g, bf16* __restrict__ xn) {
    const int row = blockIdx.x * 4 + (threadIdx.x >> 6), lane = threadIdx.x & 63;
    const float* xr = x + (size_t)row * D;
    float v[16]; float ss = 0.f;
#pragma unroll
    for (int j = 0; j < 16; ++j) { v[j] = xr[lane + 64 * j]; ss += v[j] * v[j]; }
    ss = wave_sum(ss);
    const float rstd = 1.0f / sqrtf(ss * (1.0f / D) + EPS);
#pragma unroll
    for (int j = 0; j < 16; ++j) xn[(size_t)row * D + lane + 64 * j] = (bf16)f2bf(v[j] * rstd * g[lane + 64 * j]);
}

struct TileInfo { int valid; int e; int row0; int nrows; };

template <class Op>
__global__ void __launch_bounds__(256) k_gemm(Op op, int K) {
    __shared__ float As[16][132];
    __shared__ float Bs[16][132];
    const int tid = threadIdx.x, tx = tid & 15, ty = tid >> 4;
    if (!op.setup(blockIdx.y, blockIdx.x)) return;
    float acc[8][8];
#pragma unroll
    for (int i = 0; i < 8; ++i)
#pragma unroll
        for (int j = 0; j < 8; ++j) acc[i][j] = 0.f;
    const int ar = tid >> 1, ah = tid & 1;
    const bf16* arow = op.a_row(ar);
    const float* wcol = op.w_base() + (tid & 15) * 8;
    const int wk = tid >> 4;
    for (int k0 = 0; k0 < K; k0 += 16) {
        uint4 av = *(const uint4*)(arow + k0 + ah * 8);
        const unsigned aw[4] = {av.x, av.y, av.z, av.w};
#pragma unroll
        for (int j = 0; j < 4; ++j) {
            As[ah * 8 + 2 * j][ar] = bf2f((bf16)(aw[j] & 0xffff)) * op.a_scale(k0 + ah * 8 + 2 * j);
            As[ah * 8 + 2 * j + 1][ar] = bf2f((bf16)(aw[j] >> 16)) * op.a_scale(k0 + ah * 8 + 2 * j + 1);
        }
        const float4 w0 = *(const float4*)(wcol + (size_t)(k0 + wk) * op.ldw());
        const float4 w1 = *(const float4*)(wcol + (size_t)(k0 + wk) * op.ldw() + 4);
        *(float4*)&Bs[wk][(tid & 15) * 8] = w0; *(float4*)&Bs[wk][(tid & 15) * 8 + 4] = w1;
        __syncthreads();
#pragma unroll
        for (int kk = 0; kk < 16; ++kk) {
            float a[8], b[8];
#pragma unroll
            for (int i = 0; i < 8; ++i) a[i] = As[kk][ty * 8 + i];
#pragma unroll
            for (int j = 0; j < 8; ++j) b[j] = Bs[kk][tx * 8 + j];
#pragma unroll
            for (int i = 0; i < 8; ++i)
#pragma unroll
                for (int j = 0; j < 8; ++j) acc[i][j] += a[i] * b[j];
        }
        __syncthreads();
    }
#pragma unroll
    for (int i = 0; i < 8; ++i) op.epi(ty * 8 + i, tx * 8, acc[i]);
}

struct OpIn {
    const bf16* xn; const float* w; const float* b; bf16* proj; int by, bx;
    __device__ bool setup(int by_, int bx_) { by = by_; bx = bx_; return true; }
    __device__ const bf16* a_row(int r) const { return xn + (size_t)(by * 128 + r) * D; }
    __device__ const float* w_base() const { return w + bx * 128; }
    __device__ int ldw() const { return INW; }
    __device__ float a_scale(int) const { return 1.f; }
    __device__ void epi(int r, int c0, const float* v) const {
        const int row = by * 128 + r, col = bx * 128 + c0;
#pragma unroll
        for (int j = 0; j < 8; ++j) proj[(size_t)row * INW + col + j] = (bf16)f2bf(v[j] + b[col + j]);
    }
};
struct OpOut {
    const bf16* mix; const float* w; const float* b; const float* x; bf16* x1b; int by, bx;
    __device__ bool setup(int by_, int bx_) { by = by_; bx = bx_; return true; }
    __device__ const bf16* a_row(int r) const { return mix + (size_t)(by * 128 + r) * D; }
    __device__ const float* w_base() const { return w + bx * 128; }
    __device__ int ldw() const { return D; }
    __device__ float a_scale(int) const { return 1.f; }
    __device__ void epi(int r, int c0, const float* v) const {
        const int row = by * 128 + r, col = bx * 128 + c0;
#pragma unroll
        for (int j = 0; j < 8; ++j) x1b[(size_t)row * D + col + j] = (bf16)f2bf(x[(size_t)row * D + col + j] + v[j] + b[col + j]);
    }
};
__device__ inline bool moe_tile(const unsigned* cnt, int t128, int& e, int& pos0, int& slot0) {
    int base = 0;
    for (int i = 0; i < NEXP; ++i) { const int n128 = 2 * (((int)cnt[i] + 255) / 256); if (t128 < base + n128) { e = i; pos0 = (t128 - base) * 128; slot0 = base * 128 + pos0; return true; } base += n128; }
    return false;
}
struct OpW1 {
    const bf16* x1b; const float* w1; const float* b1; const float* g; const float* rstd; const unsigned* cnt; const unsigned* dest; bf16* act_lo; bf16* act_hi;
    int e, pos0, slot0, bx;
    __device__ bool setup(int by_, int bx_) { bx = bx_; return moe_tile(cnt, by_, e, pos0, slot0); }
    __device__ int tok(int r) const { const int pos = pos0 + r; return pos < (int)cnt[e] ? (int)(dest[(size_t)e * T + pos] >> 2) : 0; }
    __device__ const bf16* a_row(int r) const { return x1b + (size_t)tok(r) * D; }
    __device__ const float* w_base() const { return w1 + (size_t)e * D * 2 * DFF + bx * 128; }
    __device__ int ldw() const { return 2 * DFF; }
    __device__ float a_scale(int k) const { return g[k]; }
    __device__ void epi(int r, int c0, const float* v) const {
        const int slot = slot0 + r; const float rs = rstd[tok(r)];
        bf16* arow = act_row(act_lo, act_hi, slot);
        const int col = bx * 128 + c0;
#pragma unroll
        for (int j = 0; j < 4; ++j) {
            const float gl = v[2 * j] * rs + b1[(size_t)e * 2 * DFF + col + 2 * j], ln = v[2 * j + 1] * rs + b1[(size_t)e * 2 * DFF + col + 2 * j + 1];
            arow[(col >> 1) + j] = (bf16)f2bf(swiglu(gl, ln));
        }
    }
};
struct OpW2 {
    const bf16* act_lo; const bf16* act_hi; const float* w2; const float* b2; const unsigned* cnt; const unsigned* dest; bf16* ys;
    int e, pos0, slot0, bx;
    __device__ bool setup(int by_, int bx_) { bx = bx_; return moe_tile(cnt, by_, e, pos0, slot0); }
    __device__ const bf16* a_row(int r) const { return act_row((bf16*)act_lo, (bf16*)act_hi, slot0 + r); }
    __device__ const float* w_base() const { return w2 + (size_t)e * DFF * D + bx * 128; }
    __device__ int ldw() const { return D; }
    __device__ float a_scale(int) const { return 1.f; }
    __device__ void epi(int r, int c0, const float* v) const {
        const int pos = pos0 + r; if (pos >= (int)cnt[e]) return;
        const unsigned d = dest[(size_t)e * T + pos]; const int col = bx * 128 + c0;
#pragma unroll
        for (int j = 0; j < 8; ++j) ys[(size_t)d * D + col + j] = (bf16)f2bf(v[j] + b2[(size_t)e * D + col + j]);
    }
};

__global__ void __launch_bounds__(512) k_conv(const bf16* __restrict__ proj, const float* __restrict__ cw, const float* __restrict__ g, bf16* __restrict__ mix) {
    __shared__ float red[8];
    const int t = blockIdx.x, c = threadIdx.x, s = t % SEQ;
    const bf16* p = proj + (size_t)t * INW;
    float cu0 = bf2f(p[CONVW + c]) * bf2f(p[2 * CONVW + c]), cu1 = 0.f, cu2 = 0.f;
    if (s >= 1) cu1 = bf2f(p[CONVW + c - INW]) * bf2f(p[2 * CONVW + c - INW]);
    if (s >= 2) cu2 = bf2f(p[CONVW + c - 2 * INW]) * bf2f(p[2 * CONVW + c - 2 * INW]);
    const float y = bf2f(p[c]) * (cw[2 * CONVW + c] * cu0 + cw[CONVW + c] * cu1 + cw[c] * cu2);
    float ss = wave_sum(y * y);
    if ((c & 63) == 0) red[c >> 6] = ss;
    __syncthreads();
    ss = 0.f;
#pragma unroll
    for (int i = 0; i < 8; ++i) ss += red[i];
    const float rstd = 1.0f / sqrtf(ss * (1.0f / CONVW) + EPS);
    mix[(size_t)t * D + c] = (bf16)f2bf(y * rstd * g[c]);
}
__global__ void __launch_bounds__(512) k_attn(const bf16* __restrict__ proj, const float* __restrict__ qg, const float* __restrict__ kg, const float* __restrict__ sinks,
                                              const float* __restrict__ rel_bias, const float* __restrict__ g, bf16* __restrict__ mix) {
    __shared__ float qs[8][64];
    __shared__ float ps[8][128];
    __shared__ float red[8];
    const int t = blockIdx.x, h = threadIdx.x >> 6, lane = threadIdx.x & 63, s = t % SEQ, kv = h / QPKV;
    const bf16* p = proj + (size_t)t * INW;
    {
        const float q = bf2f(p[3 * CONVW + h * HD + lane]);
        const float ss = wave_sum(q * q);
        qs[h][lane] = q * (1.0f / sqrtf(ss * (1.0f / HD) + EPS)) * qg[lane] * 0.125f;
    }
    __syncthreads();
    float lg[2];
#pragma unroll
    for (int i = 0; i < 2; ++i) {
        const int rel = lane + 64 * i;
        lg[i] = -INFINITY;
        if (rel <= s) {
            const bf16* kr = p - (size_t)rel * INW + 3 * CONVW + ATTNW + kv * HD;
            float ss = 0.f, dot = 0.f;
            for (int d = 0; d < HD; ++d) { const float k = bf2f(kr[d]); ss += k * k; dot += k * kg[d] * qs[h][d]; }
            lg[i] = dot * (1.0f / sqrtf(ss * (1.0f / HD) + EPS)) + rel_bias[T5B[rel] * NQH + h];
        }
    }
    const float sk = sinks[h];
    float m = fmaxf(fmaxf(lg[0], lg[1]), sk);
#pragma unroll
    for (int o = 1; o < 64; o <<= 1) m = fmaxf(m, __shfl_xor(m, o));
    const float p0 = (lg[0] == -INFINITY) ? 0.f : expf(lg[0] - m), p1 = (lg[1] == -INFINITY) ? 0.f : expf(lg[1] - m);
    const float den = wave_sum(p0 + p1) + expf(sk - m);
    ps[h][lane] = p0 / den; ps[h][lane + 64] = p1 / den;
    __syncthreads();
    float o = 0.f;
    const int nk = s < 127 ? s + 1 : 128;
    for (int rel = 0; rel < nk; ++rel) o += ps[h][rel] * bf2f(p[-(ptrdiff_t)rel * INW + 3 * CONVW + ATTNW + KVW + kv * HD + lane]);
    float ss = wave_sum(o * o);
    if (lane == 0) red[h] = ss;
    __syncthreads();
    ss = 0.f;
#pragma unroll
    for (int i = 0; i < 8; ++i) ss += red[i];
    const float rstd = 1.0f / sqrtf(ss * (1.0f / ATTNW) + EPS);
    mix[(size_t)t * D + CONVW + h * HD + lane] = (bf16)f2bf(o * rstd * g[h * HD + lane]);
}
__global__ void __launch_bounds__(256) k_router(const bf16* __restrict__ x1b, const float* __restrict__ g, const float* __restrict__ wr, const float* __restrict__ br,
                                                float* __restrict__ rstd_o, float* __restrict__ gate_tk, unsigned* __restrict__ dest, float* __restrict__ rsl, unsigned* cnt) {
    const int t = blockIdx.x * 4 + (threadIdx.x >> 6), lane = threadIdx.x & 63;
    float h[16]; float ss = 0.f;
#pragma unroll
    for (int j = 0; j < 16; ++j) { const float v = bf2f(x1b[(size_t)t * D + lane + 64 * j]); ss += v * v; h[j] = v * g[lane + 64 * j]; }
    ss = wave_sum(ss);
    const float rstd = 1.0f / sqrtf(ss * (1.0f / D) + EPS);
    float lg[NEXP];
    for (int e = 0; e < NEXP; ++e) {
        float a = 0.f;
#pragma unroll
        for (int j = 0; j < 16; ++j) a += h[j] * wr[(size_t)(lane + 64 * j) * NEXP + e];
        lg[e] = wave_sum(a) * rstd + br[e];
    }
    if (lane == 0) {
        rstd_o[t] = rstd;
        int idx[4]; float val[4];
        unsigned used = 0u;
        for (int k = 0; k < 4; ++k) { int bi = -1; float bv = -INFINITY; for (int e = 0; e < NEXP; ++e) if (!((used >> e) & 1u) && lg[e] > bv) { bv = lg[e]; bi = e; } idx[k] = bi; val[k] = bv; used |= 1u << bi; }
        float den = 0.f, pe[4];
        for (int k = 0; k < 4; ++k) { pe[k] = expf(val[k] - val[0]); den += pe[k]; }
        for (int k = 0; k < 4; ++k) {
            gate_tk[t * 4 + k] = pe[k] / den;
            const unsigned pos = atomicAdd(&cnt[idx[k]], 1u);
            dest[(size_t)idx[k] * T + pos] = (unsigned)(t * 4 + k); rsl[(size_t)idx[k] * T + pos] = rstd;
        }
    }
}
__global__ void __launch_bounds__(256) k_combine(const bf16* __restrict__ x1b, const bf16* __restrict__ ys, const float* __restrict__ gate_tk, float* __restrict__ out) {
    const size_t i = (size_t)blockIdx.x * 256 + threadIdx.x; const int t = (int)(i / D), c = (int)(i % D);
    float v = bf2f(x1b[i]);
#pragma unroll
    for (int k = 0; k < 4; ++k) v += gate_tk[t * 4 + k] * bf2f(ys[((size_t)t * 4 + k) * D + c]);
    out[i] = v;
}
}
namespace pg8 {
#define PG8_LAS __attribute__((address_space(3)))
constexpr int BM = 256, BK = 64, HALF = 128, HTB = HALF * BK * 2  , STAGE_BYTES = 8 * HTB, NXCD = 8, WGM = 8;

__host__ __device__ __forceinline__ int lds_byte(int r, int c) { const int st = (r >> 4) * 2 + (c >> 5), rr = r & 15, cc = c & 31, ob = rr * 64 + cc * 2; return st * 1024 + (ob ^ (((ob >> 9) & 1) << 5)); }
__host__ __device__ __forceinline__ void stage_rc(int b, int& R, int& C) { const int st = b / 1024, sb = b % 1024, swz = sb ^ (((sb >> 9) & 1) << 5); R = (st >> 1) * 16 + swz / 64; C = (st & 1) * 32 + (swz % 64) / 2; }
__host__ __device__ __forceinline__ int perm32(int rho) { const int n = rho >> 4, i = rho & 15; return 8 * (i >> 2) + 4 * n + (i & 3); }

struct Unit { const char* A; const char* B; int pm, pn, e, pos0; };

__device__ __forceinline__ void tile_of(int L, int nM, int nN, int& pm, int& pn) {
    const int nwg = nM * nN; int wgid = L; { const int q = nwg / NXCD, r = nwg % NXCD, xcd = wgid % NXCD, off = wgid / NXCD; wgid = (xcd < r ? xcd * (q + 1) : r * (q + 1) + (xcd - r) * q) + off; }
    const int nig = WGM * nN, gid = wgid / nig, fm = gid * WGM, gsz = (nM - fm) < WGM ? (nM - fm) : WGM;
    pm = fm + ((wgid % nig) % gsz); pn = (wgid % nig) / gsz;
}
struct DenseOrder {
    const char* A; const char* Bt; int nM, nN, G, c; size_t tstep;
    __device__ __forceinline__ void init(const void* A_, const void* Bt_, int M, int N, int K, int G_, int c_) { A = (const char*)A_; Bt = (const char*)Bt_; nM = M / BM; nN = N / BM; G = G_; c = c_; tstep = (size_t)BM * K * 2; }
    __device__ __forceinline__ bool next(int i, Unit& u) const {
        const int L = i * G + c; if (L >= nM * nN) return false;
        tile_of(L, nM, nN, u.pm, u.pn); u.A = A + (size_t)u.pm * tstep; u.B = Bt + (size_t)u.pn * tstep; u.e = 0; u.pos0 = 0; return true;
    }
};

__device__ __forceinline__ void glds16s(const void* sbase, unsigned voff, unsigned lds_dst) { unsigned keep;
    asm volatile("s_mov_b32 %0, m0\n\ts_mov_b32 m0, %3\n\ts_nop 0\n\tglobal_load_lds_dwordx4 %1, %2\n\ts_mov_b32 m0, %0" : "=&s"(keep) : "v"(voff), "s"(sbase), "s"(lds_dst) : "memory"); }
__device__ __forceinline__ const void* uniform_ptr(const void* p) { const unsigned long long v = (unsigned long long)p; const unsigned lo = __builtin_amdgcn_readfirstlane((unsigned)v), hi = __builtin_amdgcn_readfirstlane((unsigned)(v >> 32)); return (const void*)(((unsigned long long)hi << 32) | lo); }
__device__ __forceinline__ unsigned cvt_pk_bf16(float lo, float hi) { unsigned r; asm volatile("v_cvt_pk_bf16_f32 %0, %1, %2" : "=v"(r) : "v"(lo), "v"(hi)); return r; }

typedef f32x4 Acc[2][2][4][2];

template <class Epi, class Sched, bool GATHER, bool ALIGN_EPI, bool FP8 = false, int KREP = 1, int EREP = 1>
__device__ __forceinline__ void gemm_phase(PG8_LAS unsigned char* lds, const int K, const Sched& S, const Epi& E) {
    const int tid = threadIdx.x, wid = __builtin_amdgcn_readfirstlane(tid >> 6), lane = tid & 63, wr = wid >> 2, wc = wid & 3, fr = lane & 15, fq = lane >> 4;
    const int nt = K / BK;
    unsigned voffA[2][2], voffB[2];
    const size_t kstep = (size_t)(BK * 2);
    const size_t hstep = (size_t)HALF * K * 2;
#pragma unroll
    for (int i = 0; i < 2; ++i) { int R, C; stage_rc(tid * 16 + i * 8192, R, C); const int Rb = (R & ~31) + perm32(R & 31);
        voffB[i] = (unsigned)(Rb * K + C) * 2u;
        if (!GATHER) { voffA[0][i] = (unsigned)(R * K + C) * 2u; voffA[1][i] = voffA[0][i] + (unsigned)hstep; } }
    const unsigned ldsb = __builtin_amdgcn_readfirstlane((unsigned)(size_t)lds + (unsigned)wid * 1024u);
    const int aoff = lds_byte(wr * 64 + fr, fq * 8), boff = lds_byte(wc * 32 + fr, fq * 8);
#define PG8_SA(b, h) (((b) * 2 + (h)) * HTB)
#define PG8_SB(b, h) ((4 + (b) * 2 + (h)) * HTB)
#define PG8_STAGE(bufoff, gbase, v0, v1) do { const void* _g = uniform_ptr(gbase); glds16s(_g, (v0), ldsb + (bufoff)); glds16s(_g, (v1), ldsb + (bufoff) + 8192); } while (0)
#define PG8_STAGE_B(bufoff, gbase) PG8_STAGE(bufoff, gbase, voffB[0], voffB[1])
#define PG8_STAGE_A(bufoff, gbase, h) PG8_STAGE(bufoff, gbase, voffA[h][0], voffA[h][1])
#define PG8_LDA(dst, b, h) do { _Pragma("unroll") for (int m = 0; m < 4; ++m) _Pragma("unroll") for (int k = 0; k < 2; ++k) dst[m][k] = *(const PG8_LAS bf16x8*)(lds + PG8_SA(b, h) + aoff + m * 2048 + k * 1024); } while (0)
#define PG8_LDB(dst, b, h) do { _Pragma("unroll") for (int n = 0; n < 2; ++n) _Pragma("unroll") for (int k = 0; k < 2; ++k) dst[n][k] = *(const PG8_LAS bf16x8*)(lds + PG8_SB(b, h) + boff + n * 2048 + k * 1024); } while (0)
#define PG8_MMA(ai, bj, At, Bt) do { __builtin_amdgcn_s_setprio(1); \
        if constexpr (FP8) { i32x8 _b[2]; _Pragma("unroll") for (int n = 0; n < 2; ++n) _b[n] = __builtin_shufflevector(__builtin_bit_cast(i32x4, Bt[n][0]), __builtin_bit_cast(i32x4, Bt[n][1]), 0, 1, 2, 3, 4, 5, 6, 7); \
            _Pragma("unroll") for (int m = 0; m < 4; ++m) { const i32x8 _a = __builtin_shufflevector(__builtin_bit_cast(i32x4, At[m][0]), __builtin_bit_cast(i32x4, At[m][1]), 0, 1, 2, 3, 4, 5, 6, 7); \
                _Pragma("unroll") for (int n = 0; n < 2; ++n) acc[ai][bj][m][n] = __builtin_amdgcn_mfma_scale_f32_16x16x128_f8f6f4(_b[n], _a, acc[ai][bj][m][n], 0, 0, 0, 0x7f7f7f7f, 0, 0x7f7f7f7f); } } \
        else { _Pragma("unroll") for (int m = 0; m < 4; ++m) _Pragma("unroll") for (int n = 0; n < 2; ++n) _Pragma("unroll") for (int k = 0; k < 2; ++k) \
            acc[ai][bj][m][n] = __builtin_amdgcn_mfma_f32_16x16x32_bf16(Bt[n][k], At[m][k], acc[ai][bj][m][n], 0, 0, 0); } \
        __builtin_amdgcn_s_setprio(0); } while (0)
#define PG8_WAIT_V(n) asm volatile("s_waitcnt vmcnt(" #n ")" ::: "memory")
#define PG8_WAIT_L(n) asm volatile("s_waitcnt lgkmcnt(" #n ")" ::: "memory")
#define PG8_BAR __builtin_amdgcn_s_barrier()
#define PG8_SCHED __builtin_amdgcn_sched_barrier(0)
    Unit cur, nxt; int ui = 0;
    if (!S.next(0, cur)) return;
    Acc acc;
#pragma unroll
    for (int a = 0; a < 2; ++a)
#pragma unroll
        for (int b = 0; b < 2; ++b)
#pragma unroll
            for (int m = 0; m < 4; ++m)
#pragma unroll
                for (int n = 0; n < 2; ++n) acc[a][b][m][n] = (f32x4){0.f, 0.f, 0.f, 0.f};
    bf16x8 At[4][2], B0[2][2], B1[2][2];
    const char* cA = cur.A; const char* cB = cur.B;
    if constexpr (GATHER) S.rows(cur, voffA);
    PG8_STAGE_B(PG8_SB(0, 0), cB); PG8_STAGE_B(PG8_SB(0, 1), cB + hstep); PG8_STAGE_A(PG8_SA(0, 0), cA, 0); PG8_STAGE_A(PG8_SA(0, 1), cA, 1);
    if (wr == 1) PG8_BAR;
    PG8_WAIT_V(2); PG8_BAR;
    PG8_STAGE_B(PG8_SB(1, 0), cB + kstep); PG8_STAGE_A(PG8_SA(1, 0), cA + kstep, 0); PG8_STAGE_B(PG8_SB(1, 1), cB + hstep + kstep);
    PG8_WAIT_V(6); PG8_BAR;
    for (;;) {
        const bool has_next = S.next(ui + 1, nxt);
        const char* nA = has_next ? nxt.A : cA; const char* nB = has_next ? nxt.B : cB;
#pragma unroll 1
        for (int tt = 0; tt < KREP * nt; tt += 2) {
            const bool last = (tt == KREP * nt - 2); const int t = (KREP == 1) ? tt : (tt % nt), t2 = (KREP == 1) ? tt + 2 : ((tt + 2) % nt);
            const char* a1 = cA + (size_t)(t + 1) * kstep;
            const char* a2 = last ? nA : cA + (size_t)t2 * kstep; const char* b2 = last ? nB : cB + (size_t)t2 * kstep;
            const char* a3 = a2 + kstep; const char* b3 = b2 + kstep;
            PG8_LDB(B0, 0, 0); PG8_LDB(B1, 0, 1); PG8_SCHED; PG8_LDA(At, 0, 0); PG8_STAGE_A(PG8_SA(1, 1), a1, 1);
            if constexpr (GATHER) { if (last && has_next) S.rows(nxt, voffA); }
            PG8_WAIT_V(8); PG8_WAIT_L(0); PG8_BAR; PG8_MMA(0, 0, At, B0); PG8_MMA(0, 1, At, B1); PG8_BAR; PG8_SCHED;
            PG8_LDA(At, 0, 1); PG8_STAGE_B(PG8_SB(0, 0), b2); PG8_STAGE_B(PG8_SB(0, 1), b2 + hstep); PG8_STAGE_A(PG8_SA(0, 0), a2, 0);
            PG8_WAIT_V(8); PG8_WAIT_L(0); PG8_BAR; PG8_MMA(1, 0, At, B0); PG8_MMA(1, 1, At, B1); PG8_BAR; PG8_SCHED;
            PG8_LDB(B0, 1, 0); PG8_LDB(B1, 1, 1); PG8_SCHED; PG8_LDA(At, 1, 0); PG8_STAGE_A(PG8_SA(0, 1), a2, 1);
            PG8_WAIT_V(8); PG8_WAIT_L(0); PG8_BAR; PG8_MMA(0, 0, At, B0); PG8_MMA(0, 1, At, B1); PG8_BAR; PG8_SCHED;
            PG8_LDA(At, 1, 1); PG8_STAGE_B(PG8_SB(1, 0), b3); PG8_STAGE_B(PG8_SB(1, 1), b3 + hstep); PG8_STAGE_A(PG8_SA(1, 0), a3, 0);
            PG8_WAIT_V(8); PG8_WAIT_L(0); PG8_BAR; PG8_MMA(1, 0, At, B0); PG8_MMA(1, 1, At, B1); PG8_BAR; PG8_SCHED;
        }
        if constexpr (ALIGN_EPI) { if (wr == 0) PG8_BAR; }
        {
            int tz = threadIdx.x; asm volatile("" : "+v"(tz)); const int wz = __builtin_amdgcn_readfirstlane(tz >> 6), lz = tz & 63;
            for (int er = 0; er < EREP; ++er) E(acc, cur, wz >> 2, wz & 3, lz & 15, lz >> 4);
        }
        if (!has_next) break;
#pragma unroll
        for (int a = 0; a < 2; ++a)
#pragma unroll
            for (int b = 0; b < 2; ++b)
#pragma unroll
                for (int m = 0; m < 4; ++m)
#pragma unroll
                    for (int n = 0; n < 2; ++n) acc[a][b][m][n] = (f32x4){0.f, 0.f, 0.f, 0.f};
        cur = nxt; cA = nA; cB = nB; ++ui;
        if constexpr (ALIGN_EPI) { if (wr == 1) PG8_BAR; }
    }
    PG8_WAIT_V(0);
    if constexpr (!ALIGN_EPI) { if (wr == 0) PG8_BAR; }
    PG8_BAR;
#undef PG8_SA
#undef PG8_SB
#undef PG8_STAGE
#undef PG8_STAGE_A
#undef PG8_STAGE_B
#undef PG8_LDA
#undef PG8_LDB
#undef PG8_MMA
#undef PG8_WAIT_V
#undef PG8_WAIT_L
#undef PG8_BAR
#undef PG8_SCHED
}
}
constexpr int NWAVES = 8;
constexpr int RING_OFF = 0, RING_BYTES = 131072;
constexpr int MOE_OFF = RING_BYTES;
constexpr int LDSCTL_OFF = MOE_OFF + 512, MISC_OFF = LDSCTL_OFF + 320;
constexpr int LDS_BYTES = 163840;
static_assert(MISC_OFF + 128 <= LDS_BYTES, "LDS map");

#define GAS __attribute__((address_space(1)))
#define LAS __attribute__((address_space(3)))
typedef GAS unsigned gu32;
#define RLX_AGENT __ATOMIC_RELAXED, __HIP_MEMORY_SCOPE_AGENT
#define LDS_WAIT() asm volatile("s_waitcnt lgkmcnt(0)" ::: "memory")
#define VM_WAIT() asm volatile("s_waitcnt vmcnt(0)" ::: "memory")

#define XB_TMO      128
#define XB_XCNT(j)  (256  + 64 * (j))
#define XB_XSUB(j)  (1280 + 64 * (j))
#define XB_XGEN(j)  (2304 + 64 * (j))
#define XB_TOP      3328
#define XB_TOPGEN   3392
#define XCD_BAR_WORDS 3456
#define XB_SPIN_CAP (1u << 18)
__device__ __forceinline__ unsigned xb_ld(unsigned* p)              { return __hip_atomic_load(p, __ATOMIC_RELAXED, __HIP_MEMORY_SCOPE_AGENT); }
__device__ __forceinline__ unsigned xb_add(unsigned* p, unsigned v) { return __hip_atomic_fetch_add(p, v, __ATOMIC_RELAXED, __HIP_MEMORY_SCOPE_AGENT); }
__device__ __forceinline__ unsigned xb_xcc_id() { return (unsigned)__builtin_amdgcn_s_getreg((3 << 11) | 20) & 0xFu; }
#define XB_SPIN(cond, bar) do { unsigned _sp = 0; while (cond) { __builtin_amdgcn_s_sleep(1); \
    if ((++_sp & 255u) == 0u) { if (xb_ld(&(bar)[XB_TMO])) break; if (_sp > XB_SPIN_CAP) { atomicAdd(&(bar)[XB_TMO], 1u); break; } } } } while (0)
struct XcdBarrier { unsigned* bar; unsigned x; volatile LAS unsigned* st; };
__device__ __forceinline__ XcdBarrier xcd_barrier_post(unsigned* bar, volatile LAS unsigned* st) {
    XcdBarrier b; b.bar = bar; b.x = xb_xcc_id(); b.st = st;
    if (threadIdx.x == 0) (void)xb_add(&bar[XB_XCNT(b.x)], 1u);
    return b;
}
__device__ __forceinline__ void xcd_barrier_complete(unsigned* bar, unsigned x, unsigned& nloc, unsigned& nx) {
    const unsigned G = gridDim.x * gridDim.y * gridDim.z;
    unsigned sum, cnt, mine, sp = 0u;
    for (;;) {
        sum = 0u; cnt = 0u; mine = 0u;
#pragma unroll
        for (unsigned j = 0; j < 16; ++j) { const unsigned c = xb_ld(&bar[XB_XCNT(j)]); sum += c; cnt += (c > 0u) ? 1u : 0u; mine = (j == x) ? c : mine; }
        if (sum == G) break;
        __builtin_amdgcn_s_sleep(1);
        if ((++sp & 255u) == 0u) { if (xb_ld(&bar[XB_TMO])) break; if (sp > XB_SPIN_CAP) { atomicAdd(&bar[XB_TMO], 1u); break; } }
    }
    nloc = mine > 0u ? mine : 1u; nx = cnt > 0u ? cnt : 1u;
}
__device__ __forceinline__ void xcd_barrier(const XcdBarrier& b) {
    asm volatile("s_waitcnt vmcnt(0)" ::: "memory");
    __syncthreads();
    if (threadIdx.x == 0) {
        unsigned* bar = b.bar;
        __builtin_amdgcn_s_waitcnt(0);
        unsigned nloc = b.st[0], nx = b.st[1];
        if (nloc == 0u) { xcd_barrier_complete(bar, b.x, nloc, nx); b.st[0] = nloc; b.st[1] = nx; }
        const unsigned old = xb_add(&bar[XB_XSUB(b.x)], 1u);
        const unsigned gen = old / nloc;
        if (old + 1u == (gen + 1u) * nloc) {
            __builtin_amdgcn_fence(__ATOMIC_RELEASE, "agent");
            asm volatile("s_waitcnt vmcnt(0)" ::: "memory");
            const unsigned og = xb_add(&bar[XB_TOP], 1u);
            const unsigned tg = og / nx;
            if (og + 1u == (tg + 1u) * nx) xb_add(&bar[XB_TOPGEN], 1u);
            else XB_SPIN(xb_ld(&bar[XB_TOPGEN]) == tg, bar);
            __builtin_amdgcn_fence(__ATOMIC_ACQUIRE, "agent");
            xb_add(&bar[XB_XGEN(b.x)], 1u);
            asm volatile("s_waitcnt vmcnt(0)" ::: "memory");
        } else {
            XB_SPIN(xb_ld(&bar[XB_XGEN(b.x)]) == gen, bar);
            __builtin_amdgcn_fence(__ATOMIC_ACQUIRE, "agent");
            asm volatile("s_waitcnt vmcnt(0)" ::: "memory");
        }
    }
    __syncthreads();
}

struct Frame {
    LAS unsigned char* lds;
    volatile LAS unsigned* MISC;
    gu32* ctl;
    int tid, lane, wave;
    int vcu, G;
    const float *x, *norm_mix, *w_in, *b_in, *conv_w, *q_norm, *k_norm, *sinks, *rel_bias, *on_conv, *on_attn, *w_out, *b_out, *norm_ffn, *w_router, *b_router, *w1, *b1, *w2, *b2;
    float* out;
    bf16 *WinT, *WoutT, *WR; unsigned char *W1Q, *W2Q, *x1q, *act;
    float *B1S, *rstd, *gate, *rsl;
    unsigned* dest;
    bf16 *xn, *proj, *mix, *x1b, *ys;
};

struct EpiIn {
    bf16* O; const float* bias;
    __device__ __forceinline__ void operator()(const pg8::Acc& acc, const pg8::Unit& u, int wr, int wc, int fr, int fq) const {
        const int row0 = u.pm * 256 + wr * 64 + fr, col0 = u.pn * 256 + wc * 32 + 8 * fq;
        f32x4 bv[2][2];
#pragma unroll
        for (int bj = 0; bj < 2; ++bj)
#pragma unroll
            for (int n = 0; n < 2; ++n) bv[bj][n] = *(const f32x4*)(bias + col0 + bj * 128 + 4 * n);
#pragma unroll
        for (int ai = 0; ai < 2; ++ai)
#pragma unroll
            for (int m = 0; m < 4; ++m) { bf16* rowp = O + (size_t)(row0 + ai * 128 + m * 16) * INW + col0;
#pragma unroll
                for (int bj = 0; bj < 2; ++bj) { const f32x4 v0 = acc[ai][bj][m][0] + bv[bj][0], v1 = acc[ai][bj][m][1] + bv[bj][1];
                    v4u w; w.x = pg8::cvt_pk_bf16(v0[0], v0[1]); w.y = pg8::cvt_pk_bf16(v0[2], v0[3]); w.z = pg8::cvt_pk_bf16(v1[0], v1[1]); w.w = pg8::cvt_pk_bf16(v1[2], v1[3]);
                    *(v4u*)(rowp + bj * 128) = w; } }
    }
};
struct EpiOut {
    bf16* O; const float* bias; const float* x; unsigned char* Q;
    __device__ __forceinline__ void operator()(const pg8::Acc& acc, const pg8::Unit& u, int wr, int wc, int fr, int fq) const {
        const int row0 = u.pm * 256 + wr * 64 + fr, col0 = u.pn * 256 + wc * 32 + 8 * fq;
        f32x4 bv[2][2];
#pragma unroll
        for (int bj = 0; bj < 2; ++bj)
#pragma unroll
            for (int n = 0; n < 2; ++n) bv[bj][n] = *(const f32x4*)(bias + col0 + bj * 128 + 4 * n);
#pragma unroll
        for (int ai = 0; ai < 2; ++ai)
#pragma unroll
            for (int m = 0; m < 4; ++m) { const size_t off = (size_t)(row0 + ai * 128 + m * 16) * D + col0;
#pragma unroll
                for (int bj = 0; bj < 2; ++bj) { const f32x4 x0 = *(const f32x4*)(x + off + bj * 128), x1 = *(const f32x4*)(x + off + bj * 128 + 4);
                    const f32x4 v0 = acc[ai][bj][m][0] + bv[bj][0] + x0, v1 = acc[ai][bj][m][1] + bv[bj][1] + x1;
                    v4u w; w.x = pg8::cvt_pk_bf16(v0[0], v0[1]); w.y = pg8::cvt_pk_bf16(v0[2], v0[3]); w.z = pg8::cvt_pk_bf16(v1[0], v1[1]); w.w = pg8::cvt_pk_bf16(v1[2], v1[3]);
                    *(v4u*)(O + off + bj * 128) = w;
                    v2u q; q.x = pk4_fp8(v0[0], v0[1], v0[2], v0[3]); q.y = pk4_fp8(v1[0], v1[1], v1[2], v1[3]); *(v2u*)(Q + off + bj * 128) = q; }
                asm volatile("" ::: "memory"); }
    }
};
template <bool GATHER> struct MoeOrder {
    const char* Abase; const char* Bt; size_t bstride_e, tstepB;
    int nN, G, c, NT; const LAS int* tile0; const LAS int* ecnt; const unsigned* dest;
    __device__ __forceinline__ bool next(int i, pg8::Unit& u) const {
        const int L = i * G + c; if (L >= NT * nN) return false;
        pg8::tile_of(L, NT, nN, u.pm, u.pn);
        int e = 0;
#pragma unroll
        for (int st = 16; st >= 1; st >>= 1) if (__builtin_amdgcn_readfirstlane(tile0[e + st]) <= u.pm) e += st;
        u.e = e; u.pos0 = (u.pm - __builtin_amdgcn_readfirstlane(tile0[e])) * 256;
        u.B = Bt + (size_t)e * bstride_e + (size_t)u.pn * tstepB;
        u.A = Abase;
        return true;
    }
    __device__ __forceinline__ void rows(const pg8::Unit& u, unsigned (&voff)[2][2]) const {
        if constexpr (!GATHER) {
            int tz = threadIdx.x; asm volatile("" : "+v"(tz));
#pragma unroll
            for (int i = 0; i < 2; ++i) { int R, C; pg8::stage_rc(tz * 16 + i * 8192, R, C);
#pragma unroll
                for (int h = 0; h < 2; ++h) voff[h][i] = (unsigned)(u.pm * 256 + h * 128 + R) * (unsigned)DFF + (unsigned)(C * 2); }
            return;
        }
        const int n = __builtin_amdgcn_readfirstlane(ecnt[u.e]);
        int tz = threadIdx.x; asm volatile("" : "+v"(tz));
#pragma unroll
        for (int i = 0; i < 2; ++i) { int R, C; pg8::stage_rc(tz * 16 + i * 8192, R, C);
#pragma unroll
            for (int h = 0; h < 2; ++h) { const int pos = u.pos0 + h * 128 + R; unsigned tok = 0u; if (pos < n) tok = dest[(size_t)u.e * T + pos] >> 2; voff[h][i] = tok * (unsigned)D + (unsigned)(C * 2); } }
    }
};
struct EpiW1 {
    unsigned char* act; const float* b1s; const float* rsl; const LAS int* ecnt;
    __device__ __forceinline__ void operator()(const pg8::Acc& acc, const pg8::Unit& u, int wr, int wc, int fr, int fq) const {
        const int n = __builtin_amdgcn_readfirstlane(ecnt[u.e]); const int acol = u.pn * 128 + wc * 32 + 8 * fq;
        unsigned char* const abase = act + (size_t)u.pm * (256 * DFF) + acol;
        const float* bg = b1s + (size_t)u.e * 2 * DFF + acol; const float* bl = bg + DFF;
        const f32x4 bg0 = *(const f32x4*)bg, bg1 = *(const f32x4*)(bg + 4), bl0 = *(const f32x4*)bl, bl1 = *(const f32x4*)(bl + 4);
#pragma unroll
        for (int ai = 0; ai < 2; ++ai)
#pragma unroll
            for (int m = 0; m < 4; ++m) { const int r = ai * 128 + wr * 64 + m * 16 + fr; const float s = (u.pos0 + r) < n ? rsl[(size_t)u.e * T + u.pos0 + r] * (1.0f / W_SCALE) : 0.f;
                const f32x4 g0 = acc[ai][0][m][0] * s + bg0, g1 = acc[ai][0][m][1] * s + bg1, l0 = acc[ai][1][m][0] * s + bl0, l1 = acc[ai][1][m][1] * s + bl1;
                v2u w; w.x = pk4_fp8(ACT_SCALE * swiglu(g0[0], l0[0]), ACT_SCALE * swiglu(g0[1], l0[1]), ACT_SCALE * swiglu(g0[2], l0[2]), ACT_SCALE * swiglu(g0[3], l0[3]));
                w.y = pk4_fp8(ACT_SCALE * swiglu(g1[0], l1[0]), ACT_SCALE * swiglu(g1[1], l1[1]), ACT_SCALE * swiglu(g1[2], l1[2]), ACT_SCALE * swiglu(g1[3], l1[3]));
                *(v2u*)(abase + (size_t)r * DFF) = w; }
    }
};
struct EpiW2 {
    bf16* ys; const float* b2; const unsigned* dest; const LAS int* ecnt; float sc; bf16* dummy;
    __device__ __forceinline__ void operator()(const pg8::Acc& acc, const pg8::Unit& u, int wr, int wc, int fr, int fq) const {
        const int n = __builtin_amdgcn_readfirstlane(ecnt[u.e]); const int col0 = u.pn * 256 + wc * 32 + 8 * fq;
        f32x4 bv[2][2];
#pragma unroll
        for (int bj = 0; bj < 2; ++bj)
#pragma unroll
            for (int nn = 0; nn < 2; ++nn) bv[bj][nn] = *(const f32x4*)(b2 + (size_t)u.e * D + col0 + bj * 128 + 4 * nn);
#pragma unroll
        for (int ai = 0; ai < 2; ++ai)
#pragma unroll
            for (int m = 0; m < 4; ++m) { const int pos = u.pos0 + ai * 128 + wr * 64 + m * 16 + fr; const bool ok = pos < n;
                const unsigned d = dest[(size_t)u.e * T + (ok ? pos : n - 1)];
                bf16* rowp = (ok ? ys + (size_t)d * D : dummy) + col0;
#pragma unroll
                for (int bj = 0; bj < 2; ++bj) { const f32x4 v0 = acc[ai][bj][m][0] * sc + bv[bj][0], v1 = acc[ai][bj][m][1] * sc + bv[bj][1];
                    v4u w; w.x = pg8::cvt_pk_bf16(v0[0], v0[1]); w.y = pg8::cvt_pk_bf16(v0[2], v0[3]); w.z = pg8::cvt_pk_bf16(v1[0], v1[1]); w.w = pg8::cvt_pk_bf16(v1[2], v1[3]);
                    *(v4u*)(rowp + bj * 128) = w; } }
    }
};

template <bool MAP1>
__device__ __forceinline__ void p0_transpose_item(const float* W, int K, int N, bf16* WT, const float* gain, LAS float* scr, int item, int lane) {
    const int nblk = N / 32, kb = item / nblk, nb = item % nblk, k0 = 64 * kb, n0 = 32 * nb;
#pragma unroll 8
    for (int i = 0; i < 32; ++i) { const int kk = 2 * i + (lane >> 5); scr[kk * 33 + (lane & 31)] = W[(size_t)(k0 + kk) * N + n0 + (lane & 31)]; }
    LDS_WAIT(); asm volatile("" ::: "memory");
    const int c = lane & 7;
    float gk[8];
#pragma unroll
    for (int j = 0; j < 8; ++j) gk[j] = gain ? gain[k0 + 8 * c + j] : 1.0f;
#pragma unroll
    for (int j = 0; j < 4; ++j) { const int nl = (lane >> 3) + 8 * j; const LAS float* s = scr + (8 * c) * 33 + nl;
        int n = n0 + nl; if (MAP1) { const int a = n >> 1; n = 256 * (a >> 7) + 128 * (n & 1) + (a & 127); }
        v4u o; o.x = pk2(s[0 * 33] * gk[0], s[1 * 33] * gk[1]); o.y = pk2(s[2 * 33] * gk[2], s[3 * 33] * gk[3]); o.z = pk2(s[4 * 33] * gk[4], s[5 * 33] * gk[5]); o.w = pk2(s[6 * 33] * gk[6], s[7 * 33] * gk[7]);
        *(GAS v4u*)(WT + (size_t)n * K + k0 + 8 * c) = o; }
    LDS_WAIT(); asm volatile("" ::: "memory");
}
template <bool MAP1>
__device__ __forceinline__ void p0_transpose_item_q(const float* W, int K, int N, unsigned char* WT, const float* gain, LAS float* scr, int item, int lane) {
    const int nblk = N / 32, kb = item / nblk, nb = item % nblk, k0 = 64 * kb, n0 = 32 * nb;
#pragma unroll 8
    for (int i = 0; i < 32; ++i) { const int kk = 2 * i + (lane >> 5); scr[kk * 33 + (lane & 31)] = W[(size_t)(k0 + kk) * N + n0 + (lane & 31)]; }
    LDS_WAIT(); asm volatile("" ::: "memory");
    const int c = lane & 3;
    float gk[16];
#pragma unroll
    for (int j = 0; j < 16; ++j) gk[j] = (gain ? gain[k0 + 16 * c + j] : 1.0f) * W_SCALE;
#pragma unroll
    for (int j = 0; j < 2; ++j) { const int nl = (lane >> 2) + 16 * j; const LAS float* s = scr + (16 * c) * 33 + nl;
        int n = n0 + nl; if (MAP1) { const int a = n >> 1; n = 256 * (a >> 7) + 128 * (n & 1) + (a & 127); }
        v4u o; o.x = pk4_fp8(s[0 * 33] * gk[0], s[1 * 33] * gk[1], s[2 * 33] * gk[2], s[3 * 33] * gk[3]); o.y = pk4_fp8(s[4 * 33] * gk[4], s[5 * 33] * gk[5], s[6 * 33] * gk[6], s[7 * 33] * gk[7]);
        o.z = pk4_fp8(s[8 * 33] * gk[8], s[9 * 33] * gk[9], s[10 * 33] * gk[10], s[11 * 33] * gk[11]); o.w = pk4_fp8(s[12 * 33] * gk[12], s[13 * 33] * gk[13], s[14 * 33] * gk[14], s[15 * 33] * gk[15]);
        *(GAS v4u*)(WT + (size_t)n * K + k0 + 16 * c) = o; }
    LDS_WAIT(); asm volatile("" ::: "memory");
}
__device__ __forceinline__ void p0_prologue(Frame& F) {
    LAS float* scr = (LAS float*)(F.lds + RING_OFF + F.wave * 16384);
    const int gw = F.vcu * NWAVES + F.wave, NGW = F.G * NWAVES;
    constexpr int I_IN = (D / 64) * (INW / 32), I_OUT = (D / 64) * (D / 32), I_1 = (D / 64) * (2 * DFF / 32), I_2 = (DFF / 64) * (D / 32);
    constexpr int NITEMS = I_IN + I_OUT + NEXP * (I_1 + I_2);
    for (int it = gw; it < NITEMS; it += NGW) {
        int r = it;
        if (r < I_IN) { p0_transpose_item<false>(F.w_in, D, INW, F.WinT, nullptr, scr, r, F.lane); continue; } r -= I_IN;
        if (r < I_OUT) { p0_transpose_item<false>(F.w_out, D, D, F.WoutT, nullptr, scr, r, F.lane); continue; } r -= I_OUT;
        if (r < NEXP * I_1) { const int e = r / I_1; p0_transpose_item_q<true>(F.w1 + (size_t)e * D * 2 * DFF, D, 2 * DFF, F.W1Q + (size_t)e * 2 * DFF * D, F.norm_ffn, scr, r % I_1, F.lane); continue; } r -= NEXP * I_1;
        { const int e = r / I_2; p0_transpose_item_q<false>(F.w2 + (size_t)e * DFF * D, DFF, D, F.W2Q + (size_t)e * D * DFF, nullptr, scr, r % I_2, F.lane); }
    }
    const int gt = F.vcu * (NWAVES * 64) + F.tid, NGT = F.G * NWAVES * 64;
    for (int i = gt; i < NEXP * D; i += NGT) { const int e = i / D, k = i % D; const float v = F.norm_ffn[k] * F.w_router[(size_t)k * NEXP + e]; const unsigned hi = f2bf(v); const float lo = v - bf2f((bf16)hi);
        F.WR[i] = (bf16)hi; F.WR[NEXP * D + i] = (bf16)f2bf(lo); }
    for (int i = gt; i < NEXP * 2 * DFF; i += NGT) { const int e = i / (2 * DFF), c = i % (2 * DFF); F.B1S[(size_t)e * 2 * DFF + (c & 1) * DFF + (c >> 1)] = F.b1[i]; }
    {
        f32x4 gv[4];
#pragma unroll
        for (int j = 0; j < 4; ++j) gv[j] = *((const f32x4*)F.norm_mix + F.lane + 64 * j);
        for (int m = gw; m < T; m += NGW) {
            const GAS f32x4* xr = (const GAS f32x4*)(F.x + (size_t)m * D) + F.lane;
            f32x4 v[4]; float s = 0.f;
#pragma unroll
            for (int j = 0; j < 4; ++j) { v[j] = xr[64 * j]; s += (v[j].x * v[j].x + v[j].y * v[j].y) + (v[j].z * v[j].z + v[j].w * v[j].w); }
            const float rstd = 1.f / sqrtf(wave_sum(s) * (1.f / D) + EPS);
            GAS unsigned long long* o8 = (GAS unsigned long long*)(F.xn + (size_t)m * D) + F.lane;
#pragma unroll
            for (int j = 0; j < 4; ++j) o8[64 * j] = (unsigned long long)pk2(v[j].x * rstd * gv[j].x, v[j].y * rstd * gv[j].y) | ((unsigned long long)pk2(v[j].z * rstd * gv[j].z, v[j].w * rstd * gv[j].w) << 32);
        }
    }
}
__device__ __forceinline__ int moe_tables(Frame& F) {
    LAS int* tile0 = (LAS int*)(F.lds + MOE_OFF); LAS int* ecnt = tile0 + 40;
    if (F.tid < NEXP) ecnt[F.tid] = (int)__hip_atomic_load(F.ctl + CW_CNT + F.tid, RLX_AGENT);
    __syncthreads();
    if (F.tid == 0) { int a = 0; for (int e = 0; e < NEXP; ++e) { tile0[e] = a; a += (ecnt[e] + 255) >> 8; } tile0[NEXP] = a; }
    __syncthreads();
    return __builtin_amdgcn_readfirstlane(tile0[NEXP]);
}
constexpr float LOG2E = 1.4426950408889634f;
__device__ __forceinline__ void unpack8(const v4u& w, float (&f)[8]) {
    f[0] = bflo(w.x); f[1] = bfhi(w.x); f[2] = bflo(w.y); f[3] = bfhi(w.y); f[4] = bflo(w.z); f[5] = bfhi(w.z); f[6] = bflo(w.w); f[7] = bfhi(w.w);
}
__device__ __forceinline__ v4u pack8(const float (&f)[8]) {
    v4u w; w.x = pg8::cvt_pk_bf16(f[0], f[1]); w.y = pg8::cvt_pk_bf16(f[2], f[3]); w.z = pg8::cvt_pk_bf16(f[4], f[5]); w.w = pg8::cvt_pk_bf16(f[6], f[7]); return w;
}

__device__ __forceinline__ void p2_conv(Frame& F) {
    const int gw = F.vcu * NWAVES + F.wave, NGW = F.G * NWAVES, c0 = 8 * F.lane;
    float w0[8], w1[8], w2[8], gg[8];
#pragma unroll
    for (int j = 0; j < 8; ++j) { w0[j] = F.conv_w[c0 + j]; w1[j] = F.conv_w[CONVW + c0 + j]; w2[j] = F.conv_w[2 * CONVW + c0 + j]; gg[j] = F.on_conv[c0 + j]; }
    for (int item = gw; item < T / 16; item += NGW) {
        const int t0 = item * 16, s0 = t0 % SEQ;
        float cu1[8], cu2[8];
#pragma unroll
        for (int j = 0; j < 8; ++j) { cu1[j] = 0.f; cu2[j] = 0.f; }
        if (s0 > 0) {
            const bf16* p = F.proj + (size_t)(t0 - 2) * INW + c0;
            const v4u ca = *(const v4u*)(p + CONVW), ua = *(const v4u*)(p + 2 * CONVW), cb = *(const v4u*)(p + INW + CONVW), ub = *(const v4u*)(p + INW + 2 * CONVW);
            float a[8], b[8]; unpack8(ca, a); unpack8(ua, b);
#pragma unroll
            for (int j = 0; j < 8; ++j) cu2[j] = a[j] * b[j];
            unpack8(cb, a); unpack8(ub, b);
#pragma unroll
            for (int j = 0; j < 8; ++j) cu1[j] = a[j] * b[j];
        }
#pragma unroll 1
        for (int tt = 0; tt < 16; tt += 4) {
            v4u bb[4], cc[4], uu[4];
#pragma unroll
            for (int q = 0; q < 4; ++q) { const bf16* p = F.proj + (size_t)(t0 + tt + q) * INW + c0; bb[q] = *(const v4u*)p; cc[q] = *(const v4u*)(p + CONVW); uu[q] = *(const v4u*)(p + 2 * CONVW); }
#pragma unroll
            for (int q = 0; q < 4; ++q) {
                float b[8], c[8], u[8], y[8]; unpack8(bb[q], b); unpack8(cc[q], c); unpack8(uu[q], u);
                float ss = 0.f;
#pragma unroll
                for (int j = 0; j < 8; ++j) { const float cu0 = c[j] * u[j]; y[j] = b[j] * (w2[j] * cu0 + w1[j] * cu1[j] + w0[j] * cu2[j]); ss += y[j] * y[j]; cu2[j] = cu1[j]; cu1[j] = cu0; }
                const float rstd = 1.f / sqrtf(wave_sum(ss) * (1.f / CONVW) + EPS);
#pragma unroll
                for (int j = 0; j < 8; ++j) y[j] = y[j] * rstd * gg[j];
                *(v4u*)(F.mix + (size_t)(t0 + tt + q) * D + c0) = pack8(y);
            }
        }
    }
}

constexpr int KS_STRIDE = 144, VT_STRIDE = 528, KS_OFF = 0, VT_OFF = 256 * KS_STRIDE, BT_OFF = VT_OFF + 64 * VT_STRIDE, ATTN_LDS = BT_OFF + 8 * 128 * 4;
static_assert(ATTN_LDS <= RING_BYTES, "attention LDS");
__device__ __forceinline__ void p2_attn(Frame& F) {
    LAS unsigned char* KS = F.lds + KS_OFF; LAS unsigned char* VT = F.lds + VT_OFF; LAS float* BT = (LAS float*)(F.lds + BT_OFF);
    const int lane = F.lane, c = lane & 15, g = lane >> 4, w = F.wave, sub = lane & 7, grp = lane >> 3;
    for (int i = F.tid; i < 8 * 128; i += NWAVES * 64) BT[i] = F.rel_bias[T5B[i & 127] * NQH + (i >> 7)] * LOG2E;
    float kg8[8];
#pragma unroll
    for (int j = 0; j < 8; ++j) kg8[j] = F.k_norm[8 * sub + j];
    float qg0[8], qg1[8];
#pragma unroll
    for (int j = 0; j < 8; ++j) { qg0[j] = F.q_norm[8 * g + j]; qg1[j] = F.q_norm[32 + 8 * g + j]; }
    __syncthreads();
    for (int unit = blockIdx.x; unit < T / 128; unit += F.G) {
        const int blk = unit % (SEQ / 128), t0 = unit * 128, tq = t0 + 16 * w + c;
        float ssq = 0.f;
#pragma unroll
        for (int kv = 0; kv < 2; ++kv) {
            __syncthreads();
            {
                v4u kr[4], vr[4];
#pragma unroll
                for (int i = 0; i < 4; ++i) {
                    const int keyk = 32 * w + 8 * i + grp, keyv = 32 * w + 2 * grp + (i & 1) + 16 * (i >> 1);
                    const bool okk = !(blk == 0 && keyk < 128), okv = !(blk == 0 && keyv < 128);
                    kr[i] = (v4u){0u, 0u, 0u, 0u}; vr[i] = (v4u){0u, 0u, 0u, 0u};
                    if (okk) kr[i] = *(const v4u*)(F.proj + (size_t)(t0 - 128 + keyk) * INW + KOFF + 64 * kv + 8 * sub);
                    if (okv) vr[i] = *(const v4u*)(F.proj + (size_t)(t0 - 128 + keyv) * INW + VOFF + 64 * kv + 8 * sub);
                }
#pragma unroll
                for (int i = 0; i < 4; ++i) {
                    float k[8]; unpack8(kr[i], k); float ss = 0.f;
#pragma unroll
                    for (int j = 0; j < 8; ++j) ss += k[j] * k[j];
                    ss += __shfl_xor(ss, 1); ss += __shfl_xor(ss, 2); ss += __shfl_xor(ss, 4);
                    const float r = 1.f / sqrtf(ss * (1.f / HD) + EPS);
#pragma unroll
                    for (int j = 0; j < 8; ++j) k[j] = k[j] * r * kg8[j];
                    *(LAS v4u*)(KS + (32 * w + 8 * i + grp) * KS_STRIDE + sub * 16) = pack8(k);
                }
#pragma unroll
                for (int pp = 0; pp < 2; ++pp) {
                    const v4u a = vr[2 * pp], b = vr[2 * pp + 1]; const unsigned aw[4] = {a.x, a.y, a.z, a.w}, bw[4] = {b.x, b.y, b.z, b.w};
                    const int key0 = 32 * w + 2 * grp + 16 * pp;
#pragma unroll
                    for (int jj = 0; jj < 8; ++jj) {
                        const unsigned word = (jj & 1) ? ((aw[jj >> 1] >> 16) | (bw[jj >> 1] & 0xffff0000u)) : ((aw[jj >> 1] & 0xffffu) | (bw[jj >> 1] << 16));
                        *(LAS unsigned*)(VT + (8 * sub + jj) * VT_STRIDE + key0 * 2) = word;
                    }
                }
            }
            __syncthreads();
#pragma unroll 1
            for (int hh = 0; hh < 4; ++hh) {
                const int h = 4 * kv + hh;
                bf16x8 Q0, Q1;
                {
                    const bf16* qp = F.proj + (size_t)tq * INW + QOFF + 64 * h + 8 * g;
                    const v4u r0 = *(const v4u*)qp, r1 = *(const v4u*)(qp + 32);
                    float a[8], b[8]; unpack8(r0, a); unpack8(r1, b); float ss = 0.f;
#pragma unroll
                    for (int j = 0; j < 8; ++j) ss += a[j] * a[j] + b[j] * b[j];
                    ss += __shfl_xor(ss, 16); ss += __shfl_xor(ss, 32);
                    const float r = (1.f / sqrtf(ss * (1.f / HD) + EPS)) * (0.125f * LOG2E);
#pragma unroll
                    for (int j = 0; j < 8; ++j) { a[j] = a[j] * r * qg0[j]; b[j] = b[j] * r * qg1[j]; }
                    const v4u p0 = pack8(a), p1 = pack8(b); Q0 = __builtin_bit_cast(bf16x8, p0); Q1 = __builtin_bit_cast(bf16x8, p1);
                }
                f32x4 st[9];
#pragma unroll
                for (int kt = 0; kt < 9; ++kt) {
                    const LAS unsigned char* kp = KS + (16 * (w + kt) + c) * KS_STRIDE + g * 16;
                    const bf16x8 k0 = *(const LAS bf16x8*)kp, k1 = *(const LAS bf16x8*)(kp + 64);
                    f32x4 z = (f32x4){0.f, 0.f, 0.f, 0.f};
                    z = __builtin_amdgcn_mfma_f32_16x16x32_bf16(k0, Q0, z, 0, 0, 0);
                    st[kt] = __builtin_amdgcn_mfma_f32_16x16x32_bf16(k1, Q1, z, 0, 0, 0);
                }
                const int relbase = 128 + c - 4 * g;
                const float sk = F.sinks[h] * LOG2E;
                float m = sk;
#pragma unroll
                for (int kt = 0; kt < 9; ++kt)
#pragma unroll
                    for (int j = 0; j < 4; ++j) {
                        const int rel = relbase - 16 * kt - j;
                        bool ok = (rel >= 0) && (rel < 128);
                        if (blk == 0) ok = ok && (16 * (w + kt) + 4 * g + j >= 128);
                        const float v = st[kt][j] + BT[h * 128 + (rel & 127)];
                        st[kt][j] = ok ? v : -INFINITY;
                        m = fmaxf(m, st[kt][j]);
                    }
                m = fmaxf(m, __shfl_xor(m, 16)); m = fmaxf(m, __shfl_xor(m, 32));
                float l = 0.f;
#pragma unroll
                for (int kt = 0; kt < 9; ++kt)
#pragma unroll
                    for (int j = 0; j < 4; ++j) { const float p = __builtin_amdgcn_exp2f(st[kt][j] - m); st[kt][j] = p; l += p; }
                l += __shfl_xor(l, 16); l += __shfl_xor(l, 32);
                l += __builtin_amdgcn_exp2f(sk - m);
                const float inv = 1.f / l;
                bf16x8 P[5];
#pragma unroll
                for (int u = 0; u < 5; ++u) {
                    v4u pw; pw.x = pg8::cvt_pk_bf16(st[2 * u][0], st[2 * u][1]); pw.y = pg8::cvt_pk_bf16(st[2 * u][2], st[2 * u][3]);
                    if (u < 4) { pw.z = pg8::cvt_pk_bf16(st[2 * u + 1][0], st[2 * u + 1][1]); pw.w = pg8::cvt_pk_bf16(st[2 * u + 1][2], st[2 * u + 1][3]); } else { pw.z = 0u; pw.w = 0u; }
                    P[u] = __builtin_bit_cast(bf16x8, pw);
                }
#pragma unroll
                for (int dt = 0; dt < 4; ++dt) {
                    f32x4 o = (f32x4){0.f, 0.f, 0.f, 0.f};
#pragma unroll
                    for (int u = 0; u < 5; ++u) {
                        const LAS unsigned char* vp = VT + (16 * dt + c) * VT_STRIDE + (16 * (w + 2 * u) + 4 * g) * 2;
                        const v2u lo = *(const LAS v2u*)vp; const v2u hi = (u < 4) ? *(const LAS v2u*)(vp + 32) : lo;
                        const v4u vv = (v4u){lo.x, lo.y, hi.x, hi.y};
                        o = __builtin_amdgcn_mfma_f32_16x16x32_bf16(__builtin_bit_cast(bf16x8, vv), P[u], o, 0, 0, 0);
                    }
                    o = o * inv;
                    ssq += (o[0] * o[0] + o[1] * o[1]) + (o[2] * o[2] + o[3] * o[3]);
                    v2u ow; ow.x = pg8::cvt_pk_bf16(o[0], o[1]); ow.y = pg8::cvt_pk_bf16(o[2], o[3]);
                    *(v2u*)(F.mix + (size_t)tq * D + CONVW + 64 * h + 16 * dt + 4 * g) = ow;
                }
            }
        }
        ssq += __shfl_xor(ssq, 16); ssq += __shfl_xor(ssq, 32);
        const float rstd = 1.f / sqrtf(ssq * (1.f / ATTNW) + EPS);
#pragma unroll 1
        for (int h = 0; h < 8; ++h)
#pragma unroll
            for (int dt = 0; dt < 4; ++dt) {
                const f32x4 gv = *(const f32x4*)(F.on_attn + 64 * h + 16 * dt + 4 * g);
                v2u* op = (v2u*)(F.mix + (size_t)tq * D + CONVW + 64 * h + 16 * dt + 4 * g);
                const v2u ow = *op;
                v2u o; o.x = pg8::cvt_pk_bf16(bflo(ow.x) * rstd * gv[0], bfhi(ow.x) * rstd * gv[1]); o.y = pg8::cvt_pk_bf16(bflo(ow.y) * rstd * gv[2], bfhi(ow.y) * rstd * gv[3]);
                *op = o;
            }
    }
    __syncthreads();
}

constexpr int RT_SCR_OFF = 133120, RT_CNT_OFF = RT_SCR_OFF + 8 * 16 * 33 * 4;
static_assert(RT_CNT_OFF + 256 <= LDS_BYTES && RT_SCR_OFF >= MISC_OFF + 128, "router LDS");
__device__ __forceinline__ void p3b_router(Frame& F, const bool commit) {
    const int lane = F.lane, fr = lane & 15, fq = lane >> 4, w = F.wave;
    LAS unsigned char* WL = F.lds;
    LAS float* scr = (LAS float*)(F.lds + RT_SCR_OFF) + w * (16 * 33);
    LAS unsigned* lcnt = (LAS unsigned*)(F.lds + RT_CNT_OFF); LAS unsigned* lbase = lcnt + 32;
    for (int ci = F.tid; ci < 2 * NEXP * 128; ci += NWAVES * 64) { const int row = ci >> 7, ch = ci & 127;
        *(LAS v4u*)(WL + row * 2048 + ((ch ^ (row & 15)) << 4)) = *(const v4u*)(F.WR + (size_t)row * D + ch * 8); }
    for (int chunk = F.vcu; chunk < T / 256; chunk += F.G) {
    if (F.tid < 32) lcnt[F.tid] = 0u;
    __syncthreads();
    int re[2][4]; unsigned rrank[2][4]; float rrs[2];
#pragma unroll
    for (int it = 0; it < 2; ++it) {
        const int tok0 = chunk * 256 + w * 32 + it * 16;
        f32x4 a0 = (f32x4){0.f, 0.f, 0.f, 0.f}, a1 = a0; float ss = 0.f;
        const bf16* xp = F.x1b + (size_t)(tok0 + fr) * D + 8 * fq;
#pragma unroll 1
        for (int s0 = 0; s0 < 32; s0 += 8) {
            v4u xa[8];
#pragma unroll
            for (int s = 0; s < 8; ++s) xa[s] = *(const v4u*)(xp + 32 * (s0 + s));
#pragma unroll
            for (int s = 0; s < 8; ++s) {
                float f[8]; unpack8(xa[s], f);
#pragma unroll
                for (int j = 0; j < 8; ++j) ss += f[j] * f[j];
                const int ch = 4 * (s0 + s) + fq; const bf16x8 av = __builtin_bit_cast(bf16x8, xa[s]);
                const bf16x8 h0 = *(const LAS bf16x8*)(WL + fr * 2048 + ((ch ^ fr) << 4)), h1 = *(const LAS bf16x8*)(WL + (16 + fr) * 2048 + ((ch ^ fr) << 4));
                const bf16x8 l0 = *(const LAS bf16x8*)(WL + (32 + fr) * 2048 + ((ch ^ fr) << 4)), l1 = *(const LAS bf16x8*)(WL + (48 + fr) * 2048 + ((ch ^ fr) << 4));
                a0 = __builtin_amdgcn_mfma_f32_16x16x32_bf16(av, h0, a0, 0, 0, 0); a1 = __builtin_amdgcn_mfma_f32_16x16x32_bf16(av, h1, a1, 0, 0, 0);
                a0 = __builtin_amdgcn_mfma_f32_16x16x32_bf16(av, l0, a0, 0, 0, 0); a1 = __builtin_amdgcn_mfma_f32_16x16x32_bf16(av, l1, a1, 0, 0, 0);
            }
        }
        ss += __shfl_xor(ss, 16); ss += __shfl_xor(ss, 32);
        const float rstd = 1.f / sqrtf(ss * (1.f / D) + EPS);
#pragma unroll
        for (int j = 0; j < 4; ++j) { scr[(4 * fq + j) * 33 + fr] = a0[j]; scr[(4 * fq + j) * 33 + 16 + fr] = a1[j]; }
        LDS_WAIT(); asm volatile("" ::: "memory");
        rrs[it] = rstd;
#pragma unroll
        for (int k = 0; k < 4; ++k) { re[it][k] = 0; rrank[it][k] = 0u; }
        if (lane < 16) {
            const int t = tok0 + lane;
            float lg[NEXP];
#pragma unroll
            for (int e = 0; e < NEXP; ++e) lg[e] = scr[lane * 33 + e] * rstd + F.b_router[e];
            float val[4]; unsigned used = 0u;
#pragma unroll
            for (int k = 0; k < 4; ++k) { int bi = 0; float bv = -INFINITY;
#pragma unroll
                for (int e = 0; e < NEXP; ++e) { const bool tk = !((used >> e) & 1u) && (lg[e] > bv); bv = tk ? lg[e] : bv; bi = tk ? e : bi; }
                re[it][k] = bi; val[k] = bv; used |= 1u << bi; }
            float pe[4], den = 0.f;
#pragma unroll
            for (int k = 0; k < 4; ++k) { pe[k] = __expf(val[k] - val[0]); den += pe[k]; }
            const float id = 1.f / den;
            *(f32x4*)(F.gate + (size_t)t * 4) = (f32x4){pe[0] * id, pe[1] * id, pe[2] * id, pe[3] * id};
            F.rstd[t] = rstd;
            if (commit) {
#pragma unroll
            for (int k = 0; k < 4; ++k) rrank[it][k] = __hip_atomic_fetch_add(lcnt + re[it][k], 1u, __ATOMIC_RELAXED, __HIP_MEMORY_SCOPE_WORKGROUP); }
        }
        LDS_WAIT(); asm volatile("" ::: "memory");
    }
    __syncthreads();
    if (F.tid < 32 && commit) lbase[F.tid] = __hip_atomic_fetch_add(F.ctl + CW_CNT + F.tid, lcnt[F.tid], RLX_AGENT);
    __syncthreads();
    if (lane < 16 && commit) {
#pragma unroll
        for (int it = 0; it < 2; ++it) { const int t = chunk * 256 + w * 32 + it * 16 + lane;
#pragma unroll
            for (int k = 0; k < 4; ++k) { const size_t p = (size_t)re[it][k] * T + lbase[re[it][k]] + rrank[it][k]; F.dest[p] = (unsigned)(t * 4 + k); F.rsl[p] = rrs[it]; } }
    }
    __syncthreads();
    }
}

__device__ __forceinline__ void p6_combine(Frame& F) {
    const int gw = F.vcu * NWAVES + F.wave, NGW = F.G * NWAVES, lane = F.lane;
    for (int t = gw * 2; t < T; t += NGW * 2) {
        v4u xb[2][2], yv[2][4][2]; f32x4 gt[2];
#pragma unroll
        for (int q = 0; q < 2; ++q) {
            const bf16* xp = F.x1b + (size_t)(t + q) * D + 8 * lane; xb[q][0] = *(const v4u*)xp; xb[q][1] = *(const v4u*)(xp + 512);
            gt[q] = *(const f32x4*)(F.gate + (size_t)(t + q) * 4);
#pragma unroll
            for (int k = 0; k < 4; ++k) { const bf16* yp = F.ys + ((size_t)(t + q) * 4 + k) * D + 8 * lane; yv[q][k][0] = *(const v4u*)yp; yv[q][k][1] = *(const v4u*)(yp + 512); }
        }
#pragma unroll
        for (int q = 0; q < 2; ++q)
#pragma unroll
            for (int hf = 0; hf < 2; ++hf) {
                float o[8]; unpack8(xb[q][hf], o);
#pragma unroll
                for (int k = 0; k < 4; ++k) { float y[8]; unpack8(yv[q][k][hf], y);
#pragma unroll
                    for (int j = 0; j < 8; ++j) o[j] += gt[q][k] * y[j]; }
                float* op = F.out + (size_t)(t + q) * D + 512 * hf + 8 * lane;
                *(f32x4*)op = (f32x4){o[0], o[1], o[2], o[3]}; *(f32x4*)(op + 4) = (f32x4){o[4], o[5], o[6], o[7]};
            }
    }
}
constexpr int N_PHASES = 8;
struct Args { const float* in[20]; float* out; unsigned char* ws; int ph_lo, ph_hi, li, pad; };
__global__ void __launch_bounds__(NWAVES * 64, 2) mega_fwd(Args) {
    extern __shared__ __attribute__((aligned(16))) unsigned char lds[];
    Frame F;
    F.lds = (LAS unsigned char*)lds;
    F.MISC = (volatile LAS unsigned*)(F.lds + MISC_OFF);
    F.tid = threadIdx.x; F.lane = F.tid & 63; F.wave = __builtin_amdgcn_readfirstlane(F.tid >> 6);
    F.G = gridDim.x; { const int bx = blockIdx.x; F.vcu = (F.G % 8 == 0) ? (bx % 8) * (F.G / 8) + bx / 8 : bx; }
    typedef const __attribute__((address_space(4))) unsigned char* kptr_t;
    const kptr_t ka = (kptr_t)__builtin_amdgcn_kernarg_segment_ptr();
#define KIN(k) (*(const float* const __attribute__((address_space(4)))*)(ka + 8 * (k)))
#define KWS() (*(unsigned char* const __attribute__((address_space(4)))*)(ka + 168))
#define KOUT() (*(float* const __attribute__((address_space(4)))*)(ka + 160))
#define KINT(off) (*(const int __attribute__((address_space(4)))*)(ka + (off)))
#define FRAME_PTRS() do { unsigned char* ws = KWS(); \
    F.x = KIN(0); F.norm_mix = KIN(1); F.w_in = KIN(2); F.b_in = KIN(3); F.conv_w = KIN(4); F.q_norm = KIN(5); F.k_norm = KIN(6); F.sinks = KIN(7); \
    F.rel_bias = KIN(8); F.on_conv = KIN(9); F.on_attn = KIN(10); F.w_out = KIN(11); F.b_out = KIN(12); F.norm_ffn = KIN(13); F.w_router = KIN(14); F.b_router = KIN(15); \
    F.w1 = KIN(16); F.b1 = KIN(17); F.w2 = KIN(18); F.b2 = KIN(19); F.out = KOUT(); \
    F.WinT = (bf16*)(ws + WS_WINT); F.WoutT = (bf16*)(ws + WS_WOUTT); F.W1Q = ws + WS_W1T; F.W2Q = ws + WS_W2T; F.WR = (bf16*)(ws + WS_WR); F.x1q = ws + WS_X1Q; F.act = ws + WS_ACT; \
    F.B1S = (float*)(ws + WS_B1); F.rstd = (float*)(ws + WS_RSTD); F.gate = (float*)(ws + WS_GATE); F.rsl = (float*)(ws + WS_RSL); F.dest = (unsigned*)(ws + WS_DEST); \
    F.xn = (bf16*)(ws + WS_XN); F.proj = (bf16*)(ws + WS_PROJ); F.mix = (bf16*)(ws + WS_MIX); F.x1b = (bf16*)(ws + WS_X1B); F.ys = (bf16*)(ws + WS_YS); } while (0)
    static_assert(sizeof(Args) == 192 && offsetof(Args, out) == 160 && offsetof(Args, ws) == 168 && offsetof(Args, ph_lo) == 176 && offsetof(Args, li) == 184, "kernarg layout");
    F.ctl = (gu32*)(KWS() + WS_CTL);
    for (int u = F.tid; u < (MISC_OFF + 128 - MOE_OFF) / 4; u += NWAVES * 64) ((LAS unsigned*)(F.lds + MOE_OFF))[u] = 0u;
    __syncthreads();
    XcdBarrier bar = xcd_barrier_post((unsigned*)(F.ctl + CW_BAR) + KINT(184) * XCD_BAR_WORDS, F.MISC + 8);
    const int lo = KINT(176), hi = KINT(180);
#ifndef COMPILE_MASK
#define COMPILE_MASK 0xFF
#endif
#define IN(k) (((COMPILE_MASK >> (k)) & 1) && lo <= (k) && (k) < hi)
#define SEAM(k) do { if (IN(k) && IN((k) + 1)) xcd_barrier(bar); } while (0)
#ifndef REPEAT_MASK
#define REPEAT_MASK 0
#endif
#define REPS(k) (((REPEAT_MASK >> (k)) & 1) ? 2 : 1)

    if (IN(0)) { FRAME_PTRS(); for (int rep = 0; rep < REPS(0); ++rep) p0_prologue(F); } SEAM(0);
    if (IN(1)) {
        FRAME_PTRS();
        pg8::DenseOrder S; S.init(F.xn, F.WinT, T, INW, D, F.G, (int)blockIdx.x);
        EpiIn E{F.proj, F.b_in};
        for (int rep = 0; rep < REPS(1); ++rep) pg8::gemm_phase<EpiIn, pg8::DenseOrder, false, true>(F.lds + RING_OFF, D, S, E);
    } SEAM(1);
    if (IN(2)) { FRAME_PTRS(); for (int rep = 0; rep < REPS(2); ++rep) { p2_conv(F); p2_attn(F); } } SEAM(2);
    if (IN(3)) {
        FRAME_PTRS();
        pg8::DenseOrder S; S.init(F.mix, F.WoutT, T, D, D, F.G, (int)blockIdx.x);
        EpiOut E{F.x1b, F.b_out, F.x, F.x1q};
        for (int rep = 0; rep < REPS(3); ++rep) pg8::gemm_phase<EpiOut, pg8::DenseOrder, false, true>(F.lds + RING_OFF, D, S, E);
    } SEAM(3);
    if (IN(4)) { FRAME_PTRS(); for (int rep = 0; rep < REPS(4); ++rep) p3b_router(F, rep == REPS(4) - 1); } SEAM(4);
    if (IN(5)) {
        FRAME_PTRS();
        const int NT = moe_tables(F);
        const LAS int* tile0 = (const LAS int*)(F.lds + MOE_OFF); const LAS int* ecnt = tile0 + 40;
        MoeOrder<true> S{(const char*)F.x1q, (const char*)F.W1Q, (size_t)2 * DFF * D, (size_t)256 * D, 2 * DFF / 256, F.G, (int)blockIdx.x, NT, tile0, ecnt, F.dest};
        EpiW1 E{F.act, F.B1S, F.rsl, ecnt};
        for (int rep = 0; rep < REPS(5); ++rep) pg8::gemm_phase<EpiW1, MoeOrder<true>, true, true, true>(F.lds + RING_OFF, D / 2, S, E);
    } SEAM(5);
    if (IN(6)) {
        FRAME_PTRS();
        const int NT = moe_tables(F);
        const LAS int* tile0 = (const LAS int*)(F.lds + MOE_OFF); const LAS int* ecnt = tile0 + 40;
        MoeOrder<false> S{(const char*)F.act, (const char*)F.W2Q, (size_t)D * DFF, (size_t)256 * DFF, D / 256, F.G, (int)blockIdx.x, NT, tile0, ecnt, F.dest};
#ifndef P6_KREP
#define P6_KREP 1
#endif
#ifndef P6_EREP
#define P6_EREP 1
#endif
        EpiW2 E{F.ys, F.b2, F.dest, ecnt, 1.0f / (W_SCALE * ACT_SCALE), (bf16*)(KWS() + WS_DUMMY)};
        for (int rep = 0; rep < REPS(6); ++rep) pg8::gemm_phase<EpiW2, MoeOrder<false>, true, true, true>(F.lds + RING_OFF, DFF / 2, S, E);
    } SEAM(6);
    if (IN(7)) { FRAME_PTRS(); for (int rep = 0; rep < REPS(7); ++rep) p6_combine(F); }
#undef IN
#undef SEAM
}

#ifndef FAST_MASK
#define FAST_MASK 0xFF
#endif
extern "C" void kernel_launch(void* const* d_in, const int* in_sizes, int n_in, void* d_out, int out_size, void* d_ws, size_t ws_size, hipStream_t stream) {
    static int grid = 0;
    if (grid == 0) {
        if (n_in != 20 || in_sizes[0] != T * D || out_size != T * D || ws_size < WS_END) { fprintf(stderr, "kernel_launch: unexpected shapes (n_in %d, in0 %d, out %d, ws %zu); nothing launched\n", n_in, n_in > 0 ? in_sizes[0] : -1, out_size, ws_size); grid = -1; return; }
        int dev = 0, cus = 0, per_cu = 0;
        if (hipGetDevice(&dev) != hipSuccess || hipDeviceGetAttribute(&cus, hipDeviceAttributeMultiprocessorCount, dev) != hipSuccess) { grid = -1; return; }
        if (hipFuncSetAttribute((const void*)mega_fwd, hipFuncAttributeMaxDynamicSharedMemorySize, LDS_BYTES) != hipSuccess) { fprintf(stderr, "kernel_launch: hipFuncSetAttribute failed\n"); grid = -1; return; }
        if (hipOccupancyMaxActiveBlocksPerMultiprocessor(&per_cu, (const void*)mega_fwd, NWAVES * 64, LDS_BYTES) != hipSuccess || per_cu < 1) fprintf(stderr, "kernel_launch: note: occupancy query reports %d\n", per_cu);
        (void)hipGetLastError();
        grid = cus;
        if (grid != 256) fprintf(stderr, "kernel_launch: %d CUs (built for 256)\n", grid);
    }
    if (grid < 0) return;
    const float* const* in = (const float* const*)d_in;
    unsigned char* ws = (unsigned char*)d_ws; float* out = (float*)d_out;
    (void)hipMemsetAsync(ws + WS_CTL, 0, CTL_ZERO_BYTES, stream);
    Args a{};
    for (int i = 0; i < 20; ++i) a.in[i] = in[i];
    a.out = out; a.ws = ws;
    unsigned* cnt = (unsigned*)(ws + WS_CTL) + CW_CNT;
    bf16* xn = (bf16*)(ws + WS_XN); bf16* proj = (bf16*)(ws + WS_PROJ); bf16* mix = (bf16*)(ws + WS_MIX); bf16* x1b = (bf16*)(ws + WS_X1B);
    float* rstd = (float*)(ws + WS_RSTD); float* gate = (float*)(ws + WS_GATE); float* rsl = (float*)(ws + WS_RSL); unsigned* dest = (unsigned*)(ws + WS_DEST);
    bf16* ys = (bf16*)(ws + WS_YS);
    static_assert(((FAST_MASK >> 5) & 3) == 3, "the MoE GEMM phases have no naive twin in the fp8 build");
    int li = 0;
    for (int p = 0; p < N_PHASES;) {
        if ((FAST_MASK >> p) & 1) {
            int q = p; while (q < N_PHASES && ((FAST_MASK >> q) & 1)) ++q;
            a.ph_lo = p; a.ph_hi = q; a.li = li++;
            hipLaunchKernelGGL(mega_fwd, dim3(grid), dim3(NWAVES * 64), LDS_BYTES, stream, a);
            p = q; continue;
        }
        switch (p) {
        case 0: a.ph_lo = 0; a.ph_hi = 1; a.li = li++; hipLaunchKernelGGL(mega_fwd, dim3(grid), dim3(NWAVES * 64), LDS_BYTES, stream, a);
                hipLaunchKernelGGL(nv::k_rms_in, dim3(T / 4), dim3(256), 0, stream, in[0], in[1], xn); break;
        case 1: { nv::OpIn op{xn, in[2], in[3], proj, 0, 0}; hipLaunchKernelGGL((nv::k_gemm<nv::OpIn>), dim3(INW / 128, T / 128), dim3(256), 0, stream, op, D); } break;
        case 2: hipLaunchKernelGGL(nv::k_conv, dim3(T), dim3(512), 0, stream, proj, in[4], in[9], mix);
                hipLaunchKernelGGL(nv::k_attn, dim3(T), dim3(512), 0, stream, proj, in[5], in[6], in[7], in[8], in[10], mix); break;
        case 3: { nv::OpOut op{mix, in[11], in[12], in[0], x1b, 0, 0}; hipLaunchKernelGGL((nv::k_gemm<nv::OpOut>), dim3(D / 128, T / 128), dim3(256), 0, stream, op, D); } break;
        case 4: hipLaunchKernelGGL(nv::k_router, dim3(T / 4), dim3(256), 0, stream, x1b, in[13], in[14], in[15], rstd, gate, dest, rsl, cnt); break;
        case 7: hipLaunchKernelGGL(nv::k_combine, dim3(T * D / 256), dim3(256), 0, stream, x1b, ys, gate, out); break;
        }
        ++p;
    }
}
```

```cpp
#include <hip/hip_runtime.h>
#include <cstdio>
#include <cstdint>
#include <cstddef>
#include <cmath>

constexpr int BATCH = 8, SEQ = 8192, D = 1024, T = BATCH * SEQ;
constexpr int HD = 64, CONVW = 512, NQH = 8, NKVH = 2, QPKV = 4, ATTNW = 512, KVW = 128, INW = 2304;
constexpr int NEXP = 32, TOPK = 4, DFF = 1024;
constexpr float EPS = 1e-5f;
constexpr int QOFF = 3 * CONVW, KOFF = QOFF + ATTNW, VOFF = KOFF + KVW;
constexpr int PW = 1792, P_CU = 512, P_Q = 1024, P_K = 1536, P_V = 1664;

constexpr size_t MiB = 1u << 20;
constexpr size_t WS_CTL = 0, CTL_ZERO_BYTES = 1 * MiB;
constexpr size_t WS_RSTD = 1 * MiB;
constexpr size_t WS_WR = 1 * MiB + 512 * 1024;
constexpr size_t WS_B1 = 1 * MiB + 768 * 1024;
constexpr size_t WS_RSA = 3 * MiB;
constexpr size_t WS_GATE = 2 * MiB;
constexpr size_t WS_DEST = 4 * MiB;
constexpr size_t WS_RSL = 12 * MiB;
constexpr size_t WS_W2T = 20 * MiB;
constexpr size_t WS_W1T = 52 * MiB;
constexpr size_t WS_DUMMY = 116 * MiB;
constexpr size_t WS_X1B = 120 * MiB;
constexpr size_t WS_XN = 872 * MiB;
constexpr size_t WS_RIN = 1 * MiB + 256 * 1024;
constexpr size_t WS_GINV = 1 * MiB + 640 * 1024;
constexpr size_t WS_ACT = 248 * MiB;
constexpr size_t WS_MIX = WS_ACT;
constexpr size_t WS_YS = 512 * MiB;
constexpr size_t WS_PROJ = 512 * MiB;
constexpr size_t WS_WINT = 800 * MiB;
constexpr size_t WS_WOUTT = 805 * MiB;
constexpr size_t WS_X1Q = 808 * MiB;
constexpr size_t WS_END = 1024 * MiB;
static_assert(WS_PROJ + (size_t)T * INW * 2 <= WS_WINT && WS_YS + (size_t)T * 4 * D * 2 <= WS_END && WS_ACT + 264 * MiB <= WS_YS && WS_W1T + 64 * MiB <= WS_X1B && WS_W2T + 32 * MiB <= WS_W1T && WS_X1B + 128 * MiB <= WS_ACT && WS_X1Q + 64 * MiB <= WS_XN && WS_XN + 128 * MiB <= WS_END, "ws map");
constexpr float W_SCALE = 32.0f, ACT_SCALE = 4.0f, YS_SCALE = 8.0f;
constexpr int ACT_LO_TILES = 0;
constexpr int CW_TMO = 0, CW_CODE = 1;
constexpr int CW_CNT = 64;
constexpr int CW_BAR = 4096;

typedef unsigned short bf16;
typedef unsigned v4u __attribute__((ext_vector_type(4)));
typedef unsigned v2u __attribute__((ext_vector_type(2)));
typedef float f32x4 __attribute__((ext_vector_type(4)));
typedef float f32x2 __attribute__((ext_vector_type(2)));
typedef short bf16x8 __attribute__((ext_vector_type(8)));
typedef int i32x4 __attribute__((ext_vector_type(4)));
typedef int i32x8 __attribute__((ext_vector_type(8)));

__device__ __forceinline__ unsigned f2bf(float f) { unsigned u = __builtin_bit_cast(unsigned, f); return (u + 0x7fffu + ((u >> 16) & 1u)) >> 16; }
__device__ __forceinline__ unsigned pk2(float lo, float hi) { return f2bf(lo) | (f2bf(hi) << 16); }
__device__ __forceinline__ float bf2f(bf16 b) { return __builtin_bit_cast(float, (unsigned)b << 16); }
__device__ __forceinline__ float bflo(unsigned w) { return __builtin_bit_cast(float, w << 16); }
__device__ __forceinline__ float bfhi(unsigned w) { return __builtin_bit_cast(float, w & 0xffff0000u); }
__device__ __forceinline__ unsigned pk4_fp8(float a, float b, float c, float d) { int w = __builtin_bit_cast(int, a);
    w = __builtin_amdgcn_cvt_pk_fp8_f32(a, b, w, false); w = __builtin_amdgcn_cvt_pk_fp8_f32(c, d, w, true); return (unsigned)w; }
__device__ __forceinline__ float wave_sum(float v) {
#pragma unroll
    for (int o = 1; o < 64; o <<= 1) v += __shfl_xor(v, o);
    return v;
}
__device__ __forceinline__ float swiglu(float gl, float ln) {
    gl = fminf(gl, 7.0f); ln = fminf(fmaxf(ln, -7.0f), 7.0f);
    return gl * (1.0f / (1.0f + __expf(-1.702f * gl))) * (ln + 1.0f);
}
__device__ __forceinline__ f32x2 swiglu2_scaled(f32x2 gl, f32x2 ln) {
    gl.x = fminf(gl.x, 7.0f); gl.y = fminf(gl.y, 7.0f);
    ln.x = __builtin_amdgcn_fmed3f(ln.x, -7.0f, 7.0f); ln.y = __builtin_amdgcn_fmed3f(ln.y, -7.0f, 7.0f);
    const f32x2 z = gl * (-1.702f * 1.4426950408889634f);
    f32x2 e; e.x = __builtin_amdgcn_exp2f(z.x); e.y = __builtin_amdgcn_exp2f(z.y);
    e = e + 1.0f;
    f32x2 r; r.x = __builtin_amdgcn_rcpf(e.x); r.y = __builtin_amdgcn_rcpf(e.y);
    return (gl * r) * (ln * ACT_SCALE + ACT_SCALE);
}
__device__ __forceinline__ f32x2 swiglu2_pre(f32x2 gl, f32x2 l4) {
    gl.x = fminf(gl.x, 7.0f); gl.y = fminf(gl.y, 7.0f);
    l4.x = __builtin_amdgcn_fmed3f(l4.x, -6.0f * ACT_SCALE, 8.0f * ACT_SCALE); l4.y = __builtin_amdgcn_fmed3f(l4.y, -6.0f * ACT_SCALE, 8.0f * ACT_SCALE);
    const f32x2 z = gl * (-1.702f * 1.4426950408889634f);
    f32x2 e; e.x = __builtin_amdgcn_exp2f(z.x); e.y = __builtin_amdgcn_exp2f(z.y);
    e = e + 1.0f;
    f32x2 r; r.x = __builtin_amdgcn_rcpf(e.x); r.y = __builtin_amdgcn_rcpf(e.y);
    return (gl * r) * l4;
}
constexpr float SWI_CZ = -1.702f * 1.4426950408889634f, SWI_ICZ = 1.0f / SWI_CZ;
__device__ __forceinline__ f32x2 swiglu2_z(f32x2 z, f32x2 lz) {
    z.x = fmaxf(z.x, 7.0f * SWI_CZ); z.y = fmaxf(z.y, 7.0f * SWI_CZ);
    lz.x = __builtin_amdgcn_fmed3f(lz.x, 8.0f * ACT_SCALE * SWI_ICZ, -6.0f * ACT_SCALE * SWI_ICZ); lz.y = __builtin_amdgcn_fmed3f(lz.y, 8.0f * ACT_SCALE * SWI_ICZ, -6.0f * ACT_SCALE * SWI_ICZ);
    f32x2 e; e.x = __builtin_amdgcn_exp2f(z.x); e.y = __builtin_amdgcn_exp2f(z.y);
    e = e + 1.0f;
    f32x2 r; r.x = __builtin_amdgcn_rcpf(e.x); r.y = __builtin_amdgcn_rcpf(e.y);
    return (z * r) * lz;
}
__device__ __forceinline__ bf16* act_row(bf16* lo, bf16* hi, int slot) { return slot < ACT_LO_TILES * 256 ? lo + (size_t)slot * DFF : hi + (size_t)(slot - ACT_LO_TILES * 256) * DFF; }
__device__ const unsigned char T5B[128] = {0, 1, 2, 3, 4, 5, 6, 7, 8, 9, 10, 11, 12, 13, 14, 15, 16, 16, 16, 17, 17, 18, 18, 18, 19, 19, 19, 20, 20, 20, 20, 21, 21, 21, 21, 22, 22, 22, 22, 22, 23, 23, 23, 23, 23, 23, 24, 24, 24, 24, 24, 24, 25, 25, 25, 25, 25, 25, 25, 26, 26, 26, 26, 26, 26, 26, 26, 27, 27, 27, 27, 27, 27, 27, 27, 27, 27, 28, 28, 28, 28, 28, 28, 28, 28, 28, 28, 29, 29, 29, 29, 29, 29, 29, 29, 29, 29, 29, 29, 30, 30, 30, 30, 30, 30, 30, 30, 30, 30, 30, 30, 30, 30, 31, 31, 31, 31, 31, 31, 31, 31, 31, 31, 31, 31, 31, 31, 31};
#define FAST_MASK 0xFF
#define REPEAT_MASK 0

namespace nv {

__global__ void __launch_bounds__(256) k_rms_in(const float* __restrict__ x, const float* __restrict__ g, bf16* __restrict__ xn) {
    const int row = blockIdx.x * 4 + (threadIdx.x >> 6), lane = threadIdx.x & 63;
    const float* xr = x + (size_t)row * D;
    float v[16]; float ss = 0.f;
#pragma unroll
    for (int j = 0; j < 16; ++j) { v[j] = xr[lane + 64 * j]; ss += v[j] * v[j]; }
    ss = wave_sum(ss);
    const float rstd = 1.0f / sqrtf(ss * (1.0f / D) + EPS);
#pragma unroll
    for (int j = 0; j < 16; ++j) xn[(size_t)row * D + lane + 64 * j] = (bf16)f2bf(v[j] * rstd * g[lane + 64 * j]);
}

struct TileInfo { int valid; int e; int row0; int nrows; };

template <class Op>
__global__ void __launch_bounds__(256) k_gemm(Op op, int K) {
    __shared__ float As[16][132];
    __shared__ float Bs[16][132];
    const int tid = threadIdx.x, tx = tid & 15, ty = tid >> 4;
    if (!op.setup(blockIdx.y, blockIdx.x)) return;
    float acc[8][8];
#pragma unroll
    for (int i = 0; i < 8; ++i)
#pragma unroll
        for (int j = 0; j < 8; ++j) acc[i][j] = 0.f;
    const int ar = tid >> 1, ah = tid & 1;
    const bf16* arow = op.a_row(ar);
    const float* wcol = op.w_base() + (tid & 15) * 8;
    const int wk = tid >> 4;
    for (int k0 = 0; k0 < K; k0 += 16) {
        uint4 av = *(const uint4*)(arow + k0 + ah * 8);
        const unsigned aw[4] = {av.x, av.y, av.z, av.w};
#pragma unroll
        for (int j = 0; j < 4; ++j) {
            As[ah * 8 + 2 * j][ar] = bf2f((bf16)(aw[j] & 0xffff)) * op.a_scale(k0 + ah * 8 + 2 * j);
            As[ah * 8 + 2 * j + 1][ar] = bf2f((bf16)(aw[j] >> 16)) * op.a_scale(k0 + ah * 8 + 2 * j + 1);
        }
        const float4 w0 = *(const float4*)(wcol + (size_t)(k0 + wk) * op.ldw());
        const float4 w1 = *(const float4*)(wcol + (size_t)(k0 + wk) * op.ldw() + 4);
        *(float4*)&Bs[wk][(tid & 15) * 8] = w0; *(float4*)&Bs[wk][(tid & 15) * 8 + 4] = w1;
        __syncthreads();
#pragma unroll
        for (int kk = 0; kk < 16; ++kk) {
            float a[8], b[8];
#pragma unroll
            for (int i = 0; i < 8; ++i) a[i] = As[kk][ty * 8 + i];
#pragma unroll
            for (int j = 0; j < 8; ++j) b[j] = Bs[kk][tx * 8 + j];
#pragma unroll
            for (int i = 0; i < 8; ++i)
#pragma unroll
                for (int j = 0; j < 8; ++j) acc[i][j] += a[i] * b[j];
        }
        __syncthreads();
    }
#pragma unroll
    for (int i = 0; i < 8; ++i) op.epi(ty * 8 + i, tx * 8, acc[i]);
}

struct OpIn {
    const bf16* xn; const float* w; const float* b; bf16* proj; int by, bx;
    __device__ bool setup(int by_, int bx_) { by = by_; bx = bx_; return true; }
    __device__ const bf16* a_row(int r) const { return xn + (size_t)(by * 128 + r) * D; }
    __device__ const float* w_base() const { return w + bx * 128; }
    __device__ int ldw() const { return INW; }
    __device__ float a_scale(int) const { return 1.f; }
    __device__ void epi(int r, int c0, const float* v) const {
        const int row = by * 128 + r, col = bx * 128 + c0;
#pragma unroll
        for (int j = 0; j < 8; ++j) proj[(size_t)row * INW + col + j] = (bf16)f2bf(v[j] + b[col + j]);
    }
};
struct OpOut {
    const bf16* mix; const float* w; const float* b; const float* x; bf16* x1b; int by, bx;
    __device__ bool setup(int by_, int bx_) { by = by_; bx = bx_; return true; }
    __device__ const bf16* a_row(int r) const { return mix + (size_t)(by * 128 + r) * D; }
    __device__ const float* w_base() const { return w + bx * 128; }
    __device__ int ldw() const { return D; }
    __device__ float a_scale(int) const { return 1.f; }
    __device__ void epi(int r, int c0, const float* v) const {
        const int row = by * 128 + r, col = bx * 128 + c0;
#pragma unroll
        for (int j = 0; j < 8; ++j) x1b[(size_t)row * D + col + j] = (bf16)f2bf(x[(size_t)row * D + col + j] + v[j] + b[col + j]);
    }
};
__device__ inline bool moe_tile(const unsigned* cnt, int t128, int& e, int& pos0, int& slot0) {
    int base = 0;
    for (int i = 0; i < NEXP; ++i) { const int n128 = 2 * (((int)cnt[i] + 255) / 256); if (t128 < base + n128) { e = i; pos0 = (t128 - base) * 128; slot0 = base * 128 + pos0; return true; } base += n128; }
    return false;
}
struct OpW1 {
    const bf16* x1b; const float* w1; const float* b1; const float* g; const float* rstd; const unsigned* cnt; const unsigned* dest; bf16* act_lo; bf16* act_hi;
    int e, pos0, slot0, bx;
    __device__ bool setup(int by_, int bx_) { bx = bx_; return moe_tile(cnt, by_, e, pos0, slot0); }
    __device__ int tok(int r) const { const int pos = pos0 + r; return pos < (int)cnt[e] ? (int)(dest[(size_t)e * T + pos] >> 2) : 0; }
    __device__ const bf16* a_row(int r) const { return x1b + (size_t)tok(r) * D; }
    __device__ const float* w_base() const { return w1 + (size_t)e * D * 2 * DFF + bx * 128; }
    __device__ int ldw() const { return 2 * DFF; }
    __device__ float a_scale(int k) const { return g[k]; }
    __device__ void epi(int r, int c0, const float* v) const {
        const int slot = slot0 + r; const float rs = rstd[tok(r)];
        bf16* arow = act_row(act_lo, act_hi, slot);
        const int col = bx * 128 + c0;
#pragma unroll
        for (int j = 0; j < 4; ++j) {
            const float gl = v[2 * j] * rs + b1[(size_t)e * 2 * DFF + col + 2 * j], ln = v[2 * j + 1] * rs + b1[(size_t)e * 2 * DFF + col + 2 * j + 1];
            arow[(col >> 1) + j] = (bf16)f2bf(swiglu(gl, ln));
        }
    }
};
struct OpW2 {
    const bf16* act_lo; const bf16* act_hi; const float* w2; const float* b2; const unsigned* cnt; const unsigned* dest; bf16* ys;
    int e, pos0, slot0, bx;
    __device__ bool setup(int by_, int bx_) { bx = bx_; return moe_tile(cnt, by_, e, pos0, slot0); }
    __device__ const bf16* a_row(int r) const { return act_row((bf16*)act_lo, (bf16*)act_hi, slot0 + r); }
    __device__ const float* w_base() const { return w2 + (size_t)e * DFF * D + bx * 128; }
    __device__ int ldw() const { return D; }
    __device__ float a_scale(int) const { return 1.f; }
    __device__ void epi(int r, int c0, const float* v) const {
        const int pos = pos0 + r; if (pos >= (int)cnt[e]) return;
        const unsigned d = dest[(size_t)e * T + pos]; const int col = bx * 128 + c0;
#pragma unroll
        for (int j = 0; j < 8; ++j) ys[(size_t)d * D + col + j] = (bf16)f2bf(v[j] + b2[(size_t)e * D + col + j]);
    }
};

__global__ void __launch_bounds__(512) k_conv(const bf16* __restrict__ proj, const float* __restrict__ cw, const float* __restrict__ g, bf16* __restrict__ mix) {
    __shared__ float red[8];
    const int t = blockIdx.x, c = threadIdx.x, s = t % SEQ;
    const bf16* p = proj + (size_t)t * INW;
    float cu0 = bf2f(p[CONVW + c]) * bf2f(p[2 * CONVW + c]), cu1 = 0.f, cu2 = 0.f;
    if (s >= 1) cu1 = bf2f(p[CONVW + c - INW]) * bf2f(p[2 * CONVW + c - INW]);
    if (s >= 2) cu2 = bf2f(p[CONVW + c - 2 * INW]) * bf2f(p[2 * CONVW + c - 2 * INW]);
    const float y = bf2f(p[c]) * (cw[2 * CONVW + c] * cu0 + cw[CONVW + c] * cu1 + cw[c] * cu2);
    float ss = wave_sum(y * y);
    if ((c & 63) == 0) red[c >> 6] = ss;
    __syncthreads();
    ss = 0.f;
#pragma unroll
    for (int i = 0; i < 8; ++i) ss += red[i];
    const float rstd = 1.0f / sqrtf(ss * (1.0f / CONVW) + EPS);
    mix[(size_t)t * D + c] = (bf16)f2bf(y * rstd * g[c]);
}
__global__ void __launch_bounds__(512) k_attn(const bf16* __restrict__ proj, const float* __restrict__ qg, const float* __restrict__ kg, const float* __restrict__ sinks,
                                              const float* __restrict__ rel_bias, const float* __restrict__ g, bf16* __restrict__ mix) {
    __shared__ float qs[8][64];
    __shared__ float ps[8][128];
    __shared__ float red[8];
    const int t = blockIdx.x, h = threadIdx.x >> 6, lane = threadIdx.x & 63, s = t % SEQ, kv = h / QPKV;
    const bf16* p = proj + (size_t)t * INW;
    {
        const float q = bf2f(p[3 * CONVW + h * HD + lane]);
        const float ss = wave_sum(q * q);
        qs[h][lane] = q * (1.0f / sqrtf(ss * (1.0f / HD) + EPS)) * qg[lane] * 0.125f;
    }
    __syncthreads();
    float lg[2];
#pragma unroll
    for (int i = 0; i < 2; ++i) {
        const int rel = lane + 64 * i;
        lg[i] = -INFINITY;
        if (rel <= s) {
            const bf16* kr = p - (size_t)rel * INW + 3 * CONVW + ATTNW + kv * HD;
            float ss = 0.f, dot = 0.f;
            for (int d = 0; d < HD; ++d) { const float k = bf2f(kr[d]); ss += k * k; dot += k * kg[d] * qs[h][d]; }
            lg[i] = dot * (1.0f / sqrtf(ss * (1.0f / HD) + EPS)) + rel_bias[T5B[rel] * NQH + h];
        }
    }
    const float sk = sinks[h];
    float m = fmaxf(fmaxf(lg[0], lg[1]), sk);
#pragma unroll
    for (int o = 1; o < 64; o <<= 1) m = fmaxf(m, __shfl_xor(m, o));
    const float p0 = (lg[0] == -INFINITY) ? 0.f : expf(lg[0] - m), p1 = (lg[1] == -INFINITY) ? 0.f : expf(lg[1] - m);
    const float den = wave_sum(p0 + p1) + expf(sk - m);
    ps[h][lane] = p0 / den; ps[h][lane + 64] = p1 / den;
    __syncthreads();
    float o = 0.f;
    const int nk = s < 127 ? s + 1 : 128;
    for (int rel = 0; rel < nk; ++rel) o += ps[h][rel] * bf2f(p[-(ptrdiff_t)rel * INW + 3 * CONVW + ATTNW + KVW + kv * HD + lane]);
    float ss = wave_sum(o * o);
    if (lane == 0) red[h] = ss;
    __syncthreads();
    ss = 0.f;
#pragma unroll
    for (int i = 0; i < 8; ++i) ss += red[i];
    const float rstd = 1.0f / sqrtf(ss * (1.0f / ATTNW) + EPS);
    mix[(size_t)t * D + CONVW + h * HD + lane] = (bf16)f2bf(o * rstd * g[h * HD + lane]);
}
__global__ void __launch_bounds__(256) k_router(const bf16* __restrict__ x1b, const float* __restrict__ g, const float* __restrict__ wr, const float* __restrict__ br,
                                                float* __restrict__ rstd_o, float* __restrict__ gate_tk, unsigned* __restrict__ dest, float* __restrict__ rsl, unsigned* cnt) {
    const int t = blockIdx.x * 4 + (threadIdx.x >> 6), lane = threadIdx.x & 63;
    float h[16]; float ss = 0.f;
#pragma unroll
    for (int j = 0; j < 16; ++j) { const float v = bf2f(x1b[(size_t)t * D + lane + 64 * j]); ss += v * v; h[j] = v * g[lane + 64 * j]; }
    ss = wave_sum(ss);
    const float rstd = 1.0f / sqrtf(ss * (1.0f / D) + EPS);
    float lg[NEXP];
    for (int e = 0; e < NEXP; ++e) {
        float a = 0.f;
#pragma unroll
        for (int j = 0; j < 16; ++j) a += h[j] * wr[(size_t)(lane + 64 * j) * NEXP + e];
        lg[e] = wave_sum(a) * rstd + br[e];
    }
    if (lane == 0) {
        rstd_o[t] = rstd;
        int idx[4]; float val[4];
        unsigned used = 0u;
        for (int k = 0; k < 4; ++k) { int bi = -1; float bv = -INFINITY; for (int e = 0; e < NEXP; ++e) if (!((used >> e) & 1u) && lg[e] > bv) { bv = lg[e]; bi = e; } idx[k] = bi; val[k] = bv; used |= 1u << bi; }
        float den = 0.f, pe[4];
        for (int k = 0; k < 4; ++k) { pe[k] = expf(val[k] - val[0]); den += pe[k]; }
        for (int k = 0; k < 4; ++k) {
            gate_tk[t * 4 + k] = pe[k] / den;
            const unsigned pos = atomicAdd(&cnt[idx[k]], 1u);
            dest[(size_t)idx[k] * T + pos] = (unsigned)(t * 4 + k); rsl[(size_t)idx[k] * T + pos] = rstd;
        }
    }
}
__global__ void __launch_bounds__(256) k_combine(const bf16* __restrict__ x1b, const bf16* __restrict__ ys, const float* __restrict__ gate_tk, float* __restrict__ out) {
    const size_t i = (size_t)blockIdx.x * 256 + threadIdx.x; const int t = (int)(i / D), c = (int)(i % D);
    float v = bf2f(x1b[i]);
#pragma unroll
    for (int k = 0; k < 4; ++k) v += gate_tk[t * 4 + k] * bf2f(ys[((size_t)t * 4 + k) * D + c]);
    out[i] = v;
}
}
#ifndef STAG_XCD
#define STAG_XCD 0
#endif
namespace pg8 {
#define PG8_LAS __attribute__((address_space(3)))
constexpr int BM = 256, BK = 64, HALF = 128, HTB = HALF * BK * 2  , STAGE_BYTES = 8 * HTB, NXCD = 8, WGM = 8;

__host__ __device__ __forceinline__ int lds_byte(int r, int c) { const int st = (r >> 4) * 2 + (c >> 5), rr = r & 15, cc = c & 31, ob = rr * 64 + cc * 2; return st * 1024 + (ob ^ (((ob >> 9) & 1) << 5)); }
__host__ __device__ __forceinline__ void stage_rc(int b, int& R, int& C) { const int st = b / 1024, sb = b % 1024, swz = sb ^ (((sb >> 9) & 1) << 5); R = (st >> 1) * 16 + swz / 64; C = (st & 1) * 32 + (swz % 64) / 2; }
__host__ __device__ __forceinline__ int perm32(int rho) { const int n = rho >> 4, i = rho & 15; return 8 * (i >> 2) + 4 * n + (i & 3); }

__device__ __forceinline__ void glds16s(const void* sbase, unsigned voff, unsigned lds_dst) {
    asm volatile("s_mov_b32 m0, %2\n\ts_nop 0\n\tglobal_load_lds_dwordx4 %0, %1" :: "v"(voff), "s"(sbase), "s"(lds_dst) : "memory", "m0"); }
#ifndef GLDS_PAIR
#define GLDS_PAIR 1
#endif
__device__ __forceinline__ void glds16s2(const void* sbase, unsigned v0, unsigned v1, unsigned lds_dst) {
    asm volatile("s_mov_b32 m0, %3\n\ts_nop 0\n\tglobal_load_lds_dwordx4 %0, %2\n\tglobal_load_lds_dwordx4 %1, %2 offset:1024" :: "v"(v0), "v"(v1), "s"(sbase), "s"(lds_dst) : "memory", "m0"); }
__host__ __device__ __forceinline__ int piece_pos(int tid, int i) { return GLDS_PAIR ? ((tid >> 6) * 2048 + i * 1024 + (tid & 63) * 16) : (tid * 16 + i * 8192); }
__host__ __device__ __forceinline__ unsigned piece_bias(int i) { return (GLDS_PAIR && i == 0) ? 1024u : 0u; }
__device__ __forceinline__ void glds4s(const void* sbase, unsigned voff, unsigned lds_dst) {
    asm volatile("s_mov_b32 m0, %2\n\ts_nop 4\n\tglobal_load_lds_dword %0, %1" :: "v"(voff), "s"(sbase), "s"(lds_dst) : "memory", "m0"); }
__device__ __forceinline__ const void* uniform_ptr(const void* p) { const unsigned long long v = (unsigned long long)p; const unsigned lo = __builtin_amdgcn_readfirstlane((unsigned)v), hi = __builtin_amdgcn_readfirstlane((unsigned)(v >> 32)); return (const void*)(((unsigned long long)hi << 32) | lo); }
struct Unit { const char* A; const char* B; int pm, pn, e, pos0; };

__device__ __forceinline__ void tile_of(int L, int nM, int nN, int& pm, int& pn) {
    const int nwg = nM * nN; int wgid = L; { const int q = nwg / NXCD, r = nwg % NXCD, xcd = wgid % NXCD, off = wgid / NXCD; wgid = (xcd < r ? xcd * (q + 1) : r * (q + 1) + (xcd - r) * q) + off; }
    const int nig = WGM * nN, gid = wgid / nig, fm = gid * WGM, gsz = (nM - fm) < WGM ? (nM - fm) : WGM;
    pm = fm + ((wgid % nig) % gsz); pn = (wgid % nig) / gsz;
}
struct DenseOrder {
    const char* A; const char* Bt; int nM, nN, G, c; size_t tstep; const float* bias; PG8_LAS unsigned char* tab; const float* rowvec; const float* colvec; const float* rowvec2; int cu_mode;
    __device__ __forceinline__ void init(const void* A_, const void* Bt_, int M, int N, int K, int G_, int c_) { A = (const char*)A_; Bt = (const char*)Bt_; nM = M / BM; nN = N / BM; G = G_; c = c_; tstep = (size_t)BM * K * 2; rowvec = nullptr; colvec = nullptr; rowvec2 = nullptr; cu_mode = 0; }
    __device__ __forceinline__ bool next(int i, Unit& u) const {
        const int L = i * G + c; if (L >= nM * nN) return false;
        tile_of(L, nM, nN, u.pm, u.pn); u.A = A + (size_t)u.pm * tstep; u.B = Bt + (size_t)u.pn * tstep; u.e = 0; u.pos0 = 0; return true;
    }
    __device__ __forceinline__ void prefetch(const Unit& u, int par, int wid, int lane) const {
        if (wid < 4) { const unsigned l0 = __builtin_amdgcn_readfirstlane((unsigned)(size_t)tab + par * 1024 + wid * 256);
            const float* bp = (cu_mode && u.pn >= 2 && u.pn < 6) ? bias + ((wid >> 1) ? 1024 : 512) + 128 * (u.pn - 2) + 64 * (wid & 1) : bias + u.pn * 256 + 64 * wid;
            glds4s(uniform_ptr(bp), (unsigned)lane * 4u, l0 + 6144u);
            if (rowvec) glds4s(uniform_ptr(rowvec + u.pm * 256 + 64 * wid), (unsigned)lane * 4u, l0 + 3072u);
            if (colvec) glds4s(uniform_ptr(colvec + u.pn * 256 + 64 * wid), (unsigned)lane * 4u, l0);
            if (rowvec2) glds4s(uniform_ptr(rowvec2 + u.pm * 256 + 64 * wid), (unsigned)lane * 4u, l0 + 9216u); }
    }
};

typedef __bf16 bf16pair __attribute__((ext_vector_type(2)));
__device__ __forceinline__ unsigned cvt_pk_bf16(float lo, float hi) { bf16pair v; v.x = (__bf16)lo; v.y = (__bf16)hi; return __builtin_bit_cast(unsigned, v); }

typedef f32x4 Acc[2][2][4][2];

template <class Epi, class Sched, bool GATHER, bool ALIGN_EPI, bool FP8 = false, bool PREF = false, int KREP = 1, int EREP = 1, int NS = 0, int MIDK = 0>
__device__ __forceinline__ void gemm_phase(PG8_LAS unsigned char* lds, const int K, const Sched& S, const Epi& E, const int stagger_ticks = 0) {
    const int tid = threadIdx.x, wid = __builtin_amdgcn_readfirstlane(tid >> 6), lane = tid & 63, wr = wid >> 2, wc = wid & 3, fr = lane & 15, fq = lane >> 4;
    const int nt = K / BK;
    unsigned voffA[2][2], voffB[2];
    const size_t kstep = (size_t)(BK * 2);
    const size_t hstep = (size_t)HALF * K * 2;
#pragma unroll
    for (int i = 0; i < 2; ++i) { int R, C; stage_rc(piece_pos(tid, i), R, C); const int Rb = (R & ~31) + perm32(R & 31);
        voffB[i] = (unsigned)(Rb * K + C) * 2u + piece_bias(i);
        if (!GATHER) { voffA[0][i] = (unsigned)(R * K + C) * 2u + piece_bias(i); voffA[1][i] = voffA[0][i] + (unsigned)hstep; } }
    const unsigned ldsb = __builtin_amdgcn_readfirstlane((unsigned)(size_t)lds + (unsigned)wid * (GLDS_PAIR ? 2048u : 1024u));
    const int aoff = lds_byte(wr * 64 + fr, fq * 8), boff = lds_byte(wc * 32 + fr, fq * 8);
#define PG8_SA(b, h) (((b) * 2 + (h)) * HTB)
#define PG8_SB(b, h) ((4 + (b) * 2 + (h)) * HTB)
#define PG8_STAGE(bufoff, gbase, v0, v1) do { const void* _g = uniform_ptr(gbase); if (GLDS_PAIR) glds16s2(_g, (v0), (v1), ldsb + (bufoff)); else { glds16s(_g, (v0), ldsb + (bufoff)); glds16s(_g, (v1), ldsb + (bufoff) + 8192); } } while (0)
#define PG8_STAGE_B(bufoff, gbase) PG8_STAGE(bufoff, gbase, voffB[0], voffB[1])
#define PG8_STAGE_A(bufoff, gbase, h) PG8_STAGE(bufoff, gbase, voffA[h][0], voffA[h][1])
#define PG8_LDA(dst, b, h) do { _Pragma("unroll") for (int m = 0; m < 4; ++m) _Pragma("unroll") for (int k = 0; k < 2; ++k) dst[m][k] = *(const PG8_LAS bf16x8*)(lds + PG8_SA(b, h) + aoff + m * 2048 + k * 1024); } while (0)
#define PG8_LDB(dst, b, h) do { _Pragma("unroll") for (int n = 0; n < 2; ++n) _Pragma("unroll") for (int k = 0; k < 2; ++k) dst[n][k] = *(const PG8_LAS bf16x8*)(lds + PG8_SB(b, h) + boff + n * 2048 + k * 1024); } while (0)
#define PG8_MMA(ai, bj, At, Bt) do { __builtin_amdgcn_s_setprio(1); \
        if constexpr (FP8) { i32x8 _b[2]; _Pragma("unroll") for (int n = 0; n < 2; ++n) _b[n] = __builtin_shufflevector(__builtin_bit_cast(i32x4, Bt[n][0]), __builtin_bit_cast(i32x4, Bt[n][1]), 0, 1, 2, 3, 4, 5, 6, 7); \
            _Pragma("unroll") for (int m = 0; m < 4; ++m) { const i32x8 _a = __builtin_shufflevector(__builtin_bit_cast(i32x4, At[m][0]), __builtin_bit_cast(i32x4, At[m][1]), 0, 1, 2, 3, 4, 5, 6, 7); \
                _Pragma("unroll") for (int n = 0; n < 2; ++n) acc[ai][bj][m][n] = __builtin_amdgcn_mfma_scale_f32_16x16x128_f8f6f4(_b[n], _a, acc[ai][bj][m][n], 0, 0, 0, 0x7f7f7f7f, 0, 0x7f7f7f7f); } } \
        else { _Pragma("unroll") for (int m = 0; m < 4; ++m) _Pragma("unroll") for (int n = 0; n < 2; ++n) _Pragma("unroll") for (int k = 0; k < 2; ++k) \
            acc[ai][bj][m][n] = __builtin_amdgcn_mfma_f32_16x16x32_bf16(Bt[n][k], At[m][k], acc[ai][bj][m][n], 0, 0, 0); } \
        __builtin_amdgcn_s_setprio(0); } while (0)
#define PG8_WAIT_V(n) asm volatile("s_waitcnt vmcnt(" #n ")" ::: "memory")
#define PG8_WAIT_VR do { if (NS > 0 && relax) asm volatile("s_waitcnt vmcnt(%0)" :: "n"(8 + NS) : "memory"); else PG8_WAIT_V(8); } while (0)
#define PG8_WAIT_L(n) asm volatile("s_waitcnt lgkmcnt(" #n ")" ::: "memory")
#define PG8_BAR __builtin_amdgcn_s_barrier()
#define PG8_SCHED __builtin_amdgcn_sched_barrier(0)
    Unit cur, nxt; int ui = 0, par = 0;
    if (!S.next(0, cur)) return;
    if (stagger_ticks > 0) {
        const unsigned long long t0 = __builtin_amdgcn_s_memrealtime(), dl = (unsigned long long)((STAG_XCD ? (blockIdx.x & 7) : ((blockIdx.x >> 3) & 7)) * stagger_ticks);
        while (__builtin_amdgcn_s_memrealtime() - t0 < dl) __builtin_amdgcn_s_sleep(16);
    }
    Acc acc;
#pragma unroll
    for (int a = 0; a < 2; ++a)
#pragma unroll
        for (int b = 0; b < 2; ++b)
#pragma unroll
            for (int m = 0; m < 4; ++m)
#pragma unroll
                for (int n = 0; n < 2; ++n) acc[a][b][m][n] = (f32x4){0.f, 0.f, 0.f, 0.f};
    bf16x8 At[4][2], B0[2][2], B1[2][2];
    const char* cA = (const char*)uniform_ptr(cur.A) - (GLDS_PAIR ? 1024 : 0); const char* cB = (const char*)uniform_ptr(cur.B) - (GLDS_PAIR ? 1024 : 0);
    if constexpr (PREF) { S.prefetch(cur, 0, wid, lane); PG8_WAIT_V(0); PG8_BAR; }
    if constexpr (GATHER) S.rows(cur, voffA, 0);
    PG8_STAGE_B(PG8_SB(0, 0), cB); PG8_STAGE_B(PG8_SB(0, 1), cB + hstep); PG8_STAGE_A(PG8_SA(0, 0), cA, 0); PG8_STAGE_A(PG8_SA(0, 1), cA, 1);
    if (wr == 1) PG8_BAR;
    PG8_WAIT_V(2); PG8_BAR;
    PG8_STAGE_B(PG8_SB(1, 0), cB + kstep); PG8_STAGE_A(PG8_SA(1, 0), cA + kstep, 0); PG8_STAGE_B(PG8_SB(1, 1), cB + hstep + kstep);
    PG8_WAIT_V(6); PG8_BAR;
    for (;;) {
        const bool has_next = S.next(ui + 1, nxt);
        const char* nA = has_next ? (const char*)uniform_ptr(nxt.A) - (GLDS_PAIR ? 1024 : 0) : cA; const char* nB = has_next ? (const char*)uniform_ptr(nxt.B) - (GLDS_PAIR ? 1024 : 0) : cB;
        if constexpr (PREF) { if (has_next) S.prefetch(nxt, par == 2 ? 0 : par + 1, wid, lane); }
#pragma unroll 1
        for (int tt = 0; tt < KREP * nt; tt += 2) {
            const bool last = (tt == KREP * nt - 2), relax = (ui > 0 && tt == 0); const int t = (KREP == 1) ? tt : (tt % nt), t2 = (KREP == 1) ? tt + 2 : ((tt + 2) % nt);
            if constexpr (MIDK > 0) { if (tt == MIDK) { const PG8_LAS float* r2 = (const PG8_LAS float*)(S.tab + 9216 + par * 1024) + wr * 64 + fr;
#pragma unroll
                for (int a = 0; a < 2; ++a)
#pragma unroll
                    for (int m = 0; m < 4; ++m) { const float sc = r2[a * 128 + m * 16];
#pragma unroll
                        for (int b = 0; b < 2; ++b)
#pragma unroll
                            for (int n = 0; n < 2; ++n) acc[a][b][m][n] *= sc; } } }
            const char* a1 = cA + (size_t)(t + 1) * kstep;
            const char* a2 = last ? nA : cA + (size_t)t2 * kstep; const char* b2 = last ? nB : cB + (size_t)t2 * kstep;
            const char* a3 = a2 + kstep; const char* b3 = b2 + kstep;
            PG8_LDB(B0, 0, 0); PG8_LDB(B1, 0, 1); PG8_SCHED; PG8_LDA(At, 0, 0); PG8_STAGE_A(PG8_SA(1, 1), a1, 1);
            if constexpr (GATHER) { if (last && has_next) S.rows(nxt, voffA, par == 2 ? 0 : par + 1); }
            PG8_WAIT_VR; PG8_WAIT_L(0); PG8_BAR; PG8_MMA(0, 0, At, B0); PG8_MMA(0, 1, At, B1); PG8_BAR; PG8_SCHED;
            PG8_LDA(At, 0, 1); PG8_STAGE_B(PG8_SB(0, 0), b2); PG8_STAGE_B(PG8_SB(0, 1), b2 + hstep); PG8_STAGE_A(PG8_SA(0, 0), a2, 0);
            PG8_WAIT_VR; PG8_WAIT_L(0); PG8_BAR; PG8_MMA(1, 0, At, B0); PG8_MMA(1, 1, At, B1); PG8_BAR; PG8_SCHED;
            PG8_LDB(B0, 1, 0); PG8_LDB(B1, 1, 1); PG8_SCHED; PG8_LDA(At, 1, 0); PG8_STAGE_A(PG8_SA(0, 1), a2, 1);
            PG8_WAIT_V(8); PG8_WAIT_L(0); PG8_BAR; PG8_MMA(0, 0, At, B0); PG8_MMA(0, 1, At, B1); PG8_BAR; PG8_SCHED;
            PG8_LDA(At, 1, 1); PG8_STAGE_B(PG8_SB(1, 0), b3); PG8_STAGE_B(PG8_SB(1, 1), b3 + hstep); PG8_STAGE_A(PG8_SA(1, 0), a3, 0);
            PG8_WAIT_V(8); PG8_WAIT_L(0); PG8_BAR; PG8_MMA(1, 0, At, B0); PG8_MMA(1, 1, At, B1); PG8_BAR; PG8_SCHED;
        }
        if constexpr (ALIGN_EPI) { if (wr == 0) PG8_BAR; }
        {
            int tz = threadIdx.x; asm volatile("" : "+v"(tz)); const int wz = __builtin_amdgcn_readfirstlane(tz >> 6), lz = tz & 63;
            for (int er = 0; er < EREP; ++er) E(acc, cur, wz >> 2, wz & 3, lz & 15, lz >> 4, par);
        }
        if (!has_next) break;
#pragma unroll
        for (int a = 0; a < 2; ++a)
#pragma unroll
            for (int b = 0; b < 2; ++b)
#pragma unroll
                for (int m = 0; m < 4; ++m)
#pragma unroll
                    for (int n = 0; n < 2; ++n) acc[a][b][m][n] = (f32x4){0.f, 0.f, 0.f, 0.f};
        cur = nxt; cA = nA; cB = nB; ++ui; par = (par == 2) ? 0 : par + 1;
        if constexpr (ALIGN_EPI) { if (wr == 1) PG8_BAR; }
    }
    PG8_WAIT_V(0);
    if constexpr (!ALIGN_EPI) { if (wr == 0) PG8_BAR; }
    PG8_BAR;
#undef PG8_SA
#undef PG8_SB
#undef PG8_STAGE
#undef PG8_STAGE_A
#undef PG8_STAGE_B
#undef PG8_LDA
#undef PG8_LDB
#undef PG8_MMA
#undef PG8_WAIT_V
#undef PG8_WAIT_VR
#undef PG8_WAIT_L
#undef PG8_BAR
#undef PG8_SCHED
}
}
constexpr int NWAVES = 8;
constexpr int RING_OFF = 0, RING_BYTES = 131072;
constexpr int MOE_OFF = RING_BYTES;
constexpr int LDSCTL_OFF = MOE_OFF + 512, MISC_OFF = LDSCTL_OFF + 320;
constexpr int TAB_OFF = 133120;
constexpr int LDS_BYTES = 163840;
static_assert(MISC_OFF + 128 <= LDS_BYTES, "LDS map");

#define GAS __attribute__((address_space(1)))
#define LAS __attribute__((address_space(3)))
typedef GAS unsigned gu32;
#define RLX_AGENT __ATOMIC_RELAXED, __HIP_MEMORY_SCOPE_AGENT
#define LDS_WAIT() asm volatile("s_waitcnt lgkmcnt(0)" ::: "memory")
#define VM_WAIT() asm volatile("s_waitcnt vmcnt(0)" ::: "memory")

#define XB_TMO      128
#define XB_XCNT(j)  (256  + 64 * (j))
#define XB_XSUB(j)  (1280 + 64 * (j))
#define XB_XGEN(j)  (2304 + 64 * (j))
#define XB_TOP      3328
#define XB_TOPGEN   3392
#define XCD_BAR_WORDS 3456
#define XB_SPIN_CAP (1u << 18)
__device__ __forceinline__ unsigned xb_ld(unsigned* p)              { return __hip_atomic_load(p, __ATOMIC_RELAXED, __HIP_MEMORY_SCOPE_AGENT); }
__device__ __forceinline__ unsigned xb_add(unsigned* p, unsigned v) { return __hip_atomic_fetch_add(p, v, __ATOMIC_RELAXED, __HIP_MEMORY_SCOPE_AGENT); }
__device__ __forceinline__ unsigned xb_xcc_id() { return (unsigned)__builtin_amdgcn_s_getreg((3 << 11) | 20) & 0xFu; }
#define XB_SPIN(cond, bar) do { unsigned _sp = 0; while (cond) { __builtin_amdgcn_s_sleep(1); \
    if ((++_sp & 255u) == 0u) { if (xb_ld(&(bar)[XB_TMO])) break; if (_sp > XB_SPIN_CAP) { atomicAdd(&(bar)[XB_TMO], 1u); break; } } } } while (0)
struct XcdBarrier { unsigned* bar; unsigned x; volatile LAS unsigned* st; };
__device__ __forceinline__ XcdBarrier xcd_barrier_post(unsigned* bar, volatile LAS unsigned* st) {
    XcdBarrier b; b.bar = bar; b.x = xb_xcc_id(); b.st = st;
    if (threadIdx.x == 0) (void)xb_add(&bar[XB_XCNT(b.x)], 1u);
    return b;
}
__device__ __forceinline__ void xcd_barrier_complete(unsigned* bar, unsigned x, unsigned& nloc, unsigned& nx) {
    const unsigned G = gridDim.x * gridDim.y * gridDim.z;
    unsigned sum, cnt, mine, sp = 0u;
    for (;;) {
        sum = 0u; cnt = 0u; mine = 0u;
#pragma unroll
        for (unsigned j = 0; j < 16; ++j) { const unsigned c = xb_ld(&bar[XB_XCNT(j)]); sum += c; cnt += (c > 0u) ? 1u : 0u; mine = (j == x) ? c : mine; }
        if (sum == G) break;
        __builtin_amdgcn_s_sleep(1);
        if ((++sp & 255u) == 0u) { if (xb_ld(&bar[XB_TMO])) break; if (sp > XB_SPIN_CAP) { atomicAdd(&bar[XB_TMO], 1u); break; } }
    }
    nloc = mine > 0u ? mine : 1u; nx = cnt > 0u ? cnt : 1u;
}
__device__ __forceinline__ void xcd_barrier(const XcdBarrier& b) {
    asm volatile("s_waitcnt vmcnt(0)" ::: "memory");
    __syncthreads();
    if (threadIdx.x == 0) {
        unsigned* bar = b.bar;
        __builtin_amdgcn_s_waitcnt(0);
        unsigned nloc = b.st[0], nx = b.st[1];
        if (nloc == 0u) { xcd_barrier_complete(bar, b.x, nloc, nx); b.st[0] = nloc; b.st[1] = nx; }
        const unsigned old = xb_add(&bar[XB_XSUB(b.x)], 1u);
        const unsigned gen = old / nloc;
        if (old + 1u == (gen + 1u) * nloc) {
            __builtin_amdgcn_fence(__ATOMIC_RELEASE, "agent");
            asm volatile("s_waitcnt vmcnt(0)" ::: "memory");
            const unsigned og = xb_add(&bar[XB_TOP], 1u);
            const unsigned tg = og / nx;
            if (og + 1u == (tg + 1u) * nx) xb_add(&bar[XB_TOPGEN], 1u);
            else XB_SPIN(xb_ld(&bar[XB_TOPGEN]) == tg, bar);
            __builtin_amdgcn_fence(__ATOMIC_ACQUIRE, "agent");
            xb_add(&bar[XB_XGEN(b.x)], 1u);
            asm volatile("s_waitcnt vmcnt(0)" ::: "memory");
        } else {
            XB_SPIN(xb_ld(&bar[XB_XGEN(b.x)]) == gen, bar);
            __builtin_amdgcn_fence(__ATOMIC_ACQUIRE, "agent");
            asm volatile("s_waitcnt vmcnt(0)" ::: "memory");
        }
    }
    __syncthreads();
}

struct Frame {
    LAS unsigned char* lds;
    volatile LAS unsigned* MISC;
    gu32* ctl;
    int tid, lane, wave;
    int vcu, G;
    const float *x, *norm_mix, *w_in, *b_in, *conv_w, *q_norm, *k_norm, *sinks, *rel_bias, *on_conv, *on_attn, *w_out, *b_out, *norm_ffn, *w_router, *b_router, *w1, *b1, *w2, *b2;
    float* out;
    bf16 *WinT, *WoutT, *WR; unsigned char *W1Q, *W2Q, *x1q, *act;
    float *B1S, *rstd, *gate, *rsl, *rin, *ginv, *rsa;
    unsigned* dest;
    bf16 *xn, *proj, *mix, *x1b; unsigned char* ys;
};

#ifndef P1_KREP
#define P1_KREP 1
#endif
#ifndef P3_KREP
#define P3_KREP 1
#endif
__device__ __forceinline__ v4u pair16(const v2u a, const v2u b) {
    const auto rx = __builtin_amdgcn_permlane16_swap(a.x, b.x, false, false), ry = __builtin_amdgcn_permlane16_swap(a.y, b.y, false, false);
    return (v4u){rx[0], ry[0], rx[1], ry[1]};
}
struct EpiIn {
    bf16* O; const LAS unsigned char* tab;
    __device__ __forceinline__ void operator()(const pg8::Acc& acc, const pg8::Unit& u, int wr, int wc, int fr, int fq, int par) const {
        const int row0 = u.pm * 256 + wr * 64 + fr;
        const LAS float* bt = (const LAS float*)(tab + 6144 + par * 1024) + wc * 32 + 8 * fq;
        f32x4 bv[2][2];
#pragma unroll
        for (int bj = 0; bj < 2; ++bj)
#pragma unroll
            for (int n = 0; n < 2; ++n) bv[bj][n] = *(const LAS f32x4*)(bt + bj * 128 + 4 * n);
        if (u.pn >= 2 && u.pn < 6) {
            const int col0 = P_CU + 128 * (u.pn - 2) + wc * 32 + 8 * fq;
#pragma unroll
            for (int ai = 0; ai < 2; ++ai)
#pragma unroll
                for (int m = 0; m < 4; ++m) { bf16* rowp = O + (size_t)(row0 + ai * 128 + m * 16) * PW + col0;
                    const f32x4 v0 = (acc[ai][0][m][0] * (1.0f / P1_KREP) + bv[0][0]) * (acc[ai][1][m][0] * (1.0f / P1_KREP) + bv[1][0]), v1 = (acc[ai][0][m][1] * (1.0f / P1_KREP) + bv[0][1]) * (acc[ai][1][m][1] * (1.0f / P1_KREP) + bv[1][1]);
                    v4u w; w.x = pg8::cvt_pk_bf16(v0[0], v0[1]); w.y = pg8::cvt_pk_bf16(v0[2], v0[3]); w.z = pg8::cvt_pk_bf16(v1[0], v1[1]); w.w = pg8::cvt_pk_bf16(v1[2], v1[3]);
                    *(v4u*)rowp = w; }
        } else {
            const int col0 = (u.pn < 2 ? 256 * u.pn : P_Q + 256 * (u.pn - 6)) + wc * 32 + 8 * fq;
#pragma unroll
            for (int ai = 0; ai < 2; ++ai)
#pragma unroll
                for (int m = 0; m < 4; ++m) { bf16* rowp = O + (size_t)(row0 + ai * 128 + m * 16) * PW + col0;
#pragma unroll
                    for (int bj = 0; bj < 2; ++bj) { const f32x4 v0 = acc[ai][bj][m][0] * (1.0f / P1_KREP) + bv[bj][0], v1 = acc[ai][bj][m][1] * (1.0f / P1_KREP) + bv[bj][1];
                        v4u w; w.x = pg8::cvt_pk_bf16(v0[0], v0[1]); w.y = pg8::cvt_pk_bf16(v0[2], v0[3]); w.z = pg8::cvt_pk_bf16(v1[0], v1[1]); w.w = pg8::cvt_pk_bf16(v1[2], v1[3]);
                        *(v4u*)(rowp + bj * 128) = w; } }
        }
    }
};
struct EpiOut {
    bf16* O; const LAS unsigned char* tab; const bf16* xn; unsigned char* Q;
    __device__ __forceinline__ void operator()(const pg8::Acc& acc, const pg8::Unit& u, int wr, int wc, int fr, int fq, int par) const {
        const int row0 = u.pm * 256 + wr * 64 + fr, col0 = u.pn * 256 + wc * 32 + 8 * fq;
        const LAS float* bt = (const LAS float*)(tab + 6144 + par * 1024) + wc * 32 + 8 * fq;
        const LAS float* gt = (const LAS float*)(tab + par * 1024) + wc * 32 + 8 * fq;
        const LAS float* rt = (const LAS float*)(tab + 3072 + par * 1024) + wr * 64 + fr;
        f32x4 bv[2][2], gi[2][2];
#pragma unroll
        for (int bj = 0; bj < 2; ++bj)
#pragma unroll
            for (int n = 0; n < 2; ++n) { bv[bj][n] = *(const LAS f32x4*)(bt + bj * 128 + 4 * n); gi[bj][n] = *(const LAS f32x4*)(gt + bj * 128 + 4 * n); }
        const bool odd = fq & 1;
#pragma unroll
        for (int ai = 0; ai < 2; ++ai) {
            v4u xw[4][2];
#pragma unroll
            for (int m = 0; m < 4; ++m)
#pragma unroll
                for (int bj = 0; bj < 2; ++bj) xw[m][bj] = *(const v4u*)(xn + (size_t)(row0 + ai * 128 + m * 16) * D + col0 + bj * 128);
#pragma unroll
            for (int m = 0; m < 4; ++m) { const size_t off = (size_t)(row0 + ai * 128 + m * 16) * D + col0; v2u qq[2];
                const float ri = rt[ai * 128 + m * 16];
#pragma unroll
                for (int bj = 0; bj < 2; ++bj) { const v4u xv = xw[m][bj];
                    const f32x4 x0 = (f32x4){bflo(xv.x), bfhi(xv.x), bflo(xv.y), bfhi(xv.y)} * ri * gi[bj][0], x1 = (f32x4){bflo(xv.z), bfhi(xv.z), bflo(xv.w), bfhi(xv.w)} * ri * gi[bj][1];
                    const f32x4 v0 = acc[ai][bj][m][0] * (1.0f / P3_KREP) + bv[bj][0] + x0, v1 = acc[ai][bj][m][1] * (1.0f / P3_KREP) + bv[bj][1] + x1;
                    v4u w; w.x = pg8::cvt_pk_bf16(v0[0], v0[1]); w.y = pg8::cvt_pk_bf16(v0[2], v0[3]); w.z = pg8::cvt_pk_bf16(v1[0], v1[1]); w.w = pg8::cvt_pk_bf16(v1[2], v1[3]);
                    *(v4u*)(O + off + bj * 128) = w;
                    qq[bj].x = pk4_fp8(v0[0], v0[1], v0[2], v0[3]); qq[bj].y = pk4_fp8(v1[0], v1[1], v1[2], v1[3]); }
                {
                    const v4u w16 = pair16(qq[0], qq[1]);
                    *(v4u*)(Q + off + (odd ? 128 - 8 : 0)) = w16; } }
            asm volatile("" ::: "memory");
        }
    }
};
template <bool GATHER> struct MoeOrder {
    const char* Abase; const char* Bt; size_t bstride_e, tstepB;
    int nN, G, c, NT; const LAS int* tile0; const LAS int* ecnt; const unsigned* dest;
    __device__ __forceinline__ bool next(int i, pg8::Unit& u) const {
        const int L = i * G + c; if (L >= NT * nN) return false;
        pg8::tile_of(L, NT, nN, u.pm, u.pn);
        int e = 0;
#pragma unroll
        for (int st = 16; st >= 1; st >>= 1) if (__builtin_amdgcn_readfirstlane(tile0[e + st]) <= u.pm) e += st;
        u.e = e; u.pos0 = (u.pm - __builtin_amdgcn_readfirstlane(tile0[e])) * 256;
        u.B = Bt + (size_t)e * bstride_e + (size_t)u.pn * tstepB;
        u.A = Abase;
        return true;
    }
    const float* rsl; LAS unsigned char* tab; const float* bias; int bias_mode;
    __device__ __forceinline__ void prefetch(const pg8::Unit& u, int par, int wid, int lane) const {
        if (wid < 4) { const size_t idx = (size_t)u.e * T + u.pos0 + 64 * wid; const unsigned l0 = __builtin_amdgcn_readfirstlane((unsigned)(size_t)tab + par * 1024 + wid * 256);
            pg8::glds4s(pg8::uniform_ptr(dest + idx), (unsigned)lane * 4u, l0); pg8::glds4s(pg8::uniform_ptr(rsl + idx), (unsigned)lane * 4u, l0 + 3072u);
            const float* bp = bias_mode == 1 ? bias + (size_t)u.e * 2 * DFF + (wid >> 1) * DFF + u.pn * 128 + 64 * (wid & 1) : bias + (size_t)u.e * D + u.pn * 256 + 64 * wid;
            pg8::glds4s(pg8::uniform_ptr(bp), (unsigned)lane * 4u, l0 + 6144u); }
    }
    __device__ __forceinline__ void rows(const pg8::Unit& u, unsigned (&voff)[2][2], int par) const {
        int tz = threadIdx.x; asm volatile("" : "+v"(tz));
        if constexpr (!GATHER) {
#pragma unroll
            for (int i = 0; i < 2; ++i) { int R, C; pg8::stage_rc(pg8::piece_pos(tz, i), R, C);
#pragma unroll
                for (int h = 0; h < 2; ++h) voff[h][i] = (unsigned)(u.pm * 256 + h * 128 + R) * (unsigned)DFF + (unsigned)(C * 2) + pg8::piece_bias(i); }
            return;
        }
        const int n = __builtin_amdgcn_readfirstlane(ecnt[u.e]); const LAS unsigned* dtab = (const LAS unsigned*)(tab + par * 1024);
#pragma unroll
        for (int i = 0; i < 2; ++i) { int R, C; pg8::stage_rc(pg8::piece_pos(tz, i), R, C);
#pragma unroll
            for (int h = 0; h < 2; ++h) { const int r = h * 128 + R; const unsigned tok = (u.pos0 + r) < n ? (dtab[r] >> 2) : 0u; voff[h][i] = tok * (unsigned)D + (unsigned)(C * 2) + pg8::piece_bias(i); } }
    }
};
#ifndef P5_KREP
#define P5_KREP 1
#endif
struct EpiW1 {
    unsigned char* act; const LAS unsigned char* tab; const LAS int* ecnt;
    __device__ __forceinline__ void operator()(const pg8::Acc& acc, const pg8::Unit& u, int wr, int wc, int fr, int fq, int par) const {
        const LAS float* rtab = (const LAS float*)(tab + 3072 + par * 1024);
        const int n = __builtin_amdgcn_readfirstlane(ecnt[u.e]); const int acol = u.pn * 128 + wc * 32 + 8 * fq;
        unsigned char* const abase = act + (size_t)u.pm * (256 * DFF) + acol;
        const LAS float* bg = (const LAS float*)(tab + 6144 + par * 1024) + wc * 32 + 8 * fq; const LAS float* bl = bg + 128;
        const f32x4 bg0 = *(const LAS f32x4*)bg * SWI_CZ, bg1 = *(const LAS f32x4*)(bg + 4) * SWI_CZ, bl0 = (*(const LAS f32x4*)bl * ACT_SCALE + ACT_SCALE) * SWI_ICZ, bl1 = (*(const LAS f32x4*)(bl + 4) * ACT_SCALE + ACT_SCALE) * SWI_ICZ;
        float rs[2][4];
#pragma unroll
        for (int ai = 0; ai < 2; ++ai)
#pragma unroll
            for (int m = 0; m < 4; ++m) rs[ai][m] = rtab[ai * 128 + wr * 64 + m * 16 + fr];
        const bool odd = fq & 1;
#pragma unroll
        for (int ai = 0; ai < 2; ++ai)
#pragma unroll
            for (int mp = 0; mp < 2; ++mp) { v2u w[2];
#pragma unroll
                for (int mm = 0; mm < 2; ++mm) { const int m = 2 * mp + mm; const int r = ai * 128 + wr * 64 + m * 16 + fr; const float s0 = (u.pos0 + r) < n ? rs[ai][m] : 0.f, s = s0 * (SWI_CZ / (W_SCALE * P5_KREP)), s4 = s0 * (ACT_SCALE * SWI_ICZ / (W_SCALE * P5_KREP));
                    const f32x4 g0 = acc[ai][0][m][0] * s + bg0, g1 = acc[ai][0][m][1] * s + bg1, l0 = acc[ai][1][m][0] * s4 + bl0, l1 = acc[ai][1][m][1] * s4 + bl1;
                    const f32x2 a0 = swiglu2_z((f32x2){g0[0], g0[1]}, (f32x2){l0[0], l0[1]}), a1 = swiglu2_z((f32x2){g0[2], g0[3]}, (f32x2){l0[2], l0[3]});
                    const f32x2 a2 = swiglu2_z((f32x2){g1[0], g1[1]}, (f32x2){l1[0], l1[1]}), a3 = swiglu2_z((f32x2){g1[2], g1[3]}, (f32x2){l1[2], l1[3]});
                    w[mm].x = pk4_fp8(a0.x, a0.y, a1.x, a1.y); w[mm].y = pk4_fp8(a2.x, a2.y, a3.x, a3.y); }
                const v4u w16 = pair16(w[0], w[1]);
                const int r = ai * 128 + wr * 64 + (2 * mp + (odd ? 1 : 0)) * 16 + fr;
                *(v4u*)(abase + (size_t)r * DFF - (odd ? 8 : 0)) = w16; }
    }
};
struct EpiW2 {
    unsigned char* ys; const LAS unsigned char* tab; const LAS int* ecnt;
    static constexpr float sc = YS_SCALE / (W_SCALE * ACT_SCALE);
    __device__ __forceinline__ void operator()(const pg8::Acc& acc, const pg8::Unit& u, int wr, int wc, int fr, int fq, int par) const {
        const LAS unsigned* dtab = (const LAS unsigned*)(tab + par * 1024); unsigned char* const dummy = ys - (WS_YS - WS_DUMMY);
        const int n = __builtin_amdgcn_readfirstlane(ecnt[u.e]); const int col0 = u.pn * 256 + wc * 32 + 8 * fq;
        f32x4 bv[2][2];
#pragma unroll
        for (int bj = 0; bj < 2; ++bj)
#pragma unroll
            for (int nn = 0; nn < 2; ++nn) bv[bj][nn] = *(const LAS f32x4*)((const LAS float*)(tab + 6144 + par * 1024) + wc * 32 + 8 * fq + bj * 128 + 4 * nn) * YS_SCALE;
        const bool odd = fq & 1;
#pragma unroll
        for (int ai = 0; ai < 2; ++ai)
#pragma unroll
            for (int m = 0; m < 4; ++m) { const int r = ai * 128 + wr * 64 + m * 16 + fr; const bool ok = (u.pos0 + r) < n;
                const unsigned d = dtab[r];
                unsigned char* rowp = (ok ? ys + (size_t)d * D : dummy) + col0;
                v2u w[2];
#pragma unroll
                for (int bj = 0; bj < 2; ++bj) { const f32x4 v0 = acc[ai][bj][m][0] * sc + bv[bj][0], v1 = acc[ai][bj][m][1] * sc + bv[bj][1];
                    w[bj].x = pk4_fp8(v0[0], v0[1], v0[2], v0[3]); w[bj].y = pk4_fp8(v1[0], v1[1], v1[2], v1[3]); }
                const v4u w16 = pair16(w[0], w[1]);
                *(v4u*)(rowp + (odd ? 128 - 8 : 0)) = w16;
            }
    }
};

template <int MAPM>
__device__ __forceinline__ void p0_transpose_item(const float* W, int K, int N, bf16* WT, const float* gain, LAS float* scr, int item, int lane) {
    const int nblk = N / 32, kb = item / nblk, nb = item % nblk, k0 = 64 * kb, n0 = 32 * nb;
    {
        f32x4 wv[8];
#pragma unroll
        for (int i = 0; i < 8; ++i) wv[i] = __builtin_nontemporal_load((const f32x4*)(W + (size_t)(k0 + 8 * i + (lane >> 3)) * N + n0 + 4 * (lane & 7)));
#pragma unroll
        for (int i = 0; i < 8; ++i)
#pragma unroll
            for (int jj = 0; jj < 4; ++jj) scr[(8 * i + (lane >> 3)) * 33 + 4 * (lane & 7) + jj] = wv[i][jj];
    }
    LDS_WAIT(); asm volatile("" ::: "memory");
    const int c = lane & 7;
    float gk[8];
#pragma unroll
    for (int j = 0; j < 8; ++j) gk[j] = (MAPM == 3) ? ((k0 + 8 * c + j) >= CONVW ? gain[k0 + 8 * c + j - CONVW] : 1.0f) : (gain ? gain[k0 + 8 * c + j] : 1.0f);
#pragma unroll
    for (int j = 0; j < 4; ++j) { const int nl = (lane >> 3) + 8 * j; const LAS float* s = scr + (8 * c) * 33 + nl;
        int n = n0 + nl; if (MAPM == 2) { if (n >= 512 && n < 1024) n = 512 + 256 * ((n - 512) >> 7) + ((n - 512) & 127); else if (n >= 1024 && n < 1536) n = 512 + 256 * ((n - 1024) >> 7) + 128 + ((n - 1024) & 127); }
        v4u o; o.x = pk2(s[0 * 33] * gk[0], s[1 * 33] * gk[1]); o.y = pk2(s[2 * 33] * gk[2], s[3 * 33] * gk[3]); o.z = pk2(s[4 * 33] * gk[4], s[5 * 33] * gk[5]); o.w = pk2(s[6 * 33] * gk[6], s[7 * 33] * gk[7]);
        *(GAS v4u*)(WT + (size_t)n * K + ((MAPM == 3) ? ((k0 + 8 * c + CONVW) & (K - 1)) : (k0 + 8 * c))) = o; }
    LDS_WAIT(); asm volatile("" ::: "memory");
}
template <bool MAP1>
__device__ __forceinline__ void p0_transpose_item_q(const float* W, int K, int N, unsigned char* WT, const float* gain, LAS float* scr, int item, int lane) {
    const int nblk = N / 32, kb = item / nblk, nb = item % nblk, k0 = 64 * kb, n0 = 32 * nb;
    {
        f32x4 wv[8];
#pragma unroll
        for (int i = 0; i < 8; ++i) wv[i] = __builtin_nontemporal_load((const f32x4*)(W + (size_t)(k0 + 8 * i + (lane >> 3)) * N + n0 + 4 * (lane & 7)));
#pragma unroll
        for (int i = 0; i < 8; ++i)
#pragma unroll
            for (int jj = 0; jj < 4; ++jj) scr[(8 * i + (lane >> 3)) * 33 + 4 * (lane & 7) + jj] = wv[i][jj];
    }
    LDS_WAIT(); asm volatile("" ::: "memory");
    const int c = lane & 3;
    float gk[16];
#pragma unroll
    for (int j = 0; j < 16; ++j) gk[j] = (gain ? gain[k0 + 16 * c + j] : 1.0f) * W_SCALE;
#pragma unroll
    for (int j = 0; j < 2; ++j) { const int nl = (lane >> 2) + 16 * j; const LAS float* s = scr + (16 * c) * 33 + nl;
        int n = n0 + nl; if (MAP1) { const int a = n >> 1; n = 256 * (a >> 7) + 128 * (n & 1) + (a & 127); }
        v4u o; o.x = pk4_fp8(s[0 * 33] * gk[0], s[1 * 33] * gk[1], s[2 * 33] * gk[2], s[3 * 33] * gk[3]); o.y = pk4_fp8(s[4 * 33] * gk[4], s[5 * 33] * gk[5], s[6 * 33] * gk[6], s[7 * 33] * gk[7]);
        o.z = pk4_fp8(s[8 * 33] * gk[8], s[9 * 33] * gk[9], s[10 * 33] * gk[10], s[11 * 33] * gk[11]); o.w = pk4_fp8(s[12 * 33] * gk[12], s[13 * 33] * gk[13], s[14 * 33] * gk[14], s[15 * 33] * gk[15]);
        *(GAS v4u*)(WT + (size_t)n * K + k0 + 16 * c) = o; }
    LDS_WAIT(); asm volatile("" ::: "memory");
}
__device__ __forceinline__ void p0_prologue(Frame& F) {
    LAS float* scr = (LAS float*)(F.lds + RING_OFF + F.wave * 16384);
    const int gw = F.vcu * NWAVES + F.wave, NGW = F.G * NWAVES;
    constexpr int I_IN = (D / 64) * (INW / 32), I_OUT = (D / 64) * (D / 32), I_1 = (D / 64) * (2 * DFF / 32), I_2 = (DFF / 64) * (D / 32);
    constexpr int NITEMS = I_IN + I_OUT + NEXP * (I_1 + I_2);
    for (int it = gw; it < NITEMS; it += NGW) {
        int r = it;
        if (r < I_IN) { p0_transpose_item<2>(F.w_in, D, INW, F.WinT, nullptr, scr, r, F.lane); continue; } r -= I_IN;
        if (r < I_OUT) { p0_transpose_item<3>(F.w_out, D, D, F.WoutT, F.on_attn, scr, r, F.lane); continue; } r -= I_OUT;
        if (r < NEXP * I_1) { const int e = r / I_1; p0_transpose_item_q<true>(F.w1 + (size_t)e * D * 2 * DFF, D, 2 * DFF, F.W1Q + (size_t)e * 2 * DFF * D, F.norm_ffn, scr, r % I_1, F.lane); continue; } r -= NEXP * I_1;
        { const int e = r / I_2; p0_transpose_item_q<false>(F.w2 + (size_t)e * DFF * D, DFF, D, F.W2Q + (size_t)e * D * DFF, nullptr, scr, r % I_2, F.lane); }
    }
    const int gt = F.vcu * (NWAVES * 64) + F.tid, NGT = F.G * NWAVES * 64;
    for (int i = gt; i < NEXP * D; i += NGT) { const int e = i / D, k = i % D; const float v = F.norm_ffn[k] * F.w_router[(size_t)k * NEXP + e]; const unsigned hi = f2bf(v); const float lo = v - bf2f((bf16)hi);
        F.WR[i] = (bf16)hi; F.WR[NEXP * D + i] = (bf16)f2bf(lo); }
    for (int i = gt; i < D; i += NGT) F.ginv[i] = 1.0f / F.norm_mix[i];
    for (int i = gt; i < NEXP * 2 * DFF; i += NGT) { const int e = i / (2 * DFF), c = i % (2 * DFF); F.B1S[(size_t)e * 2 * DFF + (c & 1) * DFF + (c >> 1)] = F.b1[i]; }
    {
        f32x4 gv[4];
#pragma unroll
        for (int j = 0; j < 4; ++j) gv[j] = *((const f32x4*)F.norm_mix + F.lane + 64 * j);
        for (int m = gw; m < T; m += NGW) {
            const GAS f32x4* xr = (const GAS f32x4*)(F.x + (size_t)m * D) + F.lane;
            f32x4 v[4]; float s = 0.f;
#pragma unroll
            for (int j = 0; j < 4; ++j) { v[j] = __builtin_nontemporal_load(xr + 64 * j); s += (v[j].x * v[j].x + v[j].y * v[j].y) + (v[j].z * v[j].z + v[j].w * v[j].w); }
            const float ms = wave_sum(s) * (1.f / D) + EPS; const float rstd = 1.f / sqrtf(ms);
            if (F.lane == 0) F.rin[m] = sqrtf(ms);
            GAS unsigned long long* o8 = (GAS unsigned long long*)(F.xn + (size_t)m * D) + F.lane;
#pragma unroll
            for (int j = 0; j < 4; ++j) o8[64 * j] = (unsigned long long)pk2(v[j].x * rstd * gv[j].x, v[j].y * rstd * gv[j].y) | ((unsigned long long)pk2(v[j].z * rstd * gv[j].z, v[j].w * rstd * gv[j].w) << 32);
        }
    }
}
__device__ __forceinline__ int moe_tables(Frame& F) {
    LAS int* tile0 = (LAS int*)(F.lds + MOE_OFF); LAS int* ecnt = tile0 + 40;
    if (F.tid < NEXP) ecnt[F.tid] = (int)__hip_atomic_load(F.ctl + CW_CNT + F.tid, RLX_AGENT);
    __syncthreads();
    if (F.tid == 0) { int a = 0; for (int e = 0; e < NEXP; ++e) { tile0[e] = a; a += (ecnt[e] + 255) >> 8; } tile0[NEXP] = a; }
    __syncthreads();
    return __builtin_amdgcn_readfirstlane(tile0[NEXP]);
}
constexpr float LOG2E = 1.4426950408889634f;
__device__ __forceinline__ void unpack8(const v4u& w, float (&f)[8]) {
    f[0] = bflo(w.x); f[1] = bfhi(w.x); f[2] = bflo(w.y); f[3] = bfhi(w.y); f[4] = bflo(w.z); f[5] = bfhi(w.z); f[6] = bflo(w.w); f[7] = bfhi(w.w);
}
__device__ __forceinline__ v4u pack8(const float (&f)[8]) {
    v4u w; w.x = pg8::cvt_pk_bf16(f[0], f[1]); w.y = pg8::cvt_pk_bf16(f[2], f[3]); w.z = pg8::cvt_pk_bf16(f[4], f[5]); w.w = pg8::cvt_pk_bf16(f[6], f[7]); return w;
}

__device__ __forceinline__ void p2_conv(Frame& F) {
    const int gw = F.vcu * NWAVES + F.wave, NGW = F.G * NWAVES; int c0 = 8 * F.lane; asm volatile("" : "+v"(c0));
    float w0[8], w1[8], w2[8], gg[8];
#pragma unroll
    for (int j = 0; j < 8; ++j) { w0[j] = F.conv_w[c0 + j]; w1[j] = F.conv_w[CONVW + c0 + j]; w2[j] = F.conv_w[2 * CONVW + c0 + j]; gg[j] = F.on_conv[c0 + j]; }
    for (int item = gw; item < T / 16; item += NGW) {
        const int t0 = item * 16, s0 = t0 % SEQ;
        float cu1[8], cu2[8];
#pragma unroll
        for (int j = 0; j < 8; ++j) { cu1[j] = 0.f; cu2[j] = 0.f; }
        if (s0 > 0) {
            const bf16* p = F.proj + (size_t)(t0 - 2) * PW + P_CU + c0;
            const v4u ca = *(const v4u*)p, cb = *(const v4u*)(p + PW);
            unpack8(ca, cu2); unpack8(cb, cu1);
        }
#pragma unroll 1
        for (int tt = 0; tt < 16; tt += 8) {
            v4u bb[8], cc[8];
#pragma unroll
            for (int q = 0; q < 8; ++q) { const bf16* p = F.proj + (size_t)(t0 + tt + q) * PW + c0; bb[q] = *(const v4u*)p; cc[q] = *(const v4u*)(p + P_CU); }
#pragma unroll
            for (int q = 0; q < 8; ++q) {
                float b[8], c[8], y[8]; unpack8(bb[q], b); unpack8(cc[q], c);
                float ss = 0.f;
#pragma unroll
                for (int j = 0; j < 8; ++j) { const float cu0 = c[j]; y[j] = b[j] * (w2[j] * cu0 + w1[j] * cu1[j] + w0[j] * cu2[j]); ss += y[j] * y[j]; cu2[j] = cu1[j]; cu1[j] = cu0; }
                const float rstd = 1.f / sqrtf(wave_sum(ss) * (1.f / CONVW) + EPS);
#pragma unroll
                for (int j = 0; j < 8; ++j) y[j] = y[j] * rstd * gg[j];
                *(v4u*)(F.mix + (size_t)(t0 + tt + q) * D + ATTNW + c0) = pack8(y);
            }
        }
    }
}

constexpr int KS_STRIDE = 144, VT_STRIDE = 528, KS_OFF = 0, VT_OFF = 256 * KS_STRIDE, BT_OFF = VT_OFF + 64 * VT_STRIDE, BT_ROW = 160, ATTN_LDS = BT_OFF + 8 * BT_ROW * 4 + 64;
constexpr int OS_ROW = 136, OS_WAVE = 16 * OS_ROW;
static_assert(ATTN_LDS + 8 * OS_WAVE <= RING_BYTES, "attention staging tiles");
static_assert(ATTN_LDS <= RING_BYTES, "attention LDS");
typedef __bf16 bf16v2 __attribute__((ext_vector_type(2)));
__device__ __forceinline__ float dot2sq(unsigned w, float acc) { const bf16v2 v = __builtin_bit_cast(bf16v2, w); return __builtin_amdgcn_fdot2_f32_bf16(v, v, acc, false); }
__device__ __forceinline__ void swap32(float v, float& a, float& b) { unsigned u = __builtin_bit_cast(unsigned, v), u2 = u; asm volatile("" : "+v"(u2));
    auto r = __builtin_amdgcn_permlane32_swap(u, u2, false, false); unsigned x0 = r[0], x1 = r[1]; asm volatile("" : "+v"(x0), "+v"(x1)); a = __builtin_bit_cast(float, x0); b = __builtin_bit_cast(float, x1); }
__device__ __forceinline__ void swap16(float v, float& a, float& b) { unsigned u = __builtin_bit_cast(unsigned, v), u2 = u; asm volatile("" : "+v"(u2));
    auto r = __builtin_amdgcn_permlane16_swap(u, u2, false, false); unsigned x0 = r[0], x1 = r[1]; asm volatile("" : "+v"(x0), "+v"(x1)); a = __builtin_bit_cast(float, x0); b = __builtin_bit_cast(float, x1); }
__device__ __forceinline__ float max3f(float a, float b, float c) { float r; asm("v_max3_f32 %0, %1, %2, %3" : "=v"(r) : "v"(a), "v"(b), "v"(c)); return r; }
__device__ __forceinline__ float quad_sum(float v) { float a, b; swap32(v, a, b); v = a + b; swap16(v, a, b); return a + b; }
__device__ __forceinline__ float quad_max(float v) { float a, b; swap32(v, a, b); v = __builtin_amdgcn_fmed3f(a, b, INFINITY); swap16(v, a, b); return __builtin_amdgcn_fmed3f(a, b, INFINITY); }
__device__ __forceinline__ void p2_attn(Frame& F) {
    LAS unsigned char* KS = F.lds + KS_OFF; LAS unsigned char* VT = F.lds + VT_OFF; LAS float* BT = (LAS float*)(F.lds + BT_OFF);
    const int lane = F.lane, c = lane & 15, g = lane >> 4, w = F.wave, sub = lane & 7, grp = lane >> 3;
    for (int i = F.tid; i < 8 * BT_ROW; i += NWAVES * 64) { const int h = i / BT_ROW, rel = 143 - (i - h * BT_ROW); BT[i] = (rel >= 0 && rel < 128) ? F.rel_bias[T5B[rel & 127] * NQH + h] * LOG2E : 0.f; }
    if (F.tid < 8) BT[8 * BT_ROW + F.tid] = F.sinks[F.tid] * LOG2E;
    float kg8[8];
#pragma unroll
    for (int j = 0; j < 8; ++j) kg8[j] = F.k_norm[8 * sub + j] * F.q_norm[8 * sub + j];
    __syncthreads();
    LAS unsigned char* const OS = F.lds + ATTN_LDS + w * OS_WAVE;
    const LAS float* btl = BT + (15 - c + 4 * g);
    bool lo_ok[4];
#pragma unroll
    for (int j = 0; j < 4; ++j) lo_ok[j] = (4 * g + j) > c;
    const unsigned onesw = 0x3f803f80u; const bf16x8 ONES = __builtin_bit_cast(bf16x8, ((v4u){onesw, onesw, onesw, onesw}));
    v4u kr[4], vr[4];
#define ATTN_FETCH(unit_, kv_) do { const int _blk = (unit_) % (SEQ / 128), _t0 = (unit_) * 128; \
        _Pragma("unroll") for (int i = 0; i < 4; ++i) { \
            const int keyk = 32 * w + 8 * i + grp, keyv = 32 * w + 2 * grp + (i & 1) + 16 * (i >> 1); \
            kr[i] = (v4u){0u, 0u, 0u, 0u}; vr[i] = (v4u){0u, 0u, 0u, 0u}; \
            if (!(_blk == 0 && keyk < 128)) kr[i] = *(const v4u*)(F.proj + (size_t)(_t0 - 128 + keyk) * PW + P_K + 64 * (kv_) + 8 * sub); \
            if (!(_blk == 0 && keyv < 128)) vr[i] = *(const v4u*)(F.proj + (size_t)(_t0 - 128 + keyv) * PW + P_V + 64 * (kv_) + 8 * sub); } } while (0)
    if ((int)blockIdx.x < T / 128) ATTN_FETCH((int)blockIdx.x, 0);
    for (int unit = blockIdx.x; unit < T / 128; unit += F.G) {
        const int blk = unit % (SEQ / 128), t0 = unit * 128, tq = t0 + 16 * w + c;
        float ssq = 0.f;
        const bf16* qbase = F.proj + (size_t)tq * PW + P_Q + 8 * g;
        v4u qr[2][2];
#pragma unroll
        for (int e = 0; e < 2; ++e) { qr[e][0] = *(const v4u*)(qbase + 64 * e); qr[e][1] = *(const v4u*)(qbase + 64 * e + 32); }
#pragma unroll 1
        for (int kv = 0; kv < 2; ++kv) {
            __syncthreads();
            {
#pragma unroll
                for (int i = 0; i < 4; ++i) {
                    float k[8]; unpack8(kr[i], k); float ss = 0.f;
#pragma unroll
                    for (int j = 0; j < 8; ++j) ss += k[j] * k[j];
                    ss += __shfl_xor(ss, 1); ss += __shfl_xor(ss, 2); ss += __shfl_xor(ss, 4);
                    const float r = __builtin_amdgcn_rsqf(ss * (1.f / HD) + EPS);
#pragma unroll
                    for (int j = 0; j < 8; ++j) k[j] = k[j] * r * kg8[j];
                    *(LAS v4u*)(KS + (32 * w + 8 * i + grp) * KS_STRIDE + sub * 16) = pack8(k);
                }
#pragma unroll
                for (int pp = 0; pp < 2; ++pp) {
                    const v4u a = vr[2 * pp], b = vr[2 * pp + 1]; const unsigned aw[4] = {a.x, a.y, a.z, a.w}, bw[4] = {b.x, b.y, b.z, b.w};
                    const int key0 = 32 * w + 2 * grp + 16 * pp;
#pragma unroll
                    for (int jj = 0; jj < 8; ++jj) {
                        const unsigned word = (jj & 1) ? ((aw[jj >> 1] >> 16) | (bw[jj >> 1] & 0xffff0000u)) : ((aw[jj >> 1] & 0xffffu) | (bw[jj >> 1] << 16));
                        *(LAS unsigned*)(VT + (8 * sub + jj) * VT_STRIDE + key0 * 2) = word;
                    }
                }
            }
            __syncthreads();
            { const int nu = kv == 0 ? unit : unit + F.G; if (nu < T / 128) ATTN_FETCH(nu, kv ^ 1); }
#pragma unroll 1
            for (int hp = 0; hp < 2; ++hp) {
                const int h0 = 4 * kv + 2 * hp;
                bf16x8 Q[2][2]; float rs[2];
#pragma unroll
                for (int e = 0; e < 2; ++e) {
                    Q[e][0] = __builtin_bit_cast(bf16x8, qr[e][0]); Q[e][1] = __builtin_bit_cast(bf16x8, qr[e][1]);
                    float ss = dot2sq(qr[e][0].x, 0.f); ss = dot2sq(qr[e][0].y, ss); ss = dot2sq(qr[e][0].z, ss); ss = dot2sq(qr[e][0].w, ss);
                    ss = dot2sq(qr[e][1].x, ss); ss = dot2sq(qr[e][1].y, ss); ss = dot2sq(qr[e][1].z, ss); ss = dot2sq(qr[e][1].w, ss);
                    ss = quad_sum(ss);
                    rs[e] = __builtin_amdgcn_rsqf(ss * (1.f / HD) + EPS) * (0.125f * LOG2E);
                }
                if (h0 < 6) {
#pragma unroll
                    for (int e = 0; e < 2; ++e) { qr[e][0] = *(const v4u*)(qbase + 64 * (h0 + 2 + e)); qr[e][1] = *(const v4u*)(qbase + 64 * (h0 + 2 + e) + 32); } }
                f32x4 st[2][9];
#pragma unroll
                for (int kb = 0; kb < 3; ++kb) {
                    bf16x8 kf[3][2];
#pragma unroll
                    for (int i = 0; i < 3; ++i) { const LAS unsigned char* kp = KS + (16 * (w + 3 * kb + i) + c) * KS_STRIDE + g * 16; kf[i][0] = *(const LAS bf16x8*)kp; kf[i][1] = *(const LAS bf16x8*)(kp + 64); }
                    __builtin_amdgcn_sched_barrier(0);
#pragma unroll
                    for (int i = 0; i < 3; ++i)
#pragma unroll
                        for (int e = 0; e < 2; ++e) { f32x4 z = (f32x4){0.f, 0.f, 0.f, 0.f};
                            z = __builtin_amdgcn_mfma_f32_16x16x32_bf16(kf[i][0], Q[e][0], z, 0, 0, 0);
                            st[e][3 * kb + i] = __builtin_amdgcn_mfma_f32_16x16x32_bf16(kf[i][1], Q[e][1], z, 0, 0, 0); }
                }
                float sk[2], m[2]; bf16x8 P[2][5];
#pragma unroll
                for (int e = 0; e < 2; ++e) {
                    sk[e] = BT[8 * BT_ROW + h0 + e];
                    const LAS float* bt = btl + (h0 + e) * BT_ROW;
#pragma unroll
                    for (int kt = 0; kt < 9; ++kt)
#pragma unroll
                        for (int j = 0; j < 4; ++j) {
                            float v = st[e][kt][j] * rs[e] + bt[16 * kt + j];
                            if (kt == 0) v = lo_ok[j] ? v : -INFINITY;
                            if (kt == 8) v = lo_ok[j] ? -INFINITY : v;
                            st[e][kt][j] = v;
                        }
                    if (blk == 0) {
#pragma unroll
                        for (int kt = 0; kt < 8; ++kt) { const bool dead = (w + kt) < 8;
#pragma unroll
                            for (int j = 0; j < 4; ++j) st[e][kt][j] = dead ? -INFINITY : st[e][kt][j]; }
                    }
                    float mm = sk[e];
#pragma unroll
                    for (int kt = 0; kt < 9; ++kt) { mm = max3f(mm, st[e][kt][0], st[e][kt][1]); mm = max3f(mm, st[e][kt][2], st[e][kt][3]); }
                    m[e] = quad_max(mm);
                }
#pragma unroll
                for (int e = 0; e < 2; ++e) {
#pragma unroll
                    for (int kt = 0; kt < 9; ++kt)
#pragma unroll
                        for (int j = 0; j < 4; ++j) st[e][kt][j] = __builtin_amdgcn_exp2f(st[e][kt][j] - m[e]);
#pragma unroll
                    for (int u = 0; u < 5; ++u) {
                        v4u pw; pw.x = pg8::cvt_pk_bf16(st[e][2 * u][0], st[e][2 * u][1]); pw.y = pg8::cvt_pk_bf16(st[e][2 * u][2], st[e][2 * u][3]);
                        if (u < 4) { pw.z = pg8::cvt_pk_bf16(st[e][2 * u + 1][0], st[e][2 * u + 1][1]); pw.w = pg8::cvt_pk_bf16(st[e][2 * u + 1][2], st[e][2 * u + 1][3]); } else { pw.z = 0u; pw.w = 0u; }
                        P[e][u] = __builtin_bit_cast(bf16x8, pw);
                    }
                }
                f32x4 ls[2];
#pragma unroll
                for (int e = 0; e < 2; ++e) { ls[e] = (f32x4){0.f, 0.f, 0.f, 0.f};
#pragma unroll
                    for (int u = 0; u < 5; ++u) ls[e] = __builtin_amdgcn_mfma_f32_16x16x32_bf16(ONES, P[e][u], ls[e], 0, 0, 0); }
                f32x4 o[2][4];
#pragma unroll
                for (int dt = 0; dt < 4; ++dt) {
                    o[0][dt] = (f32x4){0.f, 0.f, 0.f, 0.f}; o[1][dt] = (f32x4){0.f, 0.f, 0.f, 0.f};
#pragma unroll
                    for (int u = 0; u < 5; ++u) {
                        const LAS unsigned char* vp = VT + (16 * dt + c) * VT_STRIDE + (16 * (w + 2 * u) + 4 * g) * 2;
                        const v2u lo = *(const LAS v2u*)vp; const v2u hi = (u < 4) ? *(const LAS v2u*)(vp + 32) : lo;
                        const bf16x8 vv = __builtin_bit_cast(bf16x8, ((v4u){lo.x, lo.y, hi.x, hi.y}));
                        o[0][dt] = __builtin_amdgcn_mfma_f32_16x16x32_bf16(vv, P[0][u], o[0][dt], 0, 0, 0);
                        o[1][dt] = __builtin_amdgcn_mfma_f32_16x16x32_bf16(vv, P[1][u], o[1][dt], 0, 0, 0);
                    }
                }
#pragma unroll
                for (int e = 0; e < 2; ++e) {
                    const int h = h0 + e;
                    const float inv = __builtin_amdgcn_rcpf(ls[e][0] + __builtin_amdgcn_exp2f(sk[e] - m[e]));
#pragma unroll
                    for (int dt = 0; dt < 4; ++dt) {
                        const f32x4 ov = o[e][dt] * inv;
                        ssq += (ov[0] * ov[0] + ov[1] * ov[1]) + (ov[2] * ov[2] + ov[3] * ov[3]);
                        v2u ow; ow.x = pg8::cvt_pk_bf16(ov[0], ov[1]); ow.y = pg8::cvt_pk_bf16(ov[2], ov[3]);
                        *(LAS v2u*)(OS + c * OS_ROW + (16 * dt + 4 * g) * 2) = ow;
                    }
                    asm volatile("" ::: "memory");
                    {
                        const LAS v2u* sp = (const LAS v2u*)(OS + c * OS_ROW + 32 * g);
                        const v2u a0 = sp[0], a1 = sp[1], a2 = sp[2], a3 = sp[3];
                        v4u* const op = (v4u*)(F.mix + (size_t)tq * D + 64 * h + 16 * g);
                        op[0] = (v4u){a0.x, a0.y, a1.x, a1.y}; op[1] = (v4u){a2.x, a2.y, a3.x, a3.y};
                    }
                    asm volatile("" ::: "memory");
                }
            }
        }
        ssq = quad_sum(ssq);
        const float rstd = __builtin_amdgcn_rsqf(ssq * (1.f / ATTNW) + EPS);
        if (g == 0) F.rsa[tq] = rstd;
    }
#undef ATTN_FETCH
    __syncthreads();
}

constexpr int RT_SCR_OFF = 133120, RT_CNT_OFF = RT_SCR_OFF + 8 * 16 * 33 * 4;
static_assert(RT_CNT_OFF + 256 <= LDS_BYTES && RT_SCR_OFF >= MISC_OFF + 128, "router LDS");
__device__ __forceinline__ void p3b_router(Frame& F, const bool commit) {
    const int lane = F.lane, fr = lane & 15, fq = lane >> 4, w = F.wave;
    LAS unsigned char* WL = F.lds;
    LAS float* scr = (LAS float*)(F.lds + RT_SCR_OFF) + w * (16 * 33);
    LAS unsigned* lcnt = (LAS unsigned*)(F.lds + RT_CNT_OFF); LAS unsigned* lbase = lcnt + 32;
    for (int ci = F.tid; ci < 2 * NEXP * 128; ci += NWAVES * 64) { const int row = ci >> 7, ch = ci & 127;
        *(LAS v4u*)(WL + row * 2048 + ((ch ^ (row & 15)) << 4)) = *(const v4u*)(F.WR + (size_t)row * D + ch * 8); }
    for (int chunk = F.vcu; chunk < T / 256; chunk += F.G) {
    if (F.tid < 32) lcnt[F.tid] = 0u;
    __syncthreads();
    int re[2][4]; unsigned rrank[2][4]; float rrs[2];
#pragma unroll
    for (int it = 0; it < 2; ++it) {
        const int tok0 = chunk * 256 + w * 32 + it * 16;
        f32x4 a0 = (f32x4){0.f, 0.f, 0.f, 0.f}, a1 = a0; float ss = 0.f;
        const bf16* xp = F.x1b + (size_t)(tok0 + fr) * D + 8 * fq;
#pragma unroll 1
        for (int s0 = 0; s0 < 32; s0 += 16) {
            v4u xa[16];
#pragma unroll
            for (int s = 0; s < 16; ++s) xa[s] = *(const v4u*)(xp + 32 * (s0 + s));
#pragma unroll
            for (int s = 0; s < 16; ++s) {
                float f[8]; unpack8(xa[s], f);
#pragma unroll
                for (int j = 0; j < 8; ++j) ss += f[j] * f[j];
                const int ch = 4 * (s0 + s) + fq; const bf16x8 av = __builtin_bit_cast(bf16x8, xa[s]);
                const bf16x8 h0 = *(const LAS bf16x8*)(WL + fr * 2048 + ((ch ^ fr) << 4)), h1 = *(const LAS bf16x8*)(WL + (16 + fr) * 2048 + ((ch ^ fr) << 4));
                const bf16x8 l0 = *(const LAS bf16x8*)(WL + (32 + fr) * 2048 + ((ch ^ fr) << 4)), l1 = *(const LAS bf16x8*)(WL + (48 + fr) * 2048 + ((ch ^ fr) << 4));
                a0 = __builtin_amdgcn_mfma_f32_16x16x32_bf16(av, h0, a0, 0, 0, 0); a1 = __builtin_amdgcn_mfma_f32_16x16x32_bf16(av, h1, a1, 0, 0, 0);
                a0 = __builtin_amdgcn_mfma_f32_16x16x32_bf16(av, l0, a0, 0, 0, 0); a1 = __builtin_amdgcn_mfma_f32_16x16x32_bf16(av, l1, a1, 0, 0, 0);
            }
        }
        ss += __shfl_xor(ss, 16); ss += __shfl_xor(ss, 32);
        const float rstd = 1.f / sqrtf(ss * (1.f / D) + EPS);
#pragma unroll
        for (int j = 0; j < 4; ++j) { scr[(4 * fq + j) * 33 + fr] = a0[j]; scr[(4 * fq + j) * 33 + 16 + fr] = a1[j]; }
        LDS_WAIT(); asm volatile("" ::: "memory");
        rrs[it] = rstd;
#pragma unroll
        for (int k = 0; k < 4; ++k) { re[it][k] = 0; rrank[it][k] = 0u; }
        if (lane < 16) {
            const int t = tok0 + lane;
            float lg[NEXP];
#pragma unroll
            for (int e = 0; e < NEXP; ++e) lg[e] = scr[lane * 33 + e] * rstd + F.b_router[e];
            float val[4]; unsigned used = 0u;
#pragma unroll
            for (int k = 0; k < 4; ++k) { int bi = 0; float bv = -INFINITY;
#pragma unroll
                for (int e = 0; e < NEXP; ++e) { const bool tk = !((used >> e) & 1u) && (lg[e] > bv); bv = tk ? lg[e] : bv; bi = tk ? e : bi; }
                re[it][k] = bi; val[k] = bv; used |= 1u << bi; }
            float pe[4], den = 0.f;
#pragma unroll
            for (int k = 0; k < 4; ++k) { pe[k] = __expf(val[k] - val[0]); den += pe[k]; }
            const float id = 1.f / den;
            *(f32x4*)(F.gate + (size_t)t * 4) = (f32x4){pe[0] * id, pe[1] * id, pe[2] * id, pe[3] * id};
            F.rstd[t] = rstd;
            if (commit) {
#pragma unroll
            for (int k = 0; k < 4; ++k) rrank[it][k] = __hip_atomic_fetch_add(lcnt + re[it][k], 1u, __ATOMIC_RELAXED, __HIP_MEMORY_SCOPE_WORKGROUP); }
        }
        LDS_WAIT(); asm volatile("" ::: "memory");
    }
    __syncthreads();
    if (F.tid < 32 && commit) lbase[F.tid] = __hip_atomic_fetch_add(F.ctl + CW_CNT + F.tid, lcnt[F.tid], RLX_AGENT);
    __syncthreads();
    if (lane < 16 && commit) {
#pragma unroll
        for (int it = 0; it < 2; ++it) { const int t = chunk * 256 + w * 32 + it * 16 + lane;
#pragma unroll
            for (int k = 0; k < 4; ++k) { const size_t p = (size_t)re[it][k] * T + lbase[re[it][k]] + rrank[it][k]; F.dest[p] = (unsigned)(t * 4 + k); F.rsl[p] = rrs[it]; } }
    }
    __syncthreads();
    }
}

__device__ __forceinline__ void unpack4_fp8(unsigned w, float (&f)[4]) {
    const f32x2 a = __builtin_amdgcn_cvt_pk_f32_fp8((int)w, false), b = __builtin_amdgcn_cvt_pk_f32_fp8((int)w, true); f[0] = a[0]; f[1] = a[1]; f[2] = b[0]; f[3] = b[1];
}
__device__ __forceinline__ void p6_combine(Frame& F) {
    const int gw = F.vcu * NWAVES + F.wave, NGW = F.G * NWAVES, lane = F.lane;
    for (int t = gw * 2; t < T; t += NGW * 2) {
        v2u xb[2][4]; unsigned yv[2][4][4]; f32x4 gt[2];
#pragma unroll
        for (int q = 0; q < 2; ++q) {
            const bf16* xp = F.x1b + (size_t)(t + q) * D + 4 * lane;
#pragma unroll
            for (int j = 0; j < 4; ++j) xb[q][j] = __builtin_nontemporal_load((const v2u*)(xp + 256 * j));
            gt[q] = *(const f32x4*)(F.gate + (size_t)(t + q) * 4) * (1.0f / YS_SCALE);
#pragma unroll
            for (int k = 0; k < 4; ++k) { const unsigned char* yp = F.ys + ((size_t)(t + q) * 4 + k) * D + 4 * lane;
#pragma unroll
                for (int j = 0; j < 4; ++j) yv[q][k][j] = __builtin_nontemporal_load((const unsigned*)(yp + 256 * j)); }
        }
#pragma unroll
        for (int q = 0; q < 2; ++q)
#pragma unroll
            for (int j = 0; j < 4; ++j) {
                float o[4] = {bflo(xb[q][j].x), bfhi(xb[q][j].x), bflo(xb[q][j].y), bfhi(xb[q][j].y)};
#pragma unroll
                for (int k = 0; k < 4; ++k) { float y[4]; unpack4_fp8(yv[q][k][j], y);
#pragma unroll
                    for (int i = 0; i < 4; ++i) o[i] += gt[q][k] * y[i]; }
                __builtin_nontemporal_store((f32x4){o[0], o[1], o[2], o[3]}, (f32x4*)(F.out + (size_t)(t + q) * D + 4 * lane + 256 * j));
            }
    }
}
#ifndef NS_RELAX
#define NS_RELAX(n) 0
#endif
#ifndef P5_KREP
#define P5_KREP 1
#endif
#ifndef P5_EREP
#define P5_EREP 1
#endif
#ifndef P2_CONV_REP
#define P2_CONV_REP 1
#endif
#ifndef P2_ATTN_REP
#define P2_ATTN_REP 1
#endif
#ifndef STAG1
#define STAG1 0
#define STAG3 0
#define STAG5 0
#define STAG6 0
#endif
constexpr int N_PHASES = 8;
struct Args { const float* in[20]; float* out; unsigned char* ws; int ph_lo, ph_hi, li, pad; };
__global__ void __launch_bounds__(NWAVES * 64, 2) mega_fwd(Args) {
    extern __shared__ __attribute__((aligned(16))) unsigned char lds[];
    Frame F;
    F.lds = (LAS unsigned char*)lds;
    F.MISC = (volatile LAS unsigned*)(F.lds + MISC_OFF);
    F.tid = threadIdx.x; F.lane = F.tid & 63; F.wave = __builtin_amdgcn_readfirstlane(F.tid >> 6);
    F.G = gridDim.x; { const int bx = blockIdx.x; F.vcu = (F.G % 8 == 0) ? (bx % 8) * (F.G / 8) + bx / 8 : bx; }
    typedef const __attribute__((address_space(4))) unsigned char* kptr_t;
    const kptr_t ka = (kptr_t)__builtin_amdgcn_kernarg_segment_ptr();
#define KIN(k) (*(const float* const __attribute__((address_space(4)))*)(ka + 8 * (k)))
#define KWS() (*(unsigned char* const __attribute__((address_space(4)))*)(ka + 168))
#define KOUT() (*(float* const __attribute__((address_space(4)))*)(ka + 160))
#define KINT(off) (*(const int __attribute__((address_space(4)))*)(ka + (off)))
#define FRAME_PTRS() do { unsigned char* ws = KWS(); \
    F.x = KIN(0); F.norm_mix = KIN(1); F.w_in = KIN(2); F.b_in = KIN(3); F.conv_w = KIN(4); F.q_norm = KIN(5); F.k_norm = KIN(6); F.sinks = KIN(7); \
    F.rel_bias = KIN(8); F.on_conv = KIN(9); F.on_attn = KIN(10); F.w_out = KIN(11); F.b_out = KIN(12); F.norm_ffn = KIN(13); F.w_router = KIN(14); F.b_router = KIN(15); \
    F.w1 = KIN(16); F.b1 = KIN(17); F.w2 = KIN(18); F.b2 = KIN(19); F.out = KOUT(); \
    F.WinT = (bf16*)(ws + WS_WINT); F.WoutT = (bf16*)(ws + WS_WOUTT); F.W1Q = ws + WS_W1T; F.W2Q = ws + WS_W2T; F.WR = (bf16*)(ws + WS_WR); F.x1q = ws + WS_X1Q; F.act = ws + WS_ACT; \
    F.B1S = (float*)(ws + WS_B1); F.rstd = (float*)(ws + WS_RSTD); F.gate = (float*)(ws + WS_GATE); F.rsl = (float*)(ws + WS_RSL); F.rin = (float*)(ws + WS_RIN); F.ginv = (float*)(ws + WS_GINV); F.rsa = (float*)(ws + WS_RSA); F.dest = (unsigned*)(ws + WS_DEST); \
    F.xn = (bf16*)(ws + WS_XN); F.proj = (bf16*)(ws + WS_PROJ); F.mix = (bf16*)(ws + WS_MIX); F.x1b = (bf16*)(ws + WS_X1B); F.ys = ws + WS_YS; } while (0)
    static_assert(sizeof(Args) == 192 && offsetof(Args, out) == 160 && offsetof(Args, ws) == 168 && offsetof(Args, ph_lo) == 176 && offsetof(Args, li) == 184, "kernarg layout");
    F.ctl = (gu32*)(KWS() + WS_CTL);
    for (int u = F.tid; u < (MISC_OFF + 128 - MOE_OFF) / 4; u += NWAVES * 64) ((LAS unsigned*)(F.lds + MOE_OFF))[u] = 0u;
    __syncthreads();
    XcdBarrier bar = xcd_barrier_post((unsigned*)(F.ctl + CW_BAR) + KINT(184) * XCD_BAR_WORDS, F.MISC + 8);
    const int lo = KINT(176), hi = KINT(180);
#ifndef COMPILE_MASK
#define COMPILE_MASK 0xFF
#endif
#define IN(k) (((COMPILE_MASK >> (k)) & 1) && lo <= (k) && (k) < hi)
#define SEAM(k) do { if (IN(k) && IN((k) + 1)) xcd_barrier(bar); } while (0)
#ifndef REPEAT_MASK
#define REPEAT_MASK 0
#endif
#define REPS(k) (((REPEAT_MASK >> (k)) & 1) ? 2 : 1)

    if (IN(0)) { FRAME_PTRS(); for (int rep = 0; rep < REPS(0); ++rep) p0_prologue(F); } SEAM(0);
    if (IN(1)) {
        FRAME_PTRS();
        pg8::DenseOrder S; S.init(F.xn, F.WinT, T, INW, D, F.G, (int)blockIdx.x); S.bias = F.b_in; S.tab = F.lds + TAB_OFF; S.cu_mode = 1;
        EpiIn E{F.proj, F.lds + TAB_OFF};
        for (int rep = 0; rep < REPS(1); ++rep) pg8::gemm_phase<EpiIn, pg8::DenseOrder, false, true, false, true, P1_KREP, 1, NS_RELAX(16)>(F.lds + RING_OFF, D, S, E, STAG1);
    } SEAM(1);
    if (IN(2)) { FRAME_PTRS(); for (int rep = 0; rep < REPS(2); ++rep) {
            _Pragma("unroll 1") for (int step = 0; step < 2; ++step) { if ((((int)blockIdx.x >> 3) & 1) == step) p2_conv(F); else p2_attn(F); } } } SEAM(2);
    if (IN(3)) {
        FRAME_PTRS();
        pg8::DenseOrder S; S.init(F.mix, F.WoutT, T, D, D, F.G, (int)blockIdx.x); S.bias = F.b_out; S.tab = F.lds + TAB_OFF; S.rowvec = F.rin; S.colvec = F.ginv; S.rowvec2 = F.rsa;
        EpiOut E{F.x1b, F.lds + TAB_OFF, F.xn, F.x1q};
        for (int rep = 0; rep < REPS(3); ++rep) pg8::gemm_phase<EpiOut, pg8::DenseOrder, false, true, false, true, 1, 1, NS_RELAX(24), ATTNW / 64>(F.lds + RING_OFF, D, S, E, STAG3);
    } SEAM(3);
    if (IN(4)) { FRAME_PTRS(); for (int rep = 0; rep < REPS(4); ++rep) p3b_router(F, rep == REPS(4) - 1); } SEAM(4);
    if (IN(5)) {
        FRAME_PTRS();
        const int NT = moe_tables(F);
        const LAS int* tile0 = (const LAS int*)(F.lds + MOE_OFF); const LAS int* ecnt = tile0 + 40;
        MoeOrder<true> S{(const char*)F.x1q, (const char*)F.W1Q, (size_t)2 * DFF * D, (size_t)256 * D, 2 * DFF / 256, F.G, (int)blockIdx.x, NT, tile0, ecnt, F.dest, F.rsl, F.lds + TAB_OFF, F.B1S, 1};
        EpiW1 E{F.act, F.lds + TAB_OFF, ecnt};
        for (int rep = 0; rep < REPS(5); ++rep) pg8::gemm_phase<EpiW1, MoeOrder<true>, true, true, true, true, P5_KREP, P5_EREP, NS_RELAX(4)>(F.lds + RING_OFF, D / 2, S, E, STAG5);
    } SEAM(5);
    if (IN(6)) {
        FRAME_PTRS();
        const int NT = moe_tables(F);
        const LAS int* tile0 = (const LAS int*)(F.lds + MOE_OFF); const LAS int* ecnt = tile0 + 40;
        MoeOrder<false> S{(const char*)F.act, (const char*)F.W2Q, (size_t)D * DFF, (size_t)256 * DFF, D / 256, F.G, (int)blockIdx.x, NT, tile0, ecnt, F.dest, F.rsl, F.lds + TAB_OFF, F.b2, 2};
#ifndef P6_KREP
#define P6_KREP 1
#endif
#ifndef P6_EREP
#define P6_EREP 1
#endif
        EpiW2 E{F.ys, F.lds + TAB_OFF, ecnt};
        for (int rep = 0; rep < REPS(6); ++rep) pg8::gemm_phase<EpiW2, MoeOrder<false>, true, true, true, true, 1, 1, NS_RELAX(8)>(F.lds + RING_OFF, DFF / 2, S, E, STAG6);
    } SEAM(6);
    if (IN(7)) { FRAME_PTRS(); for (int rep = 0; rep < REPS(7); ++rep) p6_combine(F); }
#undef IN
#undef SEAM
}

#ifndef FAST_MASK
#define FAST_MASK 0xFF
#endif
extern "C" void kernel_launch(void* const* d_in, const int* in_sizes, int n_in, void* d_out, int out_size, void* d_ws, size_t ws_size, hipStream_t stream) {
    static int grid = 0;
    if (grid == 0) {
        if (n_in != 20 || in_sizes[0] != T * D || out_size != T * D || ws_size < WS_END) { fprintf(stderr, "kernel_launch: unexpected shapes (n_in %d, in0 %d, out %d, ws %zu); nothing launched\n", n_in, n_in > 0 ? in_sizes[0] : -1, out_size, ws_size); grid = -1; return; }
        int dev = 0, cus = 0, per_cu = 0;
        if (hipGetDevice(&dev) != hipSuccess || hipDeviceGetAttribute(&cus, hipDeviceAttributeMultiprocessorCount, dev) != hipSuccess) { grid = -1; return; }
        if (hipFuncSetAttribute((const void*)mega_fwd, hipFuncAttributeMaxDynamicSharedMemorySize, LDS_BYTES) != hipSuccess) { fprintf(stderr, "kernel_launch: hipFuncSetAttribute failed\n"); grid = -1; return; }
        if (hipOccupancyMaxActiveBlocksPerMultiprocessor(&per_cu, (const void*)mega_fwd, NWAVES * 64, LDS_BYTES) != hipSuccess || per_cu < 1) fprintf(stderr, "kernel_launch: note: occupancy query reports %d\n", per_cu);
        (void)hipGetLastError();
        grid = cus;
        if (grid != 256) fprintf(stderr, "kernel_launch: %d CUs (built for 256)\n", grid);
    }
    if (grid < 0) return;
    const float* const* in = (const float* const*)d_in;
    unsigned char* ws = (unsigned char*)d_ws; float* out = (float*)d_out;
    (void)hipMemsetAsync(ws + WS_CTL, 0, CTL_ZERO_BYTES, stream);
    Args a{};
    for (int i = 0; i < 20; ++i) a.in[i] = in[i];
    a.out = out; a.ws = ws;
    unsigned* cnt = (unsigned*)(ws + WS_CTL) + CW_CNT;
    bf16* xn = (bf16*)(ws + WS_XN); bf16* proj = (bf16*)(ws + WS_PROJ); bf16* mix = (bf16*)(ws + WS_MIX); bf16* x1b = (bf16*)(ws + WS_X1B);
    float* rstd = (float*)(ws + WS_RSTD); float* gate = (float*)(ws + WS_GATE); float* rsl = (float*)(ws + WS_RSL); unsigned* dest = (unsigned*)(ws + WS_DEST);
    unsigned char* ys = ws + WS_YS;
    static_assert(((FAST_MASK >> 1) & 3) == 3 || ((FAST_MASK >> 1) & 3) == 0, "in-proj and conv/attention share the fused proj layout: both fast or both naive");
    static_assert(((FAST_MASK >> 5) & 7) == 7, "the MoE GEMM phases have no naive twin in the fp8 build");
    int li = 0;
    for (int p = 0; p < N_PHASES;) {
        if ((FAST_MASK >> p) & 1) {
            int q = p; while (q < N_PHASES && ((FAST_MASK >> q) & 1)) ++q;
            a.ph_lo = p; a.ph_hi = q; a.li = li++;
            hipLaunchKernelGGL(mega_fwd, dim3(grid), dim3(NWAVES * 64), LDS_BYTES, stream, a);
            p = q; continue;
        }
        switch (p) {
        case 0: a.ph_lo = 0; a.ph_hi = 1; a.li = li++; hipLaunchKernelGGL(mega_fwd, dim3(grid), dim3(NWAVES * 64), LDS_BYTES, stream, a);
                hipLaunchKernelGGL(nv::k_rms_in, dim3(T / 4), dim3(256), 0, stream, in[0], in[1], xn); break;
        case 1: { nv::OpIn op{xn, in[2], in[3], proj, 0, 0}; hipLaunchKernelGGL((nv::k_gemm<nv::OpIn>), dim3(INW / 128, T / 128), dim3(256), 0, stream, op, D); } break;
        case 2: hipLaunchKernelGGL(nv::k_conv, dim3(T), dim3(512), 0, stream, proj, in[4], in[9], mix);
                hipLaunchKernelGGL(nv::k_attn, dim3(T), dim3(512), 0, stream, proj, in[5], in[6], in[7], in[8], in[10], mix); break;
        case 3: { nv::OpOut op{mix, in[11], in[12], in[0], x1b, 0, 0}; hipLaunchKernelGGL((nv::k_gemm<nv::OpOut>), dim3(D / 128, T / 128), dim3(256), 0, stream, op, D); } break;
        case 4: hipLaunchKernelGGL(nv::k_router, dim3(T / 4), dim3(256), 0, stream, x1b, in[13], in[14], in[15], rstd, gate, dest, rsl, cnt); break;
        case 7:   break;
        }
        ++p;
    }
}
```

```cpp
#include <hip/hip_runtime.h>
#include <cstdio>
#include <cstdint>
#include <cstddef>
#include <cmath>

constexpr int BATCH = 8, SEQ = 8192, D = 1024, T = BATCH * SEQ;
constexpr int HD = 64, CONVW = 512, NQH = 8, NKVH = 2, QPKV = 4, ATTNW = 512, KVW = 128, INW = 2304;
constexpr int NEXP = 32, TOPK = 4, DFF = 1024;
constexpr float EPS = 1e-5f;
constexpr int QOFF = 3 * CONVW, KOFF = QOFF + ATTNW, VOFF = KOFF + KVW;
constexpr int PW = 1792, P_CU = 512, P_Q = 1024, P_K = 1536, P_V = 1664;

constexpr size_t MiB = 1u << 20;
constexpr size_t WS_CTL = 0, CTL_ZERO_BYTES = 1 * MiB;
constexpr size_t WS_RSTD = 1 * MiB;
constexpr size_t WS_WR = 1 * MiB + 512 * 1024;
constexpr size_t WS_B1 = 1 * MiB + 768 * 1024;
constexpr size_t WS_RSA = 3 * MiB;
constexpr size_t WS_GATE = 2 * MiB;
constexpr size_t WS_DEST = 4 * MiB;
constexpr size_t WS_RSL = 12 * MiB;
constexpr size_t WS_W2T = 20 * MiB;
constexpr size_t WS_W1T = 52 * MiB;
constexpr size_t WS_DUMMY = 116 * MiB;
constexpr size_t WS_X1B = 120 * MiB;
constexpr size_t WS_XN = 872 * MiB;
constexpr size_t WS_RIN = 1 * MiB + 256 * 1024;
constexpr size_t WS_GINV = 1 * MiB + 640 * 1024;
constexpr size_t WS_ACT = 248 * MiB;
constexpr size_t WS_MIX = WS_ACT;
constexpr size_t WS_YS = 512 * MiB;
constexpr size_t WS_PROJ = 512 * MiB;
constexpr size_t WS_WINT = 800 * MiB;
constexpr size_t WS_WOUTT = 805 * MiB;
constexpr size_t WS_X1Q = 808 * MiB;
constexpr size_t WS_END = 1024 * MiB;
static_assert(WS_PROJ + (size_t)T * INW * 2 <= WS_WINT && WS_YS + (size_t)T * 4 * D * 2 <= WS_END && WS_ACT + 264 * MiB <= WS_YS && WS_W1T + 64 * MiB <= WS_X1B && WS_W2T + 32 * MiB <= WS_W1T && WS_X1B + 128 * MiB <= WS_ACT && WS_X1Q + 64 * MiB <= WS_XN && WS_XN + 128 * MiB <= WS_END, "ws map");
constexpr float W_SCALE = 32.0f, ACT_SCALE = 4.0f, YS_SCALE = 8.0f;
constexpr int ACT_LO_TILES = 0;
constexpr int CW_TMO = 0, CW_CODE = 1;
constexpr int CW_CNT = 64;
constexpr int CW_BAR = 4096;

typedef unsigned short bf16;
typedef unsigned v4u __attribute__((ext_vector_type(4)));
typedef unsigned v2u __attribute__((ext_vector_type(2)));
typedef float f32x4 __attribute__((ext_vector_type(4)));
typedef float f32x2 __attribute__((ext_vector_type(2)));
typedef short bf16x8 __attribute__((ext_vector_type(8)));
typedef int i32x4 __attribute__((ext_vector_type(4)));
typedef int i32x8 __attribute__((ext_vector_type(8)));

__device__ __forceinline__ unsigned f2bf(float f) { unsigned u = __builtin_bit_cast(unsigned, f); return (u + 0x7fffu + ((u >> 16) & 1u)) >> 16; }
__device__ __forceinline__ unsigned pk2(float lo, float hi) { return f2bf(lo) | (f2bf(hi) << 16); }
__device__ __forceinline__ float bf2f(bf16 b) { return __builtin_bit_cast(float, (unsigned)b << 16); }
__device__ __forceinline__ float bflo(unsigned w) { return __builtin_bit_cast(float, w << 16); }
__device__ __forceinline__ float bfhi(unsigned w) { return __builtin_bit_cast(float, w & 0xffff0000u); }
__device__ __forceinline__ unsigned pk4_fp8(float a, float b, float c, float d) { int w = __builtin_bit_cast(int, a);
    w = __builtin_amdgcn_cvt_pk_fp8_f32(a, b, w, false); w = __builtin_amdgcn_cvt_pk_fp8_f32(c, d, w, true); return (unsigned)w; }
__device__ __forceinline__ void swap32(float v, float& a, float& b) { unsigned u = __builtin_bit_cast(unsigned, v), u2 = u; asm volatile("" : "+v"(u2));
    auto r = __builtin_amdgcn_permlane32_swap(u, u2, false, false); unsigned x0 = r[0], x1 = r[1]; asm volatile("" : "+v"(x0), "+v"(x1)); a = __builtin_bit_cast(float, x0); b = __builtin_bit_cast(float, x1); }
__device__ __forceinline__ void swap16(float v, float& a, float& b) { unsigned u = __builtin_bit_cast(unsigned, v), u2 = u; asm volatile("" : "+v"(u2));
    auto r = __builtin_amdgcn_permlane16_swap(u, u2, false, false); unsigned x0 = r[0], x1 = r[1]; asm volatile("" : "+v"(x0), "+v"(x1)); a = __builtin_bit_cast(float, x0); b = __builtin_bit_cast(float, x1); }
__device__ __forceinline__ float quad_sum(float v) { float a, b; swap32(v, a, b); v = a + b; swap16(v, a, b); return a + b; }
#define DPP_ADD(v_, ctrl_) ((v_) + __builtin_bit_cast(float, __builtin_amdgcn_update_dpp(0, __builtin_bit_cast(int, (v_)), (ctrl_), 0xF, 0xF, true)))
__device__ __forceinline__ float oct_sum(float v) { v = DPP_ADD(v, 0xB1); v = DPP_ADD(v, 0x4E); v = DPP_ADD(v, 0x141); return v; }
__device__ __forceinline__ float wave_sum(float v) { v = oct_sum(v); v = DPP_ADD(v, 0x140); return quad_sum(v); }
__device__ __forceinline__ float swiglu(float gl, float ln) {
    gl = fminf(gl, 7.0f); ln = fminf(fmaxf(ln, -7.0f), 7.0f);
    return gl * (1.0f / (1.0f + __expf(-1.702f * gl))) * (ln + 1.0f);
}
__device__ __forceinline__ f32x2 swiglu2_scaled(f32x2 gl, f32x2 ln) {
    gl.x = fminf(gl.x, 7.0f); gl.y = fminf(gl.y, 7.0f);
    ln.x = __builtin_amdgcn_fmed3f(ln.x, -7.0f, 7.0f); ln.y = __builtin_amdgcn_fmed3f(ln.y, -7.0f, 7.0f);
    const f32x2 z = gl * (-1.702f * 1.4426950408889634f);
    f32x2 e; e.x = __builtin_amdgcn_exp2f(z.x); e.y = __builtin_amdgcn_exp2f(z.y);
    e = e + 1.0f;
    f32x2 r; r.x = __builtin_amdgcn_rcpf(e.x); r.y = __builtin_amdgcn_rcpf(e.y);
    return (gl * r) * (ln * ACT_SCALE + ACT_SCALE);
}
__device__ __forceinline__ f32x2 swiglu2_pre(f32x2 gl, f32x2 l4) {
    gl.x = fminf(gl.x, 7.0f); gl.y = fminf(gl.y, 7.0f);
    l4.x = __builtin_amdgcn_fmed3f(l4.x, -6.0f * ACT_SCALE, 8.0f * ACT_SCALE); l4.y = __builtin_amdgcn_fmed3f(l4.y, -6.0f * ACT_SCALE, 8.0f * ACT_SCALE);
    const f32x2 z = gl * (-1.702f * 1.4426950408889634f);
    f32x2 e; e.x = __builtin_amdgcn_exp2f(z.x); e.y = __builtin_amdgcn_exp2f(z.y);
    e = e + 1.0f;
    f32x2 r; r.x = __builtin_amdgcn_rcpf(e.x); r.y = __builtin_amdgcn_rcpf(e.y);
    return (gl * r) * l4;
}
constexpr float SWI_CZ = -1.702f * 1.4426950408889634f, SWI_ICZ = 1.0f / SWI_CZ;
__device__ __forceinline__ f32x2 swiglu2_z(f32x2 z, f32x2 lz) {
    z.x = fmaxf(z.x, 7.0f * SWI_CZ); z.y = fmaxf(z.y, 7.0f * SWI_CZ);
    lz.x = __builtin_amdgcn_fmed3f(lz.x, 8.0f * ACT_SCALE * SWI_ICZ, -6.0f * ACT_SCALE * SWI_ICZ); lz.y = __builtin_amdgcn_fmed3f(lz.y, 8.0f * ACT_SCALE * SWI_ICZ, -6.0f * ACT_SCALE * SWI_ICZ);
    f32x2 e; e.x = __builtin_amdgcn_exp2f(z.x); e.y = __builtin_amdgcn_exp2f(z.y);
    e = e + 1.0f;
    f32x2 r; r.x = __builtin_amdgcn_rcpf(e.x); r.y = __builtin_amdgcn_rcpf(e.y);
    return (z * r) * lz;
}
__device__ __forceinline__ bf16* act_row(bf16* lo, bf16* hi, int slot) { return slot < ACT_LO_TILES * 256 ? lo + (size_t)slot * DFF : hi + (size_t)(slot - ACT_LO_TILES * 256) * DFF; }
__device__ const unsigned char T5B[128] = {0, 1, 2, 3, 4, 5, 6, 7, 8, 9, 10, 11, 12, 13, 14, 15, 16, 16, 16, 17, 17, 18, 18, 18, 19, 19, 19, 20, 20, 20, 20, 21, 21, 21, 21, 22, 22, 22, 22, 22, 23, 23, 23, 23, 23, 23, 24, 24, 24, 24, 24, 24, 25, 25, 25, 25, 25, 25, 25, 26, 26, 26, 26, 26, 26, 26, 26, 27, 27, 27, 27, 27, 27, 27, 27, 27, 27, 28, 28, 28, 28, 28, 28, 28, 28, 28, 28, 29, 29, 29, 29, 29, 29, 29, 29, 29, 29, 29, 29, 30, 30, 30, 30, 30, 30, 30, 30, 30, 30, 30, 30, 30, 30, 31, 31, 31, 31, 31, 31, 31, 31, 31, 31, 31, 31, 31, 31, 31};
#define FAST_MASK 0xFF
#define REPEAT_MASK 0

namespace nv {

__global__ void __launch_bounds__(256) k_rms_in(const float* __restrict__ x, const float* __restrict__ g, bf16* __restrict__ xn) {
    const int row = blockIdx.x * 4 + (threadIdx.x >> 6), lane = threadIdx.x & 63;
    const float* xr = x + (size_t)row * D;
    float v[16]; float ss = 0.f;
#pragma unroll
    for (int j = 0; j < 16; ++j) { v[j] = xr[lane + 64 * j]; ss += v[j] * v[j]; }
    ss = wave_sum(ss);
    const float rstd = 1.0f / sqrtf(ss * (1.0f / D) + EPS);
#pragma unroll
    for (int j = 0; j < 16; ++j) xn[(size_t)row * D + lane + 64 * j] = (bf16)f2bf(v[j] * rstd * g[lane + 64 * j]);
}

struct TileInfo { int valid; int e; int row0; int nrows; };

template <class Op>
__global__ void __launch_bounds__(256) k_gemm(Op op, int K) {
    __shared__ float As[16][132];
    __shared__ float Bs[16][132];
    const int tid = threadIdx.x, tx = tid & 15, ty = tid >> 4;
    if (!op.setup(blockIdx.y, blockIdx.x)) return;
    float acc[8][8];
#pragma unroll
    for (int i = 0; i < 8; ++i)
#pragma unroll
        for (int j = 0; j < 8; ++j) acc[i][j] = 0.f;
    const int ar = tid >> 1, ah = tid & 1;
    const bf16* arow = op.a_row(ar);
    const float* wcol = op.w_base() + (tid & 15) * 8;
    const int wk = tid >> 4;
    for (int k0 = 0; k0 < K; k0 += 16) {
        uint4 av = *(const uint4*)(arow + k0 + ah * 8);
        const unsigned aw[4] = {av.x, av.y, av.z, av.w};
#pragma unroll
        for (int j = 0; j < 4; ++j) {
            As[ah * 8 + 2 * j][ar] = bf2f((bf16)(aw[j] & 0xffff)) * op.a_scale(k0 + ah * 8 + 2 * j);
            As[ah * 8 + 2 * j + 1][ar] = bf2f((bf16)(aw[j] >> 16)) * op.a_scale(k0 + ah * 8 + 2 * j + 1);
        }
        const float4 w0 = *(const float4*)(wcol + (size_t)(k0 + wk) * op.ldw());
        const float4 w1 = *(const float4*)(wcol + (size_t)(k0 + wk) * op.ldw() + 4);
        *(float4*)&Bs[wk][(tid & 15) * 8] = w0; *(float4*)&Bs[wk][(tid & 15) * 8 + 4] = w1;
        __syncthreads();
#pragma unroll
        for (int kk = 0; kk < 16; ++kk) {
            float a[8], b[8];
#pragma unroll
            for (int i = 0; i < 8; ++i) a[i] = As[kk][ty * 8 + i];
#pragma unroll
            for (int j = 0; j < 8; ++j) b[j] = Bs[kk][tx * 8 + j];
#pragma unroll
            for (int i = 0; i < 8; ++i)
#pragma unroll
                for (int j = 0; j < 8; ++j) acc[i][j] += a[i] * b[j];
        }
        __syncthreads();
    }
#pragma unroll
    for (int i = 0; i < 8; ++i) op.epi(ty * 8 + i, tx * 8, acc[i]);
}

struct OpIn {
    const bf16* xn; const float* w; const float* b; bf16* proj; int by, bx;
    __device__ bool setup(int by_, int bx_) { by = by_; bx = bx_; return true; }
    __device__ const bf16* a_row(int r) const { return xn + (size_t)(by * 128 + r) * D; }
    __device__ const float* w_base() const { return w + bx * 128; }
    __device__ int ldw() const { return INW; }
    __device__ float a_scale(int) const { return 1.f; }
    __device__ void epi(int r, int c0, const float* v) const {
        const int row = by * 128 + r, col = bx * 128 + c0;
#pragma unroll
        for (int j = 0; j < 8; ++j) proj[(size_t)row * INW + col + j] = (bf16)f2bf(v[j] + b[col + j]);
    }
};
struct OpOut {
    const bf16* mix; const float* w; const float* b; const float* x; bf16* x1b; int by, bx;
    __device__ bool setup(int by_, int bx_) { by = by_; bx = bx_; return true; }
    __device__ const bf16* a_row(int r) const { return mix + (size_t)(by * 128 + r) * D; }
    __device__ const float* w_base() const { return w + bx * 128; }
    __device__ int ldw() const { return D; }
    __device__ float a_scale(int) const { return 1.f; }
    __device__ void epi(int r, int c0, const float* v) const {
        const int row = by * 128 + r, col = bx * 128 + c0;
#pragma unroll
        for (int j = 0; j < 8; ++j) x1b[(size_t)row * D + col + j] = (bf16)f2bf(x[(size_t)row * D + col + j] + v[j] + b[col + j]);
    }
};
__device__ inline bool moe_tile(const unsigned* cnt, int t128, int& e, int& pos0, int& slot0) {
    int base = 0;
    for (int i = 0; i < NEXP; ++i) { const int n128 = 2 * (((int)cnt[i] + 255) / 256); if (t128 < base + n128) { e = i; pos0 = (t128 - base) * 128; slot0 = base * 128 + pos0; return true; } base += n128; }
    return false;
}
struct OpW1 {
    const bf16* x1b; const float* w1; const float* b1; const float* g; const float* rstd; const unsigned* cnt; const unsigned* dest; bf16* act_lo; bf16* act_hi;
    int e, pos0, slot0, bx;
    __device__ bool setup(int by_, int bx_) { bx = bx_; return moe_tile(cnt, by_, e, pos0, slot0); }
    __device__ int tok(int r) const { const int pos = pos0 + r; return pos < (int)cnt[e] ? (int)(dest[(size_t)e * T + pos] >> 2) : 0; }
    __device__ const bf16* a_row(int r) const { return x1b + (size_t)tok(r) * D; }
    __device__ const float* w_base() const { return w1 + (size_t)e * D * 2 * DFF + bx * 128; }
    __device__ int ldw() const { return 2 * DFF; }
    __device__ float a_scale(int k) const { return g[k]; }
    __device__ void epi(int r, int c0, const float* v) const {
        const int slot = slot0 + r; const float rs = rstd[tok(r)];
        bf16* arow = act_row(act_lo, act_hi, slot);
        const int col = bx * 128 + c0;
#pragma unroll
        for (int j = 0; j < 4; ++j) {
            const float gl = v[2 * j] * rs + b1[(size_t)e * 2 * DFF + col + 2 * j], ln = v[2 * j + 1] * rs + b1[(size_t)e * 2 * DFF + col + 2 * j + 1];
            arow[(col >> 1) + j] = (bf16)f2bf(swiglu(gl, ln));
        }
    }
};
struct OpW2 {
    const bf16* act_lo; const bf16* act_hi; const float* w2; const float* b2; const unsigned* cnt; const unsigned* dest; bf16* ys;
    int e, pos0, slot0, bx;
    __device__ bool setup(int by_, int bx_) { bx = bx_; return moe_tile(cnt, by_, e, pos0, slot0); }
    __device__ const bf16* a_row(int r) const { return act_row((bf16*)act_lo, (bf16*)act_hi, slot0 + r); }
    __device__ const float* w_base() const { return w2 + (size_t)e * DFF * D + bx * 128; }
    __device__ int ldw() const { return D; }
    __device__ float a_scale(int) const { return 1.f; }
    __device__ void epi(int r, int c0, const float* v) const {
        const int pos = pos0 + r; if (pos >= (int)cnt[e]) return;
        const unsigned d = dest[(size_t)e * T + pos]; const int col = bx * 128 + c0;
#pragma unroll
        for (int j = 0; j < 8; ++j) ys[(size_t)d * D + col + j] = (bf16)f2bf(v[j] + b2[(size_t)e * D + col + j]);
    }
};

__global__ void __launch_bounds__(512) k_conv(const bf16* __restrict__ proj, const float* __restrict__ cw, const float* __restrict__ g, bf16* __restrict__ mix) {
    __shared__ float red[8];
    const int t = blockIdx.x, c = threadIdx.x, s = t % SEQ;
    const bf16* p = proj + (size_t)t * INW;
    float cu0 = bf2f(p[CONVW + c]) * bf2f(p[2 * CONVW + c]), cu1 = 0.f, cu2 = 0.f;
    if (s >= 1) cu1 = bf2f(p[CONVW + c - INW]) * bf2f(p[2 * CONVW + c - INW]);
    if (s >= 2) cu2 = bf2f(p[CONVW + c - 2 * INW]) * bf2f(p[2 * CONVW + c - 2 * INW]);
    const float y = bf2f(p[c]) * (cw[2 * CONVW + c] * cu0 + cw[CONVW + c] * cu1 + cw[c] * cu2);
    float ss = wave_sum(y * y);
    if ((c & 63) == 0) red[c >> 6] = ss;
    __syncthreads();
    ss = 0.f;
#pragma unroll
    for (int i = 0; i < 8; ++i) ss += red[i];
    const float rstd = 1.0f / sqrtf(ss * (1.0f / CONVW) + EPS);
    mix[(size_t)t * D + c] = (bf16)f2bf(y * rstd * g[c]);
}
__global__ void __launch_bounds__(512) k_attn(const bf16* __restrict__ proj, const float* __restrict__ qg, const float* __restrict__ kg, const float* __restrict__ sinks,
                                              const float* __restrict__ rel_bias, const float* __restrict__ g, bf16* __restrict__ mix) {
    __shared__ float qs[8][64];
    __shared__ float ps[8][128];
    __shared__ float red[8];
    const int t = blockIdx.x, h = threadIdx.x >> 6, lane = threadIdx.x & 63, s = t % SEQ, kv = h / QPKV;
    const bf16* p = proj + (size_t)t * INW;
    {
        const float q = bf2f(p[3 * CONVW + h * HD + lane]);
        const float ss = wave_sum(q * q);
        qs[h][lane] = q * (1.0f / sqrtf(ss * (1.0f / HD) + EPS)) * qg[lane] * 0.125f;
    }
    __syncthreads();
    float lg[2];
#pragma unroll
    for (int i = 0; i < 2; ++i) {
        const int rel = lane + 64 * i;
        lg[i] = -INFINITY;
        if (rel <= s) {
            const bf16* kr = p - (size_t)rel * INW + 3 * CONVW + ATTNW + kv * HD;
            float ss = 0.f, dot = 0.f;
            for (int d = 0; d < HD; ++d) { const float k = bf2f(kr[d]); ss += k * k; dot += k * kg[d] * qs[h][d]; }
            lg[i] = dot * (1.0f / sqrtf(ss * (1.0f / HD) + EPS)) + rel_bias[T5B[rel] * NQH + h];
        }
    }
    const float sk = sinks[h];
    float m = fmaxf(fmaxf(lg[0], lg[1]), sk);
#pragma unroll
    for (int o = 1; o < 64; o <<= 1) m = fmaxf(m, __shfl_xor(m, o));
    const float p0 = (lg[0] == -INFINITY) ? 0.f : expf(lg[0] - m), p1 = (lg[1] == -INFINITY) ? 0.f : expf(lg[1] - m);
    const float den = wave_sum(p0 + p1) + expf(sk - m);
    ps[h][lane] = p0 / den; ps[h][lane + 64] = p1 / den;
    __syncthreads();
    float o = 0.f;
    const int nk = s < 127 ? s + 1 : 128;
    for (int rel = 0; rel < nk; ++rel) o += ps[h][rel] * bf2f(p[-(ptrdiff_t)rel * INW + 3 * CONVW + ATTNW + KVW + kv * HD + lane]);
    float ss = wave_sum(o * o);
    if (lane == 0) red[h] = ss;
    __syncthreads();
    ss = 0.f;
#pragma unroll
    for (int i = 0; i < 8; ++i) ss += red[i];
    const float rstd = 1.0f / sqrtf(ss * (1.0f / ATTNW) + EPS);
    mix[(size_t)t * D + CONVW + h * HD + lane] = (bf16)f2bf(o * rstd * g[h * HD + lane]);
}
__global__ void __launch_bounds__(256) k_router(const bf16* __restrict__ x1b, const float* __restrict__ g, const float* __restrict__ wr, const float* __restrict__ br,
                                                float* __restrict__ rstd_o, float* __restrict__ gate_tk, unsigned* __restrict__ dest, float* __restrict__ rsl, unsigned* cnt) {
    const int t = blockIdx.x * 4 + (threadIdx.x >> 6), lane = threadIdx.x & 63;
    float h[16]; float ss = 0.f;
#pragma unroll
    for (int j = 0; j < 16; ++j) { const float v = bf2f(x1b[(size_t)t * D + lane + 64 * j]); ss += v * v; h[j] = v * g[lane + 64 * j]; }
    ss = wave_sum(ss);
    const float rstd = 1.0f / sqrtf(ss * (1.0f / D) + EPS);
    float lg[NEXP];
    for (int e = 0; e < NEXP; ++e) {
        float a = 0.f;
#pragma unroll
        for (int j = 0; j < 16; ++j) a += h[j] * wr[(size_t)(lane + 64 * j) * NEXP + e];
        lg[e] = wave_sum(a) * rstd + br[e];
    }
    if (lane == 0) {
        rstd_o[t] = rstd;
        int idx[4]; float val[4];
        unsigned used = 0u;
        for (int k = 0; k < 4; ++k) { int bi = -1; float bv = -INFINITY; for (int e = 0; e < NEXP; ++e) if (!((used >> e) & 1u) && lg[e] > bv) { bv = lg[e]; bi = e; } idx[k] = bi; val[k] = bv; used |= 1u << bi; }
        float den = 0.f, pe[4];
        for (int k = 0; k < 4; ++k) { pe[k] = expf(val[k] - val[0]); den += pe[k]; }
        for (int k = 0; k < 4; ++k) {
            gate_tk[t * 4 + k] = pe[k] / den;
            const unsigned pos = atomicAdd(&cnt[idx[k]], 1u);
            dest[(size_t)idx[k] * T + pos] = (unsigned)(t * 4 + k); rsl[(size_t)idx[k] * T + pos] = rstd;
        }
    }
}
__global__ void __launch_bounds__(256) k_combine(const bf16* __restrict__ x1b, const bf16* __restrict__ ys, const float* __restrict__ gate_tk, float* __restrict__ out) {
    const size_t i = (size_t)blockIdx.x * 256 + threadIdx.x; const int t = (int)(i / D), c = (int)(i % D);
    float v = bf2f(x1b[i]);
#pragma unroll
    for (int k = 0; k < 4; ++k) v += gate_tk[t * 4 + k] * bf2f(ys[((size_t)t * 4 + k) * D + c]);
    out[i] = v;
}
}
#ifndef STAG_XCD
#define STAG_XCD 0
#endif
namespace pg8 {
#define PG8_LAS __attribute__((address_space(3)))
constexpr int BM = 256, BK = 64, HALF = 128, HTB = HALF * BK * 2  , STAGE_BYTES = 8 * HTB, NXCD = 8, WGM = 8;

__host__ __device__ __forceinline__ int lds_byte(int r, int c) { const int st = (r >> 4) * 2 + (c >> 5), rr = r & 15, cc = c & 31, ob = rr * 64 + cc * 2; return st * 1024 + (ob ^ (((ob >> 9) & 1) << 5)); }
__host__ __device__ __forceinline__ void stage_rc(int b, int& R, int& C) { const int st = b / 1024, sb = b % 1024, swz = sb ^ (((sb >> 9) & 1) << 5); R = (st >> 1) * 16 + swz / 64; C = (st & 1) * 32 + (swz % 64) / 2; }
__host__ __device__ __forceinline__ int perm32(int rho) { const int n = rho >> 4, i = rho & 15; return 8 * (i >> 2) + 4 * n + (i & 3); }

__device__ __forceinline__ void glds16s(const void* sbase, unsigned voff, unsigned lds_dst) {
    asm volatile("s_mov_b32 m0, %2\n\ts_nop 0\n\tglobal_load_lds_dwordx4 %0, %1" :: "v"(voff), "s"(sbase), "s"(lds_dst) : "memory", "m0"); }
#ifndef GLDS_PAIR
#define GLDS_PAIR 1
#endif
__device__ __forceinline__ void glds16s2(const void* sbase, unsigned v0, unsigned v1, unsigned lds_dst) {
    asm volatile("s_mov_b32 m0, %3\n\ts_nop 0\n\tglobal_load_lds_dwordx4 %0, %2\n\tglobal_load_lds_dwordx4 %1, %2 offset:1024" :: "v"(v0), "v"(v1), "s"(sbase), "s"(lds_dst) : "memory", "m0"); }
__host__ __device__ __forceinline__ int piece_pos(int tid, int i) { return GLDS_PAIR ? ((tid >> 6) * 2048 + i * 1024 + (tid & 63) * 16) : (tid * 16 + i * 8192); }
__host__ __device__ __forceinline__ unsigned piece_bias(int i) { return (GLDS_PAIR && i == 0) ? 1024u : 0u; }
__device__ __forceinline__ void glds4s(const void* sbase, unsigned voff, unsigned lds_dst) {
    asm volatile("s_mov_b32 m0, %2\n\ts_nop 4\n\tglobal_load_lds_dword %0, %1" :: "v"(voff), "s"(sbase), "s"(lds_dst) : "memory", "m0"); }
__device__ __forceinline__ const void* uniform_ptr(const void* p) { const unsigned long long v = (unsigned long long)p; const unsigned lo = __builtin_amdgcn_readfirstlane((unsigned)v), hi = __builtin_amdgcn_readfirstlane((unsigned)(v >> 32)); return (const void*)(((unsigned long long)hi << 32) | lo); }
struct Unit { const char* A; const char* B; int pm, pn, e, pos0, nrows; };

__device__ __forceinline__ void tile_of(int L, int nM, int nN, int& pm, int& pn) {
    const int nwg = nM * nN; int wgid = L; { const int q = nwg / NXCD, r = nwg % NXCD, xcd = wgid % NXCD, off = wgid / NXCD; wgid = (xcd < r ? xcd * (q + 1) : r * (q + 1) + (xcd - r) * q) + off; }
    const int nig = WGM * nN, gid = wgid / nig, fm = gid * WGM, gsz = (nM - fm) < WGM ? (nM - fm) : WGM;
    int rr = wgid % nig;
    if (gsz == WGM) { pm = fm + (rr & (WGM - 1)); pn = rr >> 3; }
    else { int q = 0; while (rr >= gsz) { rr -= gsz; ++q; } pm = fm + rr; pn = q; }
    static_assert(WGM == 8, "tile_of");
}
struct DenseOrder {
    const char* A; const char* Bt; int nM, nN, G, c; size_t tstep; const float* bias; PG8_LAS unsigned char* tab; const float* rowvec; const float* colvec; const float* rowvec2; int cu_mode;
    __device__ __forceinline__ void init(const void* A_, const void* Bt_, int M, int N, int K, int G_, int c_) { A = (const char*)A_; Bt = (const char*)Bt_; nM = M / BM; nN = N / BM; G = G_; c = c_; tstep = (size_t)BM * K * 2; rowvec = nullptr; colvec = nullptr; rowvec2 = nullptr; cu_mode = 0; }
    __device__ __forceinline__ bool next(int i, Unit& u) const {
        const int L = i * G + c; if (L >= nM * nN) return false;
        tile_of(L, nM, nN, u.pm, u.pn); u.A = A + (size_t)u.pm * tstep; u.B = Bt + (size_t)u.pn * tstep; u.e = 0; u.pos0 = 0; u.nrows = 256; return true;
    }
    __device__ __forceinline__ void prefetch(const Unit& u, int par, int wid, int lane) const {
        if (wid < 4) { const unsigned l0 = __builtin_amdgcn_readfirstlane((unsigned)(size_t)tab + par * 1024 + wid * 256);
            unsigned tl = threadIdx.x; asm volatile("" : "+v"(tl)); tl = (tl & 63u) * 4u;
            const float* bp = (cu_mode && u.pn >= 2 && u.pn < 6) ? bias + ((wid >> 1) ? 1024 : 512) + 128 * (u.pn - 2) + 64 * (wid & 1) : bias + u.pn * 256 + 64 * wid;
            glds4s(uniform_ptr(bp), tl, l0 + 6144u);
            if (rowvec) glds4s(uniform_ptr(rowvec + u.pm * 256 + 64 * wid), tl, l0 + 3072u);
            if (colvec) glds4s(uniform_ptr(colvec + u.pn * 256 + 64 * wid), tl, l0);
            if (rowvec2) glds4s(uniform_ptr(rowvec2 + u.pm * 256 + 64 * wid), tl, l0 + 9216u); }
    }
};

typedef __bf16 bf16pair __attribute__((ext_vector_type(2)));
__device__ __forceinline__ unsigned cvt_pk_bf16(float lo, float hi) { bf16pair v; v.x = (__bf16)lo; v.y = (__bf16)hi; return __builtin_bit_cast(unsigned, v); }

typedef f32x4 Acc[2][2][4][2];

template <class Epi, class Sched, bool GATHER, bool ALIGN_EPI, bool FP8 = false, bool PREF = false, int KREP = 1, int EREP = 1, int NS = 0, int MIDK = 0>
__device__ __forceinline__ void gemm_phase(PG8_LAS unsigned char* lds, const int K, const Sched& S, const Epi& E, const int stagger_ticks = 0) {
    const int tid = threadIdx.x, wid = __builtin_amdgcn_readfirstlane(tid >> 6), lane = tid & 63, wr = wid >> 2, wc = wid & 3, fr = lane & 15, fq = lane >> 4;
    const int nt = K / BK;
    unsigned voffA[2][2], voffB[2];
    const size_t kstep = (size_t)(BK * 2);
    const size_t hstep = (size_t)HALF * K * 2;
#pragma unroll
    for (int i = 0; i < 2; ++i) { int R, C; stage_rc(piece_pos(tid, i), R, C); const int Rb = (R & ~31) + perm32(R & 31);
        voffB[i] = (unsigned)(Rb * K + C) * 2u + piece_bias(i);
        if (!GATHER) { voffA[0][i] = (unsigned)(R * K + C) * 2u + piece_bias(i); voffA[1][i] = voffA[0][i] + (unsigned)hstep; } }
    const unsigned ldsb = __builtin_amdgcn_readfirstlane((unsigned)(size_t)lds + (unsigned)wid * (GLDS_PAIR ? 2048u : 1024u));
    const int aoff = lds_byte(wr * 64 + fr, fq * 8), boff = lds_byte(wc * 32 + fr, fq * 8);
#define PG8_SA(b, h) (((b) * 2 + (h)) * HTB)
#define PG8_SB(b, h) ((4 + (b) * 2 + (h)) * HTB)
#define PG8_STAGE(bufoff, gbase, v0, v1) do { const void* _g = uniform_ptr(gbase); if (GLDS_PAIR) glds16s2(_g, (v0), (v1), ldsb + (bufoff)); else { glds16s(_g, (v0), ldsb + (bufoff)); glds16s(_g, (v1), ldsb + (bufoff) + 8192); } } while (0)
#define PG8_STAGE_B(bufoff, gbase) PG8_STAGE(bufoff, gbase, voffB[0], voffB[1])
#define PG8_STAGE_A(bufoff, gbase, h) PG8_STAGE(bufoff, gbase, voffA[h][0], voffA[h][1])
#define PG8_LDA(dst, b, h) do { _Pragma("unroll") for (int m = 0; m < 4; ++m) _Pragma("unroll") for (int k = 0; k < 2; ++k) dst[m][k] = *(const PG8_LAS bf16x8*)(lds + PG8_SA(b, h) + aoff + m * 2048 + k * 1024); } while (0)
#define PG8_LDB(dst, b, h) do { _Pragma("unroll") for (int n = 0; n < 2; ++n) _Pragma("unroll") for (int k = 0; k < 2; ++k) dst[n][k] = *(const PG8_LAS bf16x8*)(lds + PG8_SB(b, h) + boff + n * 2048 + k * 1024); } while (0)
#define PG8_MMA_BODY(ai, bj, At, Bt) do { \
        if constexpr (FP8) { i32x8 _b[2]; _Pragma("unroll") for (int n = 0; n < 2; ++n) _b[n] = __builtin_shufflevector(__builtin_bit_cast(i32x4, Bt[n][0]), __builtin_bit_cast(i32x4, Bt[n][1]), 0, 1, 2, 3, 4, 5, 6, 7); \
            _Pragma("unroll") for (int m = 0; m < 4; ++m) { const i32x8 _a = __builtin_shufflevector(__builtin_bit_cast(i32x4, At[m][0]), __builtin_bit_cast(i32x4, At[m][1]), 0, 1, 2, 3, 4, 5, 6, 7); \
                _Pragma("unroll") for (int n = 0; n < 2; ++n) acc[ai][bj][m][n] = __builtin_amdgcn_mfma_scale_f32_16x16x128_f8f6f4(_b[n], _a, acc[ai][bj][m][n], 0, 0, 0, 0x7f7f7f7f, 0, 0x7f7f7f7f); } } \
        else { _Pragma("unroll") for (int m = 0; m < 4; ++m) _Pragma("unroll") for (int n = 0; n < 2; ++n) _Pragma("unroll") for (int k = 0; k < 2; ++k) \
            acc[ai][bj][m][n] = __builtin_amdgcn_mfma_f32_16x16x32_bf16(Bt[n][k], At[m][k], acc[ai][bj][m][n], 0, 0, 0); } \
        } while (0)
#define PG8_MMA2(ai, At, Ba, Bb) do { __builtin_amdgcn_s_setprio(1); PG8_MMA_BODY(ai, 0, At, Ba); PG8_MMA_BODY(ai, 1, At, Bb); __builtin_amdgcn_s_setprio(0); } while (0)
#define PG8_WAIT_V(n) asm volatile("s_waitcnt vmcnt(" #n ")" ::: "memory")
#define PG8_WAIT_VR do { if (NS > 0 && relax) asm volatile("s_waitcnt vmcnt(%0)" :: "n"(8 + NS) : "memory"); else PG8_WAIT_V(8); } while (0)
#define PG8_WAIT_L(n) asm volatile("s_waitcnt lgkmcnt(" #n ")" ::: "memory")
#define PG8_BAR __builtin_amdgcn_s_barrier()
#define PG8_SCHED __builtin_amdgcn_sched_barrier(0)
    Unit cur, nxt; int ui = 0, par = 0;
    if (!S.next(0, cur)) return;
    if (stagger_ticks > 0) {
        const unsigned long long t0 = __builtin_amdgcn_s_memrealtime(), dl = (unsigned long long)((STAG_XCD ? (blockIdx.x & 7) : ((blockIdx.x >> 3) & 7)) * stagger_ticks);
        while (__builtin_amdgcn_s_memrealtime() - t0 < dl) __builtin_amdgcn_s_sleep(16);
    }
    Acc acc;
#pragma unroll
    for (int a = 0; a < 2; ++a)
#pragma unroll
        for (int b = 0; b < 2; ++b)
#pragma unroll
            for (int m = 0; m < 4; ++m)
#pragma unroll
                for (int n = 0; n < 2; ++n) acc[a][b][m][n] = (f32x4){0.f, 0.f, 0.f, 0.f};
    bf16x8 At[4][2], B0[2][2], B1[2][2];
    const char* cA = (const char*)uniform_ptr(cur.A) - (GLDS_PAIR ? 1024 : 0); const char* cB = (const char*)uniform_ptr(cur.B) - (GLDS_PAIR ? 1024 : 0);
    if constexpr (PREF) { S.prefetch(cur, 0, wid, lane); PG8_WAIT_V(0); PG8_BAR; }
    if constexpr (GATHER) S.rows(cur, voffA, 0);
    PG8_STAGE_B(PG8_SB(0, 0), cB); PG8_STAGE_B(PG8_SB(0, 1), cB + hstep); PG8_STAGE_A(PG8_SA(0, 0), cA, 0); PG8_STAGE_A(PG8_SA(0, 1), cA, 1);
    if (wr == 1) PG8_BAR;
    PG8_WAIT_V(2); PG8_BAR;
    PG8_STAGE_B(PG8_SB(1, 0), cB + kstep); PG8_STAGE_A(PG8_SA(1, 0), cA + kstep, 0); PG8_STAGE_B(PG8_SB(1, 1), cB + hstep + kstep);
    PG8_WAIT_V(6); PG8_BAR;
    for (;;) {
        const bool has_next = S.next(ui + 1, nxt);
        const char* nA = has_next ? (const char*)uniform_ptr(nxt.A) - (GLDS_PAIR ? 1024 : 0) : cA; const char* nB = has_next ? (const char*)uniform_ptr(nxt.B) - (GLDS_PAIR ? 1024 : 0) : cB;
        if constexpr (PREF) { if (has_next) S.prefetch(nxt, par == 2 ? 0 : par + 1, wid, lane); }
#pragma unroll 1
        for (int tt = 0; tt < KREP * nt; tt += 2) {
            const bool last = (tt == KREP * nt - 2), relax = (ui > 0 && tt == 0); const int t = (KREP == 1) ? tt : (tt % nt), t2 = (KREP == 1) ? tt + 2 : ((tt + 2) % nt);
            if constexpr (MIDK > 0) { if (tt == MIDK) { const PG8_LAS float* r2 = (const PG8_LAS float*)(S.tab + 9216 + par * 1024) + wr * 64 + fr;
#pragma unroll
                for (int a = 0; a < 2; ++a)
#pragma unroll
                    for (int m = 0; m < 4; ++m) { const float sc = r2[a * 128 + m * 16];
#pragma unroll
                        for (int b = 0; b < 2; ++b)
#pragma unroll
                            for (int n = 0; n < 2; ++n) acc[a][b][m][n] *= sc; } } }
            const char* a1 = cA + (size_t)(t + 1) * kstep;
            const char* a2 = last ? nA : cA + (size_t)t2 * kstep; const char* b2 = last ? nB : cB + (size_t)t2 * kstep;
            const char* a3 = a2 + kstep; const char* b3 = b2 + kstep;
            PG8_LDB(B0, 0, 0); PG8_LDB(B1, 0, 1); PG8_SCHED; PG8_LDA(At, 0, 0); PG8_STAGE_A(PG8_SA(1, 1), a1, 1);
            if constexpr (GATHER) { if (last && has_next) S.rows(nxt, voffA, par == 2 ? 0 : par + 1); }
            PG8_WAIT_VR; PG8_WAIT_L(0); PG8_BAR; PG8_MMA2(0, At, B0, B1); PG8_BAR; PG8_SCHED;
            PG8_LDA(At, 0, 1); PG8_STAGE_B(PG8_SB(0, 0), b2); PG8_STAGE_B(PG8_SB(0, 1), b2 + hstep); PG8_STAGE_A(PG8_SA(0, 0), a2, 0);
            PG8_WAIT_VR; PG8_WAIT_L(0); PG8_BAR; PG8_MMA2(1, At, B0, B1); PG8_BAR; PG8_SCHED;
            PG8_LDB(B0, 1, 0); PG8_LDB(B1, 1, 1); PG8_SCHED; PG8_LDA(At, 1, 0); PG8_STAGE_A(PG8_SA(0, 1), a2, 1);
            PG8_WAIT_V(8); PG8_WAIT_L(0); PG8_BAR; PG8_MMA2(0, At, B0, B1); PG8_BAR; PG8_SCHED;
            PG8_LDA(At, 1, 1); PG8_STAGE_B(PG8_SB(1, 0), b3); PG8_STAGE_B(PG8_SB(1, 1), b3 + hstep); PG8_STAGE_A(PG8_SA(1, 0), a3, 0);
            PG8_WAIT_V(8); PG8_WAIT_L(0); PG8_BAR; PG8_MMA2(1, At, B0, B1); PG8_BAR; PG8_SCHED;
        }
        if constexpr (ALIGN_EPI) { if (wr == 0) PG8_BAR; }
        {
            int tz = threadIdx.x; asm volatile("" : "+v"(tz)); const int wz = __builtin_amdgcn_readfirstlane(tz >> 6), lz = tz & 63;
            for (int er = 0; er < EREP; ++er) E(acc, cur, wz >> 2, wz & 3, lz & 15, lz >> 4, par);
        }
        if (!has_next) break;
#pragma unroll
        for (int a = 0; a < 2; ++a)
#pragma unroll
            for (int b = 0; b < 2; ++b)
#pragma unroll
                for (int m = 0; m < 4; ++m)
#pragma unroll
                    for (int n = 0; n < 2; ++n) { f32x2 lo, hi; asm volatile("v_mov_b64 %0, 0\n\tv_mov_b64 %1, 0" : "=v"(lo), "=v"(hi)); acc[a][b][m][n] = (f32x4){lo.x, lo.y, hi.x, hi.y}; }
        cur = nxt; cA = nA; cB = nB; ++ui; par = (par == 2) ? 0 : par + 1;
        if constexpr (ALIGN_EPI) { if (wr == 1) PG8_BAR; }
    }
    PG8_WAIT_V(0);
    if constexpr (!ALIGN_EPI) { if (wr == 0) PG8_BAR; }
    PG8_BAR;
#undef PG8_SA
#undef PG8_SB
#undef PG8_STAGE
#undef PG8_STAGE_A
#undef PG8_STAGE_B
#undef PG8_LDA
#undef PG8_LDB
#undef PG8_MMA_BODY
#undef PG8_MMA2
#undef PG8_WAIT_V
#undef PG8_WAIT_VR
#undef PG8_WAIT_L
#undef PG8_BAR
#undef PG8_SCHED
}
}
constexpr int NWAVES = 8;
constexpr int RING_OFF = 0, RING_BYTES = 131072;
constexpr int MOE_OFF = RING_BYTES;
constexpr int LDSCTL_OFF = MOE_OFF + 512, MISC_OFF = LDSCTL_OFF + 320;
constexpr int TAB_OFF = 133120;
constexpr int TINFO_OFF = 150528;
constexpr int LDS_BYTES = 163840;
static_assert(MISC_OFF + 128 <= LDS_BYTES, "LDS map");

#define GAS __attribute__((address_space(1)))
#define LAS __attribute__((address_space(3)))
typedef GAS unsigned gu32;
#define RLX_AGENT __ATOMIC_RELAXED, __HIP_MEMORY_SCOPE_AGENT
#define LDS_WAIT() asm volatile("s_waitcnt lgkmcnt(0)" ::: "memory")
#define VM_WAIT() asm volatile("s_waitcnt vmcnt(0)" ::: "memory")

#define XB_TMO      128
#define XB_XCNT(j)  (256  + 64 * (j))
#define XB_XSUB(j)  (1280 + 64 * (j))
#define XB_XGEN(j)  (2304 + 64 * (j))
#define XB_TOP      3328
#define XB_TOPGEN   3392
#define XCD_BAR_WORDS 3456
#define XB_SPIN_CAP (1u << 18)
__device__ __forceinline__ unsigned xb_ld(unsigned* p)              { return __hip_atomic_load(p, __ATOMIC_RELAXED, __HIP_MEMORY_SCOPE_AGENT); }
__device__ __forceinline__ unsigned xb_add(unsigned* p, unsigned v) { return __hip_atomic_fetch_add(p, v, __ATOMIC_RELAXED, __HIP_MEMORY_SCOPE_AGENT); }
__device__ __forceinline__ unsigned xb_xcc_id() { return (unsigned)__builtin_amdgcn_s_getreg((3 << 11) | 20) & 0xFu; }
#define XB_SPIN(cond, bar) do { unsigned _sp = 0; while (cond) { __builtin_amdgcn_s_sleep(1); \
    if ((++_sp & 255u) == 0u) { if (xb_ld(&(bar)[XB_TMO])) break; if (_sp > XB_SPIN_CAP) { atomicAdd(&(bar)[XB_TMO], 1u); break; } } } } while (0)
struct XcdBarrier { unsigned* bar; unsigned x; volatile LAS unsigned* st; };
__device__ __forceinline__ XcdBarrier xcd_barrier_post(unsigned* bar, volatile LAS unsigned* st) {
    XcdBarrier b; b.bar = bar; b.x = xb_xcc_id(); b.st = st;
    if (threadIdx.x == 0) (void)xb_add(&bar[XB_XCNT(b.x)], 1u);
    return b;
}
__device__ __forceinline__ void xcd_barrier_complete(unsigned* bar, unsigned x, unsigned& nloc, unsigned& nx) {
    const unsigned G = gridDim.x * gridDim.y * gridDim.z;
    unsigned sum, cnt, mine, sp = 0u;
    for (;;) {
        sum = 0u; cnt = 0u; mine = 0u;
#pragma unroll
        for (unsigned j = 0; j < 16; ++j) { const unsigned c = xb_ld(&bar[XB_XCNT(j)]); sum += c; cnt += (c > 0u) ? 1u : 0u; mine = (j == x) ? c : mine; }
        if (sum == G) break;
        __builtin_amdgcn_s_sleep(1);
        if ((++sp & 255u) == 0u) { if (xb_ld(&bar[XB_TMO])) break; if (sp > XB_SPIN_CAP) { atomicAdd(&bar[XB_TMO], 1u); break; } }
    }
    nloc = mine > 0u ? mine : 1u; nx = cnt > 0u ? cnt : 1u;
}
__device__ __forceinline__ void xcd_barrier(const XcdBarrier& b) {
    asm volatile("s_waitcnt vmcnt(0)" ::: "memory");
    __syncthreads();
    if (threadIdx.x == 0) {
        unsigned* bar = b.bar;
        __builtin_amdgcn_s_waitcnt(0);
        unsigned nloc = b.st[0], nx = b.st[1];
        if (nloc == 0u) { xcd_barrier_complete(bar, b.x, nloc, nx); b.st[0] = nloc; b.st[1] = nx; }
        const unsigned old = xb_add(&bar[XB_XSUB(b.x)], 1u);
        const unsigned gen = old / nloc;
        if (old + 1u == (gen + 1u) * nloc) {
            __builtin_amdgcn_fence(__ATOMIC_RELEASE, "agent");
            asm volatile("s_waitcnt vmcnt(0)" ::: "memory");
            const unsigned og = xb_add(&bar[XB_TOP], 1u);
            const unsigned tg = og / nx;
            if (og + 1u == (tg + 1u) * nx) xb_add(&bar[XB_TOPGEN], 1u);
            else XB_SPIN(xb_ld(&bar[XB_TOPGEN]) == tg, bar);
            __builtin_amdgcn_fence(__ATOMIC_ACQUIRE, "agent");
            xb_add(&bar[XB_XGEN(b.x)], 1u);
            asm volatile("s_waitcnt vmcnt(0)" ::: "memory");
        } else {
            XB_SPIN(xb_ld(&bar[XB_XGEN(b.x)]) == gen, bar);
            __builtin_amdgcn_fence(__ATOMIC_ACQUIRE, "agent");
            asm volatile("s_waitcnt vmcnt(0)" ::: "memory");
        }
    }
    __syncthreads();
}

struct Frame {
    LAS unsigned char* lds;
    volatile LAS unsigned* MISC;
    gu32* ctl;
    int tid, lane, wave;
    int vcu, G;
    const float *x, *norm_mix, *w_in, *b_in, *conv_w, *q_norm, *k_norm, *sinks, *rel_bias, *on_conv, *on_attn, *w_out, *b_out, *norm_ffn, *w_router, *b_router, *w1, *b1, *w2, *b2;
    float* out;
    bf16 *WinT, *WoutT, *WR; unsigned char *W1Q, *W2Q, *x1q, *act;
    float *B1S, *rstd, *gate, *rsl, *rin, *ginv, *rsa;
    unsigned* dest;
    bf16 *xn, *proj, *mix, *x1b; unsigned char* ys;
};

#ifndef P1_KREP
#define P1_KREP 1
#endif
#ifndef P3_FP8
#define P3_FP8 1
#endif
constexpr float MIXA_SCALE = 16.0f;
#ifndef P3_KREP
#define P3_KREP 1
#endif
__device__ __forceinline__ v4u pair16(const v2u a, const v2u b) {
    const auto rx = __builtin_amdgcn_permlane16_swap(a.x, b.x, false, false), ry = __builtin_amdgcn_permlane16_swap(a.y, b.y, false, false);
    return (v4u){rx[0], ry[0], rx[1], ry[1]};
}
struct EpiIn {
    bf16* O; const LAS unsigned char* tab;
    __device__ __forceinline__ void operator()(const pg8::Acc& acc, const pg8::Unit& u, int wr, int wc, int fr, int fq, int par) const {
        const int row0 = u.pm * 256 + wr * 64 + fr;
        const LAS float* bt = (const LAS float*)(tab + 6144 + par * 1024) + wc * 32 + 8 * fq;
        f32x4 bv[2][2];
#pragma unroll
        for (int bj = 0; bj < 2; ++bj)
#pragma unroll
            for (int n = 0; n < 2; ++n) bv[bj][n] = *(const LAS f32x4*)(bt + bj * 128 + 4 * n);
        if (u.pn >= 2 && u.pn < 6) {
            const int col0 = P_CU + 128 * (u.pn - 2) + wc * 32 + 8 * fq;
#pragma unroll
            for (int ai = 0; ai < 2; ++ai)
#pragma unroll
                for (int m = 0; m < 4; ++m) { unsigned char* const rowp = (unsigned char*)O + (unsigned)(((row0 + ai * 128 + m * 16) * PW + col0) * 2);
                    const f32x4 v0 = (acc[ai][0][m][0] * (1.0f / P1_KREP) + bv[0][0]) * (acc[ai][1][m][0] * (1.0f / P1_KREP) + bv[1][0]), v1 = (acc[ai][0][m][1] * (1.0f / P1_KREP) + bv[0][1]) * (acc[ai][1][m][1] * (1.0f / P1_KREP) + bv[1][1]);
                    v4u w; w.x = pg8::cvt_pk_bf16(v0[0], v0[1]); w.y = pg8::cvt_pk_bf16(v0[2], v0[3]); w.z = pg8::cvt_pk_bf16(v1[0], v1[1]); w.w = pg8::cvt_pk_bf16(v1[2], v1[3]);
                    *(v4u*)rowp = w; }
        } else {
            const int col0 = (u.pn < 2 ? 256 * u.pn : P_Q + 256 * (u.pn - 6)) + wc * 32 + 8 * fq;
#pragma unroll
            for (int ai = 0; ai < 2; ++ai)
#pragma unroll
                for (int m = 0; m < 4; ++m) { unsigned char* const rowp = (unsigned char*)O + (unsigned)(((row0 + ai * 128 + m * 16) * PW + col0) * 2);
#pragma unroll
                    for (int bj = 0; bj < 2; ++bj) { const f32x4 v0 = acc[ai][bj][m][0] * (1.0f / P1_KREP) + bv[bj][0], v1 = acc[ai][bj][m][1] * (1.0f / P1_KREP) + bv[bj][1];
                        v4u w; w.x = pg8::cvt_pk_bf16(v0[0], v0[1]); w.y = pg8::cvt_pk_bf16(v0[2], v0[3]); w.z = pg8::cvt_pk_bf16(v1[0], v1[1]); w.w = pg8::cvt_pk_bf16(v1[2], v1[3]);
                        *(v4u*)(rowp + bj * 256) = w; } }
        }
    }
};
constexpr float P3_ASC = P3_FP8 ? 1.0f / (P3_KREP * W_SCALE) : 1.0f / P3_KREP;
struct EpiOut {
    bf16* O; const LAS unsigned char* tab; const bf16* xn; unsigned char* Q;
    __device__ __forceinline__ void operator()(const pg8::Acc& acc, const pg8::Unit& u, int wr, int wc, int fr, int fq, int par) const {
        const int row0 = u.pm * 256 + wr * 64 + fr, col0 = u.pn * 256 + wc * 32 + 8 * fq;
        const LAS float* bt = (const LAS float*)(tab + 6144 + par * 1024) + wc * 32 + 8 * fq;
        const LAS float* gt = (const LAS float*)(tab + par * 1024) + wc * 32 + 8 * fq;
        const LAS float* rt = (const LAS float*)(tab + 3072 + par * 1024) + wr * 64 + fr;
        f32x4 bv[2][2], gi[2][2];
#pragma unroll
        for (int bj = 0; bj < 2; ++bj)
#pragma unroll
            for (int n = 0; n < 2; ++n) { bv[bj][n] = *(const LAS f32x4*)(bt + bj * 128 + 4 * n); gi[bj][n] = *(const LAS f32x4*)(gt + bj * 128 + 4 * n); }
        const bool odd = fq & 1;
        float rsc[2][4];
#pragma unroll
        for (int ai = 0; ai < 2; ++ai)
#pragma unroll
            for (int m = 0; m < 4; ++m) rsc[ai][m] = rt[ai * 128 + m * 16];
#pragma unroll
        for (int ai = 0; ai < 2; ++ai) {
            v4u xw[4][2];
#pragma unroll
            for (int m = 0; m < 4; ++m)
#pragma unroll
                for (int bj = 0; bj < 2; ++bj) xw[m][bj] = *(const v4u*)((const unsigned char*)xn + (unsigned)(((row0 + ai * 128 + m * 16) * D + col0 + bj * 128) * 2));
#pragma unroll
            for (int m = 0; m < 4; ++m) { const unsigned off = (unsigned)((row0 + ai * 128 + m * 16) * D + col0); v2u qq[2];
                const float ri = rsc[ai][m];
#pragma unroll
                for (int bj = 0; bj < 2; ++bj) { const v4u xv = xw[m][bj];
                    const f32x4 x0 = (f32x4){bflo(xv.x), bfhi(xv.x), bflo(xv.y), bfhi(xv.y)} * ri * gi[bj][0], x1 = (f32x4){bflo(xv.z), bfhi(xv.z), bflo(xv.w), bfhi(xv.w)} * ri * gi[bj][1];
                    const f32x4 v0 = acc[ai][bj][m][0] * P3_ASC + bv[bj][0] + x0, v1 = acc[ai][bj][m][1] * P3_ASC + bv[bj][1] + x1;
                    v4u w; w.x = pg8::cvt_pk_bf16(v0[0], v0[1]); w.y = pg8::cvt_pk_bf16(v0[2], v0[3]); w.z = pg8::cvt_pk_bf16(v1[0], v1[1]); w.w = pg8::cvt_pk_bf16(v1[2], v1[3]);
                    *(v4u*)((unsigned char*)O + (off + bj * 128) * 2u) = w;
                    qq[bj].x = pk4_fp8(v0[0], v0[1], v0[2], v0[3]); qq[bj].y = pk4_fp8(v1[0], v1[1], v1[2], v1[3]); }
                {
                    const v4u w16 = pair16(qq[0], qq[1]);
                    *(v4u*)(Q + (off + (odd ? 128u - 8u : 0u))) = w16; } }
            asm volatile("" ::: "memory");
        }
    }
};
template <bool GATHER> struct MoeOrder {
    const char* Abase; const char* Bt; size_t bstride_e, tstepB;
    int nN, G, c, NT; const LAS int* tile0; const LAS int* ecnt; const unsigned* dest;
    __device__ __forceinline__ bool next(int i, pg8::Unit& u) const {
        const int L = i * G + c; if (L >= NT * nN) return false;
        pg8::tile_of(L, NT, nN, u.pm, u.pn);
        const unsigned ti = __builtin_amdgcn_readfirstlane(((const LAS unsigned*)((const LAS unsigned char*)tile0 + (TINFO_OFF - MOE_OFF)))[u.pm]);
        const int e = (int)(ti >> 20);
        u.e = e; u.pos0 = (u.pm - (int)((ti >> 9) & 2047u)) * 256; u.nrows = (int)(ti & 511u);
        u.B = Bt + (size_t)e * bstride_e + (size_t)u.pn * tstepB;
        u.A = Abase;
        return true;
    }
    const float* rsl; LAS unsigned char* tab; const float* bias; int bias_mode;
    __device__ __forceinline__ void prefetch(const pg8::Unit& u, int par, int wid, int lane) const {
        if (wid < 4) { const size_t idx = (size_t)u.e * T + u.pos0 + 64 * wid; const unsigned l0 = __builtin_amdgcn_readfirstlane((unsigned)(size_t)tab + par * 1024 + wid * 256);
            pg8::glds4s(pg8::uniform_ptr(dest + idx), (unsigned)lane * 4u, l0); if constexpr (GATHER) pg8::glds4s(pg8::uniform_ptr(rsl + idx), (unsigned)lane * 4u, l0 + 3072u);
            const float* bp = bias_mode == 1 ? bias + (size_t)u.e * 2 * DFF + (wid >> 1) * DFF + u.pn * 128 + 64 * (wid & 1) : bias + (size_t)u.e * D + u.pn * 256 + 64 * wid;
            pg8::glds4s(pg8::uniform_ptr(bp), (unsigned)lane * 4u, l0 + 6144u); }
    }
    __device__ __forceinline__ void rows(const pg8::Unit& u, unsigned (&voff)[2][2], int par) const {
        int tz = threadIdx.x; asm volatile("" : "+v"(tz));
        if constexpr (!GATHER) {
#pragma unroll
            for (int i = 0; i < 2; ++i) { int R, C; pg8::stage_rc(pg8::piece_pos(tz, i), R, C);
#pragma unroll
                for (int h = 0; h < 2; ++h) voff[h][i] = (unsigned)(u.pm * 256 + h * 128 + R) * (unsigned)DFF + (unsigned)(C * 2) + pg8::piece_bias(i); }
            return;
        }
        const int n = u.nrows; const LAS unsigned* dtab = (const LAS unsigned*)(tab + par * 1024);
#pragma unroll
        for (int i = 0; i < 2; ++i) { int R, C; pg8::stage_rc(pg8::piece_pos(tz, i), R, C);
#pragma unroll
            for (int h = 0; h < 2; ++h) { const int r = h * 128 + R; const unsigned dr = dtab[r]; const unsigned tok = r < n ? (dr >> 2) : 0u; voff[h][i] = tok * (unsigned)D + (unsigned)(C * 2) + pg8::piece_bias(i); } }
    }
};
#ifndef P5_KREP
#define P5_KREP 1
#endif
struct EpiW1 {
    unsigned char* act; const LAS unsigned char* tab; const LAS int* ecnt;
    __device__ __forceinline__ void operator()(const pg8::Acc& acc, const pg8::Unit& u, int wr, int wc, int fr, int fq, int par) const {
        const LAS float* rtab = (const LAS float*)(tab + 3072 + par * 1024);
        const int n = u.nrows; const int acol = u.pn * 128 + wc * 32 + 8 * fq;
        unsigned char* const abase = act + (size_t)u.pm * (256 * DFF) + u.pn * 128;
        const unsigned aoffl = (unsigned)(wc * 32 + 8 * fq);
        const LAS float* bg = (const LAS float*)(tab + 6144 + par * 1024) + wc * 32 + 8 * fq; const LAS float* bl = bg + 128;
        const f32x4 bg0 = *(const LAS f32x4*)bg, bg1 = *(const LAS f32x4*)(bg + 4), bl0 = *(const LAS f32x4*)bl, bl1 = *(const LAS f32x4*)(bl + 4);
        float rs[2][4];
#pragma unroll
        for (int ai = 0; ai < 2; ++ai)
#pragma unroll
            for (int m = 0; m < 4; ++m) rs[ai][m] = rtab[ai * 128 + wr * 64 + m * 16 + fr];
        const bool odd = fq & 1;
#pragma unroll
        for (int ai = 0; ai < 2; ++ai)
#pragma unroll
            for (int mp = 0; mp < 2; ++mp) { v2u w[2];
#pragma unroll
                for (int mm = 0; mm < 2; ++mm) { const int m = 2 * mp + mm; const int r = ai * 128 + wr * 64 + m * 16 + fr; const float s0 = rs[ai][m], s = s0 * (1.0f / P5_KREP),        s4 = s0 * (ACT_SCALE * SWI_ICZ * SWI_ICZ / P5_KREP);
                    const f32x4 g0 = acc[ai][0][m][0] * s + bg0, g1 = acc[ai][0][m][1] * s + bg1, l0 = acc[ai][1][m][0] * s4 + bl0, l1 = acc[ai][1][m][1] * s4 + bl1;
                    const f32x2 a0 = swiglu2_z((f32x2){g0[0], g0[1]}, (f32x2){l0[0], l0[1]}), a1 = swiglu2_z((f32x2){g0[2], g0[3]}, (f32x2){l0[2], l0[3]});
                    const f32x2 a2 = swiglu2_z((f32x2){g1[0], g1[1]}, (f32x2){l1[0], l1[1]}), a3 = swiglu2_z((f32x2){g1[2], g1[3]}, (f32x2){l1[2], l1[3]});
                    w[mm].x = pk4_fp8(a0.x, a0.y, a1.x, a1.y); w[mm].y = pk4_fp8(a2.x, a2.y, a3.x, a3.y); }
                const v4u w16 = pair16(w[0], w[1]);
                const int r = ai * 128 + wr * 64 + (2 * mp + (odd ? 1 : 0)) * 16 + fr;
                *(v4u*)(abase + (unsigned)(r * DFF + (int)aoffl - (odd ? 8 : 0))) = w16; }
    }
};
struct EpiW2 {
    unsigned char* ys; const LAS unsigned char* tab; const LAS int* ecnt;
    static constexpr float sc = YS_SCALE / (W_SCALE * ACT_SCALE);
    __device__ __forceinline__ void operator()(const pg8::Acc& acc, const pg8::Unit& u, int wr, int wc, int fr, int fq, int par) const {
        const LAS unsigned* dtab = (const LAS unsigned*)(tab + par * 1024); unsigned char* const dummy = ys - (WS_YS - WS_DUMMY);
        const int n = u.nrows; const int col0 = u.pn * 256 + wc * 32 + 8 * fq;
        f32x4 bv[2][2];
#pragma unroll
        for (int bj = 0; bj < 2; ++bj)
#pragma unroll
            for (int nn = 0; nn < 2; ++nn) bv[bj][nn] = *(const LAS f32x4*)((const LAS float*)(tab + 6144 + par * 1024) + wc * 32 + 8 * fq + bj * 128 + 4 * nn) * YS_SCALE;
        const bool odd = fq & 1;
        unsigned dd[2][4];
#pragma unroll
        for (int ai = 0; ai < 2; ++ai)
#pragma unroll
            for (int m = 0; m < 4; ++m) dd[ai][m] = dtab[ai * 128 + wr * 64 + m * 16 + fr];
#pragma unroll
        for (int ai = 0; ai < 2; ++ai)
#pragma unroll
            for (int m = 0; m < 4; ++m) { const int r = ai * 128 + wr * 64 + m * 16 + fr; const bool ok = r < n;
                const unsigned roff = dd[ai][m] * (unsigned)D + (unsigned)col0;
                v2u w[2];
#pragma unroll
                for (int bj = 0; bj < 2; ++bj) { const f32x4 v0 = acc[ai][bj][m][0] * sc + bv[bj][0], v1 = acc[ai][bj][m][1] * sc + bv[bj][1];
                    w[bj].x = pk4_fp8(v0[0], v0[1], v0[2], v0[3]); w[bj].y = pk4_fp8(v1[0], v1[1], v1[2], v1[3]); }
                const v4u w16 = pair16(w[0], w[1]);
                if (ok) *(v4u*)(ys + (roff + (odd ? 128u - 8u : 0u))) = w16;
            }
    }
};

template <int MAPM>
__device__ __forceinline__ void p0_transpose_item(const float* W, int K, int N, bf16* WT, const float* gain, LAS float* scr, int item, int lane) {
    const int nblk = N / 32, kb = item / nblk, nb = item % nblk, k0 = 64 * kb, n0 = 32 * nb;
    {
        f32x4 wv[8];
#pragma unroll
        for (int i = 0; i < 8; ++i) wv[i] = __builtin_nontemporal_load((const f32x4*)(W + (size_t)(k0 + 8 * i + (lane >> 3)) * N + n0 + 4 * (lane & 7)));
#pragma unroll
        for (int i = 0; i < 8; ++i)
#pragma unroll
            for (int jj = 0; jj < 4; ++jj) scr[(8 * i + (lane >> 3)) * 33 + 4 * (lane & 7) + jj] = wv[i][jj];
    }
    LDS_WAIT(); asm volatile("" ::: "memory");
    const int c = lane & 7;
    float gk[8];
#pragma unroll
    for (int j = 0; j < 8; ++j) gk[j] = (MAPM == 3) ? ((k0 + 8 * c + j) >= CONVW ? gain[k0 + 8 * c + j - CONVW] : 1.0f) : (gain ? gain[k0 + 8 * c + j] : 1.0f);
#pragma unroll
    for (int j = 0; j < 4; ++j) { const int nl = (lane >> 3) + 8 * j; const LAS float* s = scr + (8 * c) * 33 + nl;
        int n = n0 + nl; if (MAPM == 2) { if (n >= 512 && n < 1024) n = 512 + 256 * ((n - 512) >> 7) + ((n - 512) & 127); else if (n >= 1024 && n < 1536) n = 512 + 256 * ((n - 1024) >> 7) + 128 + ((n - 1024) & 127); }
        v4u o; o.x = pg8::cvt_pk_bf16(s[0 * 33] * gk[0], s[1 * 33] * gk[1]); o.y = pg8::cvt_pk_bf16(s[2 * 33] * gk[2], s[3 * 33] * gk[3]); o.z = pg8::cvt_pk_bf16(s[4 * 33] * gk[4], s[5 * 33] * gk[5]); o.w = pg8::cvt_pk_bf16(s[6 * 33] * gk[6], s[7 * 33] * gk[7]);
        *(GAS v4u*)(WT + (size_t)n * K + ((MAPM == 3) ? ((k0 + 8 * c + CONVW) & (K - 1)) : (k0 + 8 * c))) = o; }
    LDS_WAIT(); asm volatile("" ::: "memory");
}
template <int MAPQ>
__device__ __forceinline__ void p0_transpose_item_q(const float* W, int K, int N, unsigned char* WT, const float* gain, LAS float* scr, int item, int lane) {
    const int nblk = N / 32, kb = item / nblk, nb = item % nblk, k0 = 64 * kb, n0 = 32 * nb;
    {
        f32x4 wv[8];
#pragma unroll
        for (int i = 0; i < 8; ++i) wv[i] = __builtin_nontemporal_load((const f32x4*)(W + (size_t)(k0 + 8 * i + (lane >> 3)) * N + n0 + 4 * (lane & 7)));
#pragma unroll
        for (int i = 0; i < 8; ++i)
#pragma unroll
            for (int jj = 0; jj < 4; ++jj) scr[(8 * i + (lane >> 3)) * 33 + 4 * (lane & 7) + jj] = wv[i][jj];
    }
    LDS_WAIT(); asm volatile("" ::: "memory");
    const int c = lane & 3;
    float gk[16];
#pragma unroll
    for (int j = 0; j < 16; ++j) gk[j] = ((MAPQ == 3) ? ((k0 + 16 * c + j) >= CONVW ? gain[k0 + 16 * c + j - CONVW] : 1.0f) : (gain ? gain[k0 + 16 * c + j] : 1.0f)) * W_SCALE;
#pragma unroll
    for (int j = 0; j < 2; ++j) { const int nl = (lane >> 2) + 16 * j; const LAS float* s = scr + (16 * c) * 33 + nl;
        int n = n0 + nl; if (MAPQ == 1) { const int a = n >> 1; n = 256 * (a >> 7) + 128 * (n & 1) + (a & 127); }
        v4u o; o.x = pk4_fp8(s[0 * 33] * gk[0], s[1 * 33] * gk[1], s[2 * 33] * gk[2], s[3 * 33] * gk[3]); o.y = pk4_fp8(s[4 * 33] * gk[4], s[5 * 33] * gk[5], s[6 * 33] * gk[6], s[7 * 33] * gk[7]);
        o.z = pk4_fp8(s[8 * 33] * gk[8], s[9 * 33] * gk[9], s[10 * 33] * gk[10], s[11 * 33] * gk[11]); o.w = pk4_fp8(s[12 * 33] * gk[12], s[13 * 33] * gk[13], s[14 * 33] * gk[14], s[15 * 33] * gk[15]);
        *(GAS v4u*)(WT + (size_t)n * K + ((MAPQ == 3) ? ((k0 + 16 * c + CONVW) & (K - 1)) : (k0 + 16 * c))) = o; }
    LDS_WAIT(); asm volatile("" ::: "memory");
}
__device__ __forceinline__ void p0_prologue(Frame& F) {
    LAS float* scr = (LAS float*)(F.lds + RING_OFF + F.wave * 16384);
    const int gw = F.vcu * NWAVES + F.wave, NGW = F.G * NWAVES;
    constexpr int I_IN = (D / 64) * (INW / 32), I_OUT = (D / 64) * (D / 32), I_1 = (D / 64) * (2 * DFF / 32), I_2 = (DFF / 64) * (D / 32);
    constexpr int NITEMS = I_IN + I_OUT + NEXP * (I_1 + I_2);
    for (int it = gw; it < NITEMS; it += NGW) {
        int r = it;
        if (r < I_IN) { p0_transpose_item<2>(F.w_in, D, INW, F.WinT, nullptr, scr, r, F.lane); continue; } r -= I_IN;
        if (r < I_OUT) { if (P3_FP8) p0_transpose_item_q<3>(F.w_out, D, D, (unsigned char*)F.WoutT, F.on_attn, scr, r, F.lane); else p0_transpose_item<3>(F.w_out, D, D, F.WoutT, F.on_attn, scr, r, F.lane); continue; } r -= I_OUT;
        if (r < NEXP * I_1) { const int e = r / I_1; p0_transpose_item_q<1>(F.w1 + (size_t)e * D * 2 * DFF, D, 2 * DFF, F.W1Q + (size_t)e * 2 * DFF * D, F.norm_ffn, scr, r % I_1, F.lane); continue; } r -= NEXP * I_1;
        { const int e = r / I_2; p0_transpose_item_q<0>(F.w2 + (size_t)e * DFF * D, DFF, D, F.W2Q + (size_t)e * D * DFF, nullptr, scr, r % I_2, F.lane); }
    }
    const int gt = F.vcu * (NWAVES * 64) + F.tid, NGT = F.G * NWAVES * 64;
    for (int i = gt; i < NEXP * D; i += NGT) { const int e = i / D, k = i % D; const float v = F.norm_ffn[k] * F.w_router[(size_t)k * NEXP + e]; const unsigned hi = f2bf(v); const float lo = v - bf2f((bf16)hi);
        F.WR[i] = (bf16)hi; F.WR[NEXP * D + i] = (bf16)f2bf(lo); }
    for (int i = gt; i < D; i += NGT) F.ginv[i] = 1.0f / F.norm_mix[i];
    for (int i = gt; i < NEXP * 2 * DFF; i += NGT) { const int e = i / (2 * DFF), c = i % (2 * DFF); F.B1S[(size_t)e * 2 * DFF + (c & 1) * DFF + (c >> 1)] = (c & 1) ? (F.b1[i] * ACT_SCALE + ACT_SCALE) * SWI_ICZ : F.b1[i] * SWI_CZ; }
    {
        f32x4 gv[4];
#pragma unroll
        for (int j = 0; j < 4; ++j) gv[j] = *((const f32x4*)F.norm_mix + F.lane + 64 * j);
        for (int m = gw; m < T; m += NGW) {
            const GAS f32x4* xr = (const GAS f32x4*)(F.x + (size_t)m * D) + F.lane;
            f32x4 v[4]; float s = 0.f;
#pragma unroll
            for (int j = 0; j < 4; ++j) { v[j] = __builtin_nontemporal_load(xr + 64 * j); s += (v[j].x * v[j].x + v[j].y * v[j].y) + (v[j].z * v[j].z + v[j].w * v[j].w); }
            const float ms = wave_sum(s) * (1.f / D) + EPS; const float rstd = __builtin_amdgcn_rsqf(ms);
            if (F.lane == 0) F.rin[m] = ms * rstd;
            GAS unsigned long long* o8 = (GAS unsigned long long*)(F.xn + (size_t)m * D) + F.lane;
#pragma unroll
            for (int j = 0; j < 4; ++j) o8[64 * j] = (unsigned long long)pg8::cvt_pk_bf16(v[j].x * rstd * gv[j].x, v[j].y * rstd * gv[j].y) | ((unsigned long long)pg8::cvt_pk_bf16(v[j].z * rstd * gv[j].z, v[j].w * rstd * gv[j].w) << 32);
        }
    }
}
__device__ __forceinline__ int moe_tables(Frame& F) {
    LAS int* tile0 = (LAS int*)(F.lds + MOE_OFF); LAS int* ecnt = tile0 + 40;
    if (F.tid < NEXP) ecnt[F.tid] = (int)__hip_atomic_load(F.ctl + CW_CNT + F.tid, RLX_AGENT);
    __syncthreads();
    if (F.tid == 0) { int a = 0; for (int e = 0; e < NEXP; ++e) { tile0[e] = a; a += (ecnt[e] + 255) >> 8; } tile0[NEXP] = a; }
    __syncthreads();
    const int NT = __builtin_amdgcn_readfirstlane(tile0[NEXP]);
    LAS unsigned* tinfo = (LAS unsigned*)(F.lds + TINFO_OFF);
    for (int pm = F.tid; pm < NT; pm += NWAVES * 64) { int e = 0;
#pragma unroll
        for (int st = 16; st >= 1; st >>= 1) if (tile0[e + st] <= pm) e += st;
        const int left = ecnt[e] - (pm - tile0[e]) * 256;
        tinfo[pm] = ((unsigned)e << 20) | ((unsigned)tile0[e] << 9) | (unsigned)(left < 256 ? left : 256); }
    __syncthreads();
    return NT;
}
constexpr float LOG2E = 1.4426950408889634f;
__device__ __forceinline__ void unpack8(const v4u& w, float (&f)[8]) {
    f[0] = bflo(w.x); f[1] = bfhi(w.x); f[2] = bflo(w.y); f[3] = bfhi(w.y); f[4] = bflo(w.z); f[5] = bfhi(w.z); f[6] = bflo(w.w); f[7] = bfhi(w.w);
}
__device__ __forceinline__ v4u pack8(const float (&f)[8]) {
    v4u w; w.x = pg8::cvt_pk_bf16(f[0], f[1]); w.y = pg8::cvt_pk_bf16(f[2], f[3]); w.z = pg8::cvt_pk_bf16(f[4], f[5]); w.w = pg8::cvt_pk_bf16(f[6], f[7]); return w;
}

__device__ __forceinline__ void p2_conv(Frame& F) {
    const int gw = F.vcu * NWAVES + F.wave, NGW = F.G * NWAVES; int c0 = 8 * F.lane; asm volatile("" : "+v"(c0));
    float w0[8], w1[8], w2[8], gg[8];
#pragma unroll
    for (int j = 0; j < 8; ++j) { w0[j] = F.conv_w[c0 + j]; w1[j] = F.conv_w[CONVW + c0 + j]; w2[j] = F.conv_w[2 * CONVW + c0 + j]; gg[j] = F.on_conv[c0 + j]; }
    for (int item = gw; item < T / 16; item += NGW) {
        const int t0 = item * 16, s0 = t0 % SEQ;
        float cu1[8], cu2[8];
#pragma unroll
        for (int j = 0; j < 8; ++j) { cu1[j] = 0.f; cu2[j] = 0.f; }
        if (s0 > 0) {
            const bf16* p = (const bf16*)((const unsigned char*)F.proj + (unsigned)(((t0 - 2) * PW + P_CU + c0) * 2));
            const v4u ca = *(const v4u*)p, cb = *(const v4u*)(p + PW);
            unpack8(ca, cu2); unpack8(cb, cu1);
        }
#pragma unroll 1
        for (int tt = 0; tt < 16; tt += 4) {
            v4u bb[4], cc[4];
#pragma unroll
            for (int q = 0; q < 4; ++q) { const unsigned po = (unsigned)(((t0 + tt + q) * PW + c0) * 2); bb[q] = *(const v4u*)((const unsigned char*)F.proj + po); cc[q] = *(const v4u*)((const unsigned char*)F.proj + (po + P_CU * 2)); }
#pragma unroll
            for (int q = 0; q < 4; ++q) {
                float b[8], c[8], y[8]; unpack8(bb[q], b); unpack8(cc[q], c);
                float ss = 0.f;
#pragma unroll
                for (int j = 0; j < 8; ++j) { const float cu0 = c[j]; y[j] = b[j] * (w2[j] * cu0 + w1[j] * cu1[j] + w0[j] * cu2[j]); ss += y[j] * y[j]; cu2[j] = cu1[j]; cu1[j] = cu0; }
                const float rstd = __builtin_amdgcn_rsqf(wave_sum(ss) * (1.f / CONVW) + EPS);
#pragma unroll
                for (int j = 0; j < 8; ++j) y[j] = y[j] * rstd * gg[j];
                if (P3_FP8) { v2u yq; yq.x = pk4_fp8(y[0], y[1], y[2], y[3]); yq.y = pk4_fp8(y[4], y[5], y[6], y[7]); *(v2u*)((unsigned char*)F.mix + (unsigned)((t0 + tt + q) * D + ATTNW + c0)) = yq; }
                else *(v4u*)((unsigned char*)F.mix + (unsigned)(((t0 + tt + q) * D + ATTNW + c0) * 2)) = pack8(y);
            }
        }
    }
}

constexpr int KS_STRIDE = 144, VT_STRIDE = 528, KS_OFF = 0, VT_OFF = 256 * KS_STRIDE, BT_OFF = VT_OFF + 64 * VT_STRIDE, BT_ROW = 160, ATTN_LDS = BT_OFF + 8 * BT_ROW * 4 + 64;
constexpr int OS_ROW = 136, OS_WAVE = 16 * OS_ROW;
static_assert(ATTN_LDS + 8 * OS_WAVE <= RING_BYTES, "attention staging tiles");
static_assert(ATTN_LDS <= RING_BYTES, "attention LDS");
typedef __bf16 bf16v2 __attribute__((ext_vector_type(2)));
__device__ __forceinline__ float dot2sq(unsigned w, float acc) { const bf16v2 v = __builtin_bit_cast(bf16v2, w); return __builtin_amdgcn_fdot2_f32_bf16(v, v, acc, false); }
__device__ __forceinline__ float max3f(float a, float b, float c) { float r; asm("v_max3_f32 %0, %1, %2, %3" : "=v"(r) : "v"(a), "v"(b), "v"(c)); return r; }
__device__ __forceinline__ float quad_max(float v) { float a, b; swap32(v, a, b); v = __builtin_amdgcn_fmed3f(a, b, INFINITY); swap16(v, a, b); return __builtin_amdgcn_fmed3f(a, b, INFINITY); }
__device__ __forceinline__ void p2_attn(Frame& F) {
    LAS unsigned char* KS = F.lds + KS_OFF; LAS unsigned char* VT = F.lds + VT_OFF; LAS float* BT = (LAS float*)(F.lds + BT_OFF);
    const int lane = F.lane, c = lane & 15, g = lane >> 4, w = F.wave, sub = lane & 7, grp = lane >> 3;
    for (int i = F.tid; i < 8 * BT_ROW; i += NWAVES * 64) { const int h = i / BT_ROW, rel = 143 - (i - h * BT_ROW); BT[i] = (rel >= 0 && rel < 128) ? F.rel_bias[T5B[rel & 127] * NQH + h] * LOG2E : 0.f; }
    if (F.tid < 8) BT[8 * BT_ROW + F.tid] = F.sinks[F.tid] * LOG2E;
    float kg8[8];
#pragma unroll
    for (int j = 0; j < 8; ++j) kg8[j] = F.k_norm[8 * sub + j] * F.q_norm[8 * sub + j];
    __syncthreads();
    LAS unsigned char* const OS = F.lds + ATTN_LDS + w * OS_WAVE;
    const LAS float* btl = BT + (15 - c + 4 * g);
    bool lo_ok[4];
#pragma unroll
    for (int j = 0; j < 4; ++j) lo_ok[j] = (4 * g + j) > c;
    const unsigned onesw = 0x3f803f80u; const bf16x8 ONES = __builtin_bit_cast(bf16x8, ((v4u){onesw, onesw, onesw, onesw}));
    v4u kr[4], vr[4];
#define ATTN_FETCH(unit_, kv_) do { const int _blk = (unit_) % (SEQ / 128), _t0 = (unit_) * 128; \
        _Pragma("unroll") for (int i = 0; i < 4; ++i) { \
            const int keyk = 32 * w + 8 * i + grp, keyv = 32 * w + 2 * grp + (i & 1) + 16 * (i >> 1); \
            kr[i] = (v4u){0u, 0u, 0u, 0u}; vr[i] = (v4u){0u, 0u, 0u, 0u}; \
            if (!(_blk == 0 && keyk < 128)) kr[i] = *(const v4u*)((const unsigned char*)F.proj + (unsigned)(((_t0 - 128 + keyk) * PW + P_K + 64 * (kv_) + 8 * sub) * 2)); \
            if (!(_blk == 0 && keyv < 128)) vr[i] = *(const v4u*)((const unsigned char*)F.proj + (unsigned)(((_t0 - 128 + keyv) * PW + P_V + 64 * (kv_) + 8 * sub) * 2)); } } while (0)
    if ((int)blockIdx.x < T / 128) ATTN_FETCH((int)blockIdx.x, 0);
    for (int unit = blockIdx.x; unit < T / 128; unit += F.G) {
        const int blk = unit % (SEQ / 128), t0 = unit * 128, tq = t0 + 16 * w + c;
        float ssq = 0.f;
        const unsigned qoff = (unsigned)((tq * PW + P_Q + 8 * g) * 2);
#define QLOAD(el_) (*(const v4u*)((const unsigned char*)F.proj + (qoff + (unsigned)((el_) * 2))))
        v4u qr[2][2];
#pragma unroll
        for (int e = 0; e < 2; ++e) { qr[e][0] = QLOAD(64 * e); qr[e][1] = QLOAD(64 * e + 32); }
#pragma unroll 1
        for (int kv = 0; kv < 2; ++kv) {
            __syncthreads();
            {
#pragma unroll
                for (int i = 0; i < 4; ++i) {
                    float k[8]; unpack8(kr[i], k); float ss = 0.f;
#pragma unroll
                    for (int j = 0; j < 8; ++j) ss += k[j] * k[j];
                    ss = oct_sum(ss);
                    const float r = __builtin_amdgcn_rsqf(ss * (1.f / HD) + EPS);
#pragma unroll
                    for (int j = 0; j < 8; ++j) k[j] = k[j] * r * kg8[j];
                    *(LAS v4u*)(KS + (32 * w + 8 * i + grp) * KS_STRIDE + sub * 16) = pack8(k);
                }
#pragma unroll
                for (int pp = 0; pp < 2; ++pp) {
                    const v4u a = vr[2 * pp], b = vr[2 * pp + 1]; const unsigned aw[4] = {a.x, a.y, a.z, a.w}, bw[4] = {b.x, b.y, b.z, b.w};
                    const int key0 = 32 * w + 2 * grp + 16 * pp;
#pragma unroll
                    for (int jj = 0; jj < 8; ++jj) {
                        const unsigned word = (jj & 1) ? ((aw[jj >> 1] >> 16) | (bw[jj >> 1] & 0xffff0000u)) : ((aw[jj >> 1] & 0xffffu) | (bw[jj >> 1] << 16));
                        *(LAS unsigned*)(VT + (8 * sub + jj) * VT_STRIDE + key0 * 2) = word;
                    }
                }
            }
            __syncthreads();
            { const int nu = kv == 0 ? unit : unit + F.G; if (nu < T / 128) ATTN_FETCH(nu, kv ^ 1); }
#pragma unroll 1
            for (int hp = 0; hp < 2; ++hp) {
                const int h0 = 4 * kv + 2 * hp;
                bf16x8 Q[2][2]; float rs[2];
#pragma unroll
                for (int e = 0; e < 2; ++e) {
                    Q[e][0] = __builtin_bit_cast(bf16x8, qr[e][0]); Q[e][1] = __builtin_bit_cast(bf16x8, qr[e][1]);
                    float ss = dot2sq(qr[e][0].x, 0.f); ss = dot2sq(qr[e][0].y, ss); ss = dot2sq(qr[e][0].z, ss); ss = dot2sq(qr[e][0].w, ss);
                    ss = dot2sq(qr[e][1].x, ss); ss = dot2sq(qr[e][1].y, ss); ss = dot2sq(qr[e][1].z, ss); ss = dot2sq(qr[e][1].w, ss);
                    ss = quad_sum(ss);
                    rs[e] = __builtin_amdgcn_rsqf(ss * (1.f / HD) + EPS) * (0.125f * LOG2E);
                }
                if (h0 < 6) {
#pragma unroll
                    for (int e = 0; e < 2; ++e) { qr[e][0] = QLOAD(64 * (h0 + 2 + e)); qr[e][1] = QLOAD(64 * (h0 + 2 + e) + 32); } }
                f32x4 st[2][9];
#pragma unroll
                for (int kb = 0; kb < 3; ++kb) {
                    bf16x8 kf[3][2];
#pragma unroll
                    for (int i = 0; i < 3; ++i) { const LAS unsigned char* kp = KS + (16 * (w + 3 * kb + i) + c) * KS_STRIDE + g * 16; kf[i][0] = *(const LAS bf16x8*)kp; kf[i][1] = *(const LAS bf16x8*)(kp + 64); }
                    __builtin_amdgcn_sched_barrier(0);
#pragma unroll
                    for (int i = 0; i < 3; ++i)
#pragma unroll
                        for (int e = 0; e < 2; ++e) { f32x4 z = (f32x4){0.f, 0.f, 0.f, 0.f};
                            z = __builtin_amdgcn_mfma_f32_16x16x32_bf16(kf[i][0], Q[e][0], z, 0, 0, 0);
                            st[e][3 * kb + i] = __builtin_amdgcn_mfma_f32_16x16x32_bf16(kf[i][1], Q[e][1], z, 0, 0, 0); }
                }
                float sk[2], m[2]; bf16x8 P[2][5];
#pragma unroll
                for (int e = 0; e < 2; ++e) {
                    sk[e] = BT[8 * BT_ROW + h0 + e];
                    const LAS float* bt = btl + (h0 + e) * BT_ROW;
#pragma unroll
                    for (int kt = 0; kt < 9; ++kt)
#pragma unroll
                        for (int j = 0; j < 4; ++j) {
                            float v = st[e][kt][j] * rs[e] + bt[16 * kt + j];
                            if (kt == 0) v = lo_ok[j] ? v : -INFINITY;
                            if (kt == 8) v = lo_ok[j] ? -INFINITY : v;
                            st[e][kt][j] = v;
                        }
                    if (blk == 0) {
#pragma unroll
                        for (int kt = 0; kt < 8; ++kt) { const bool dead = (w + kt) < 8;
#pragma unroll
                            for (int j = 0; j < 4; ++j) st[e][kt][j] = dead ? -INFINITY : st[e][kt][j]; }
                    }
                    float mm = sk[e];
#pragma unroll
                    for (int kt = 0; kt < 9; ++kt) { mm = max3f(mm, st[e][kt][0], st[e][kt][1]); mm = max3f(mm, st[e][kt][2], st[e][kt][3]); }
                    m[e] = quad_max(mm);
                }
#pragma unroll
                for (int e = 0; e < 2; ++e) {
#pragma unroll
                    for (int kt = 0; kt < 9; ++kt)
#pragma unroll
                        for (int j = 0; j < 4; ++j) st[e][kt][j] = __builtin_amdgcn_exp2f(st[e][kt][j] - m[e]);
#pragma unroll
                    for (int u = 0; u < 5; ++u) {
                        v4u pw; pw.x = pg8::cvt_pk_bf16(st[e][2 * u][0], st[e][2 * u][1]); pw.y = pg8::cvt_pk_bf16(st[e][2 * u][2], st[e][2 * u][3]);
                        if (u < 4) { pw.z = pg8::cvt_pk_bf16(st[e][2 * u + 1][0], st[e][2 * u + 1][1]); pw.w = pg8::cvt_pk_bf16(st[e][2 * u + 1][2], st[e][2 * u + 1][3]); } else { pw.z = 0u; pw.w = 0u; }
                        P[e][u] = __builtin_bit_cast(bf16x8, pw);
                    }
                }
                f32x4 ls[2];
#pragma unroll
                for (int e = 0; e < 2; ++e) { ls[e] = (f32x4){0.f, 0.f, 0.f, 0.f};
#pragma unroll
                    for (int u = 0; u < 5; ++u) ls[e] = __builtin_amdgcn_mfma_f32_16x16x32_bf16(ONES, P[e][u], ls[e], 0, 0, 0); }
                f32x4 o[2][4];
#pragma unroll
                for (int dt = 0; dt < 4; ++dt) {
                    o[0][dt] = (f32x4){0.f, 0.f, 0.f, 0.f}; o[1][dt] = (f32x4){0.f, 0.f, 0.f, 0.f};
#pragma unroll
                    for (int u = 0; u < 5; ++u) {
                        const LAS unsigned char* vp = VT + (16 * dt + c) * VT_STRIDE + (16 * (w + 2 * u) + 4 * g) * 2;
                        const v2u lo = *(const LAS v2u*)vp; const v2u hi = (u < 4) ? *(const LAS v2u*)(vp + 32) : lo;
                        const bf16x8 vv = __builtin_bit_cast(bf16x8, ((v4u){lo.x, lo.y, hi.x, hi.y}));
                        o[0][dt] = __builtin_amdgcn_mfma_f32_16x16x32_bf16(vv, P[0][u], o[0][dt], 0, 0, 0);
                        o[1][dt] = __builtin_amdgcn_mfma_f32_16x16x32_bf16(vv, P[1][u], o[1][dt], 0, 0, 0);
                    }
                }
#pragma unroll
                for (int e = 0; e < 2; ++e) {
                    const int h = h0 + e;
                    const float inv = __builtin_amdgcn_rcpf(ls[e][0] + __builtin_amdgcn_exp2f(sk[e] - m[e])) * (P3_FP8 ? MIXA_SCALE : 1.0f);
#pragma unroll
                    for (int dt = 0; dt < 4; ++dt) {
                        const f32x4 ov = o[e][dt] * inv;
                        ssq += (ov[0] * ov[0] + ov[1] * ov[1]) + (ov[2] * ov[2] + ov[3] * ov[3]);
                        if (P3_FP8) *(LAS unsigned*)(OS + c * OS_ROW + (16 * dt + 4 * g)) = pk4_fp8(ov[0], ov[1], ov[2], ov[3]);
                        else { v2u ow; ow.x = pg8::cvt_pk_bf16(ov[0], ov[1]); ow.y = pg8::cvt_pk_bf16(ov[2], ov[3]);
                            *(LAS v2u*)(OS + c * OS_ROW + (16 * dt + 4 * g) * 2) = ow; }
                    }
                    asm volatile("" ::: "memory");
                    if (P3_FP8) {
                        const LAS v2u* sp = (const LAS v2u*)(OS + c * OS_ROW + 16 * g);
                        const v2u a0 = sp[0], a1 = sp[1];
                        *(v4u*)((unsigned char*)F.mix + (unsigned)(tq * D + 64 * h + 16 * g)) = (v4u){a0.x, a0.y, a1.x, a1.y};
                    } else
                    {
                        const LAS v2u* sp = (const LAS v2u*)(OS + c * OS_ROW + 32 * g);
                        const v2u a0 = sp[0], a1 = sp[1], a2 = sp[2], a3 = sp[3];
                        v4u* const op = (v4u*)((unsigned char*)F.mix + (unsigned)((tq * D + 64 * h + 16 * g) * 2));
                        op[0] = (v4u){a0.x, a0.y, a1.x, a1.y}; op[1] = (v4u){a2.x, a2.y, a3.x, a3.y};
                    }
                    asm volatile("" ::: "memory");
                }
            }
        }
        ssq = quad_sum(ssq);
        const float rstd = __builtin_amdgcn_rsqf(ssq * (P3_FP8 ? 1.f / (ATTNW * MIXA_SCALE * MIXA_SCALE) : 1.f / ATTNW) + EPS) * (P3_FP8 ? 1.f / MIXA_SCALE : 1.f);
        if (g == 0) F.rsa[tq] = rstd;
    }
#undef ATTN_FETCH
#undef QLOAD
    __syncthreads();
}

constexpr int RT_SCR_OFF = 133120, RT_CNT_OFF = RT_SCR_OFF + 8 * 16 * 33 * 4;
static_assert(RT_CNT_OFF + 256 <= LDS_BYTES && RT_SCR_OFF >= MISC_OFF + 128, "router LDS");
__device__ __forceinline__ void p3b_router(Frame& F, const bool commit) {
    const int lane = F.lane, fr = lane & 15, fq = lane >> 4, w = F.wave;
    LAS unsigned char* WL = F.lds;
    LAS float* scr = (LAS float*)(F.lds + RT_SCR_OFF) + w * (16 * 33);
    LAS unsigned* lcnt = (LAS unsigned*)(F.lds + RT_CNT_OFF); LAS unsigned* lbase = lcnt + 32;
    for (int ci = F.tid; ci < 2 * NEXP * 128; ci += NWAVES * 64) { const int row = ci >> 7, ch = ci & 127;
        *(LAS v4u*)(WL + row * 2048 + ((ch ^ (row & 15)) << 4)) = *(const v4u*)(F.WR + (size_t)row * D + ch * 8); }
    for (int chunk = F.vcu; chunk < T / 256; chunk += F.G) {
    if (F.tid < 32) lcnt[F.tid] = 0u;
    __syncthreads();
    int re[2][4]; unsigned rrank[2][4]; float rrs[2];
#pragma unroll
    for (int it = 0; it < 2; ++it) {
        const int tok0 = chunk * 256 + w * 32 + it * 16;
        f32x4 a0 = (f32x4){0.f, 0.f, 0.f, 0.f}, a1 = a0; float ss = 0.f;
        const unsigned xoff = (unsigned)(((tok0 + fr) * D + 8 * fq) * 2);
#pragma unroll 1
        for (int s0 = 0; s0 < 32; s0 += 16) {
            v4u xa[16];
#pragma unroll
            for (int s = 0; s < 16; ++s) xa[s] = *(const v4u*)((const unsigned char*)F.x1b + (xoff + (unsigned)(64 * (s0 + s))));
#pragma unroll
            for (int s = 0; s < 16; ++s) {
                float f[8]; unpack8(xa[s], f);
#pragma unroll
                for (int j = 0; j < 8; ++j) ss += f[j] * f[j];
                const int ch = 4 * (s0 + s) + fq; const bf16x8 av = __builtin_bit_cast(bf16x8, xa[s]);
                const bf16x8 h0 = *(const LAS bf16x8*)(WL + fr * 2048 + ((ch ^ fr) << 4)), h1 = *(const LAS bf16x8*)(WL + (16 + fr) * 2048 + ((ch ^ fr) << 4));
                const bf16x8 l0 = *(const LAS bf16x8*)(WL + (32 + fr) * 2048 + ((ch ^ fr) << 4)), l1 = *(const LAS bf16x8*)(WL + (48 + fr) * 2048 + ((ch ^ fr) << 4));
                a0 = __builtin_amdgcn_mfma_f32_16x16x32_bf16(av, h0, a0, 0, 0, 0); a1 = __builtin_amdgcn_mfma_f32_16x16x32_bf16(av, h1, a1, 0, 0, 0);
                a0 = __builtin_amdgcn_mfma_f32_16x16x32_bf16(av, l0, a0, 0, 0, 0); a1 = __builtin_amdgcn_mfma_f32_16x16x32_bf16(av, l1, a1, 0, 0, 0);
            }
        }
        ss = quad_sum(ss);
        const float rstd = __builtin_amdgcn_rsqf(ss * (1.f / D) + EPS);
#pragma unroll
        for (int j = 0; j < 4; ++j) { scr[(4 * fq + j) * 33 + fr] = a0[j]; scr[(4 * fq + j) * 33 + 16 + fr] = a1[j]; }
        LDS_WAIT(); asm volatile("" ::: "memory");
        rrs[it] = rstd;
#pragma unroll
        for (int k = 0; k < 4; ++k) { re[it][k] = 0; rrank[it][k] = 0u; }
        if (lane < 16) {
            const int t = tok0 + lane;
            float lg[NEXP];
#pragma unroll
            for (int e = 0; e < NEXP; ++e) lg[e] = scr[lane * 33 + e] * rstd + F.b_router[e];
            float val[4]; unsigned used = 0u;
#pragma unroll
            for (int k = 0; k < 4; ++k) { int bi = 0; float bv = -INFINITY;
#pragma unroll
                for (int e = 0; e < NEXP; ++e) { const bool tk = !((used >> e) & 1u) && (lg[e] > bv); bv = tk ? lg[e] : bv; bi = tk ? e : bi; }
                re[it][k] = bi; val[k] = bv; used |= 1u << bi; }
            float pe[4], den = 0.f;
#pragma unroll
            for (int k = 0; k < 4; ++k) { pe[k] = __expf(val[k] - val[0]); den += pe[k]; }
            const float id = __builtin_amdgcn_rcpf(den);
            *(f32x4*)(F.gate + (size_t)t * 4) = (f32x4){pe[0] * id, pe[1] * id, pe[2] * id, pe[3] * id};
            F.rstd[t] = rstd;
            if (commit) {
#pragma unroll
            for (int k = 0; k < 4; ++k) rrank[it][k] = __hip_atomic_fetch_add(lcnt + re[it][k], 1u, __ATOMIC_RELAXED, __HIP_MEMORY_SCOPE_WORKGROUP); }
        }
        LDS_WAIT(); asm volatile("" ::: "memory");
    }
    __syncthreads();
    if (F.tid < 32 && commit) lbase[F.tid] = __hip_atomic_fetch_add(F.ctl + CW_CNT + F.tid, lcnt[F.tid], RLX_AGENT);
    __syncthreads();
    if (lane < 16 && commit) {
#pragma unroll
        for (int it = 0; it < 2; ++it) { const int t = chunk * 256 + w * 32 + it * 16 + lane;
#pragma unroll
            for (int k = 0; k < 4; ++k) { const size_t p = (size_t)re[it][k] * T + lbase[re[it][k]] + rrank[it][k]; F.dest[p] = (unsigned)(t * 4 + k); F.rsl[p] = rrs[it] * (SWI_CZ / W_SCALE); } }
    }
    __syncthreads();
    }
}

__device__ __forceinline__ void unpack4_fp8(unsigned w, float (&f)[4]) {
    const f32x2 a = __builtin_amdgcn_cvt_pk_f32_fp8((int)w, false), b = __builtin_amdgcn_cvt_pk_f32_fp8((int)w, true); f[0] = a[0]; f[1] = a[1]; f[2] = b[0]; f[3] = b[1];
}
__device__ __forceinline__ void p6_combine(Frame& F) {
    const int gw = F.vcu * NWAVES + F.wave, NGW = F.G * NWAVES, lane = F.lane;
    for (int t = gw * 2; t < T; t += NGW * 2) {
        v2u xb[2][4]; unsigned yv[2][4][4]; f32x4 gt[2];
#pragma unroll
        for (int q = 0; q < 2; ++q) {
            const unsigned xo = (unsigned)(((t + q) * D + 4 * lane) * 2);
#pragma unroll
            for (int j = 0; j < 4; ++j) xb[q][j] = __builtin_nontemporal_load((const v2u*)((const unsigned char*)F.x1b + (xo + 512u * j)));
            gt[q] = *(const f32x4*)(F.gate + (size_t)(t + q) * 4) * (1.0f / YS_SCALE);
#pragma unroll
            for (int k = 0; k < 4; ++k) { const unsigned yo = (unsigned)(((t + q) * 4 + k) * D + 4 * lane);
#pragma unroll
                for (int j = 0; j < 4; ++j) yv[q][k][j] = __builtin_nontemporal_load((const unsigned*)(F.ys + (yo + 256u * j))); }
        }
#pragma unroll
        for (int q = 0; q < 2; ++q)
#pragma unroll
            for (int j = 0; j < 4; ++j) {
                float o[4] = {bflo(xb[q][j].x), bfhi(xb[q][j].x), bflo(xb[q][j].y), bfhi(xb[q][j].y)};
#pragma unroll
                for (int k = 0; k < 4; ++k) { float y[4]; unpack4_fp8(yv[q][k][j], y);
#pragma unroll
                    for (int i = 0; i < 4; ++i) o[i] += gt[q][k] * y[i]; }
                __builtin_nontemporal_store((f32x4){o[0], o[1], o[2], o[3]}, (f32x4*)((unsigned char*)F.out + (unsigned)(((t + q) * D + 4 * lane + 256 * j) * 4)));
            }
    }
}
#ifndef NS_RELAX
#define NS_RELAX(n) 0
#endif
#ifndef P5_KREP
#define P5_KREP 1
#endif
#ifndef P5_EREP
#define P5_EREP 1
#endif
#ifndef P2_CONV_REP
#define P2_CONV_REP 1
#endif
#ifndef P2_ATTN_REP
#define P2_ATTN_REP 1
#endif
#ifndef STAG1
#define STAG1 0
#define STAG3 0
#define STAG5 0
#define STAG6 0
#endif
constexpr int N_PHASES = 8;
struct Args { const float* in[20]; float* out; unsigned char* ws; int ph_lo, ph_hi, li, pad; };
__global__ void __launch_bounds__(NWAVES * 64, 2) mega_fwd(Args) {
    extern __shared__ __attribute__((aligned(16))) unsigned char lds[];
    Frame F;
    F.lds = (LAS unsigned char*)lds;
    F.MISC = (volatile LAS unsigned*)(F.lds + MISC_OFF);
    F.tid = threadIdx.x; F.lane = F.tid & 63; F.wave = __builtin_amdgcn_readfirstlane(F.tid >> 6);
    F.G = gridDim.x; { const int bx = blockIdx.x; F.vcu = (F.G % 8 == 0) ? (bx % 8) * (F.G / 8) + bx / 8 : bx; }
    typedef const __attribute__((address_space(4))) unsigned char* kptr_t;
    const kptr_t ka = (kptr_t)__builtin_amdgcn_kernarg_segment_ptr();
#define KIN(k) (*(const float* const __attribute__((address_space(4)))*)(ka + 8 * (k)))
#define KWS() (*(unsigned char* const __attribute__((address_space(4)))*)(ka + 168))
#define KOUT() (*(float* const __attribute__((address_space(4)))*)(ka + 160))
#define KINT(off) (*(const int __attribute__((address_space(4)))*)(ka + (off)))
#define FRAME_PTRS() do { unsigned char* ws = KWS(); \
    F.x = KIN(0); F.norm_mix = KIN(1); F.w_in = KIN(2); F.b_in = KIN(3); F.conv_w = KIN(4); F.q_norm = KIN(5); F.k_norm = KIN(6); F.sinks = KIN(7); \
    F.rel_bias = KIN(8); F.on_conv = KIN(9); F.on_attn = KIN(10); F.w_out = KIN(11); F.b_out = KIN(12); F.norm_ffn = KIN(13); F.w_router = KIN(14); F.b_router = KIN(15); \
    F.w1 = KIN(16); F.b1 = KIN(17); F.w2 = KIN(18); F.b2 = KIN(19); F.out = KOUT(); \
    F.WinT = (bf16*)(ws + WS_WINT); F.WoutT = (bf16*)(ws + WS_WOUTT); F.W1Q = ws + WS_W1T; F.W2Q = ws + WS_W2T; F.WR = (bf16*)(ws + WS_WR); F.x1q = ws + WS_X1Q; F.act = ws + WS_ACT; \
    F.B1S = (float*)(ws + WS_B1); F.rstd = (float*)(ws + WS_RSTD); F.gate = (float*)(ws + WS_GATE); F.rsl = (float*)(ws + WS_RSL); F.rin = (float*)(ws + WS_RIN); F.ginv = (float*)(ws + WS_GINV); F.rsa = (float*)(ws + WS_RSA); F.dest = (unsigned*)(ws + WS_DEST); \
    F.xn = (bf16*)(ws + WS_XN); F.proj = (bf16*)(ws + WS_PROJ); F.mix = (bf16*)(ws + WS_MIX); F.x1b = (bf16*)(ws + WS_X1B); F.ys = ws + WS_YS; } while (0)
    static_assert(sizeof(Args) == 192 && offsetof(Args, out) == 160 && offsetof(Args, ws) == 168 && offsetof(Args, ph_lo) == 176 && offsetof(Args, li) == 184, "kernarg layout");
    F.ctl = (gu32*)(KWS() + WS_CTL);
    for (int u = F.tid; u < (MISC_OFF + 128 - MOE_OFF) / 4; u += NWAVES * 64) ((LAS unsigned*)(F.lds + MOE_OFF))[u] = 0u;
    __syncthreads();
    XcdBarrier bar = xcd_barrier_post((unsigned*)(F.ctl + CW_BAR) + KINT(184) * XCD_BAR_WORDS, F.MISC + 8);
    const int lo = KINT(176), hi = KINT(180);
#ifndef COMPILE_MASK
#define COMPILE_MASK 0xFF
#endif
#define IN(k) (((COMPILE_MASK >> (k)) & 1) && lo <= (k) && (k) < hi)
#define SEAM(k) do { if (IN(k) && IN((k) + 1)) xcd_barrier(bar); } while (0)
#ifndef REPEAT_MASK
#define REPEAT_MASK 0
#endif
#define REPS(k) (((REPEAT_MASK >> (k)) & 1) ? 2 : 1)

    if (IN(0)) { FRAME_PTRS(); for (int rep = 0; rep < REPS(0); ++rep) p0_prologue(F); } SEAM(0);
    if (IN(1)) {
        FRAME_PTRS();
        pg8::DenseOrder S; S.init(F.xn, F.WinT, T, INW, D, F.G, (int)blockIdx.x); S.bias = F.b_in; S.tab = F.lds + TAB_OFF; S.cu_mode = 1;
        EpiIn E{F.proj, F.lds + TAB_OFF};
        for (int rep = 0; rep < REPS(1); ++rep) pg8::gemm_phase<EpiIn, pg8::DenseOrder, false, true, false, true, P1_KREP, 1, NS_RELAX(16)>(F.lds + RING_OFF, D, S, E, STAG1);
    } SEAM(1);
    if (IN(2)) { FRAME_PTRS(); for (int rep = 0; rep < REPS(2); ++rep) {
            _Pragma("unroll 1") for (int step = 0; step < 2; ++step) { if ((((int)blockIdx.x >> 3) & 1) == step) p2_conv(F); else p2_attn(F); } } } SEAM(2);
    if (IN(3)) {
        FRAME_PTRS();
        pg8::DenseOrder S; S.init(F.mix, F.WoutT, T, D, P3_FP8 ? D / 2 : D, F.G, (int)blockIdx.x); S.bias = F.b_out; S.tab = F.lds + TAB_OFF; S.rowvec = F.rin; S.colvec = F.ginv; S.rowvec2 = F.rsa;
        EpiOut E{F.x1b, F.lds + TAB_OFF, F.xn, F.x1q};
        for (int rep = 0; rep < REPS(3); ++rep) pg8::gemm_phase<EpiOut, pg8::DenseOrder, false, true, P3_FP8 != 0, true, 1, 1, NS_RELAX(24), P3_FP8 ? ATTNW / 128 : ATTNW / 64>(F.lds + RING_OFF, P3_FP8 ? D / 2 : D, S, E, STAG3);
    } SEAM(3);
    if (IN(4)) { FRAME_PTRS(); for (int rep = 0; rep < REPS(4); ++rep) p3b_router(F, rep == REPS(4) - 1); } SEAM(4);
    if (IN(5)) {
        FRAME_PTRS();
        const int NT = moe_tables(F);
        const LAS int* tile0 = (const LAS int*)(F.lds + MOE_OFF); const LAS int* ecnt = tile0 + 40;
        MoeOrder<true> S{(const char*)F.x1q, (const char*)F.W1Q, (size_t)2 * DFF * D, (size_t)256 * D, 2 * DFF / 256, F.G, (int)blockIdx.x, NT, tile0, ecnt, F.dest, F.rsl, F.lds + TAB_OFF, F.B1S, 1};
        EpiW1 E{F.act, F.lds + TAB_OFF, ecnt};
        for (int rep = 0; rep < REPS(5); ++rep) pg8::gemm_phase<EpiW1, MoeOrder<true>, true, true, true, true, P5_KREP, P5_EREP, NS_RELAX(4)>(F.lds + RING_OFF, D / 2, S, E, STAG5);
    } SEAM(5);
    if (IN(6)) {
        FRAME_PTRS();
#if FAST_MASK == 0xFF
        const int NT = __builtin_amdgcn_readfirstlane(((const LAS int*)(F.lds + MOE_OFF))[NEXP]);
#else
        const int NT = moe_tables(F);
#endif
        const LAS int* tile0 = (const LAS int*)(F.lds + MOE_OFF); const LAS int* ecnt = tile0 + 40;
        MoeOrder<false> S{(const char*)F.act, (const char*)F.W2Q, (size_t)D * DFF, (size_t)256 * DFF, D / 256, F.G, (int)blockIdx.x, NT, tile0, ecnt, F.dest, F.rsl, F.lds + TAB_OFF, F.b2, 2};
#ifndef P6_KREP
#define P6_KREP 1
#endif
#ifndef P6_EREP
#define P6_EREP 1
#endif
        EpiW2 E{F.ys, F.lds + TAB_OFF, ecnt};
        for (int rep = 0; rep < REPS(6); ++rep) pg8::gemm_phase<EpiW2, MoeOrder<false>, true, true, true, true, 1, 1, NS_RELAX(8)>(F.lds + RING_OFF, DFF / 2, S, E, STAG6);
    } SEAM(6);
    if (IN(7)) { FRAME_PTRS(); for (int rep = 0; rep < REPS(7); ++rep) p6_combine(F); }
#undef IN
#undef SEAM
}

#ifndef FAST_MASK
#define FAST_MASK 0xFF
#endif
extern "C" void kernel_launch(void* const* d_in, const int* in_sizes, int n_in, void* d_out, int out_size, void* d_ws, size_t ws_size, hipStream_t stream) {
    static int grid = 0;
    if (grid == 0) {
        if (n_in != 20 || in_sizes[0] != T * D || out_size != T * D || ws_size < WS_END) { fprintf(stderr, "kernel_launch: unexpected shapes (n_in %d, in0 %d, out %d, ws %zu); nothing launched\n", n_in, n_in > 0 ? in_sizes[0] : -1, out_size, ws_size); grid = -1; return; }
        int dev = 0, cus = 0, per_cu = 0;
        if (hipGetDevice(&dev) != hipSuccess || hipDeviceGetAttribute(&cus, hipDeviceAttributeMultiprocessorCount, dev) != hipSuccess) { grid = -1; return; }
        if (hipFuncSetAttribute((const void*)mega_fwd, hipFuncAttributeMaxDynamicSharedMemorySize, LDS_BYTES) != hipSuccess) { fprintf(stderr, "kernel_launch: hipFuncSetAttribute failed\n"); grid = -1; return; }
        if (hipOccupancyMaxActiveBlocksPerMultiprocessor(&per_cu, (const void*)mega_fwd, NWAVES * 64, LDS_BYTES) != hipSuccess || per_cu < 1) fprintf(stderr, "kernel_launch: note: occupancy query reports %d\n", per_cu);
        (void)hipGetLastError();
        grid = cus;
        if (grid != 256) fprintf(stderr, "kernel_launch: %d CUs (built for 256)\n", grid);
    }
    if (grid < 0) return;
    const float* const* in = (const float* const*)d_in;
    unsigned char* ws = (unsigned char*)d_ws; float* out = (float*)d_out;
    static_assert((CW_BAR + XCD_BAR_WORDS) * 4 <= 32 * 1024 && (CW_CNT + NEXP) <= CW_BAR, "control words of the single launch");
    (void)hipMemsetAsync(ws + WS_CTL, 0, FAST_MASK == 0xFF ? (size_t)32 * 1024 : CTL_ZERO_BYTES, stream);
    Args a{};
    for (int i = 0; i < 20; ++i) a.in[i] = in[i];
    a.out = out; a.ws = ws;
    unsigned* cnt = (unsigned*)(ws + WS_CTL) + CW_CNT;
    bf16* xn = (bf16*)(ws + WS_XN); bf16* proj = (bf16*)(ws + WS_PROJ); bf16* mix = (bf16*)(ws + WS_MIX); bf16* x1b = (bf16*)(ws + WS_X1B);
    float* rstd = (float*)(ws + WS_RSTD); float* gate = (float*)(ws + WS_GATE); float* rsl = (float*)(ws + WS_RSL); unsigned* dest = (unsigned*)(ws + WS_DEST);
    unsigned char* ys = ws + WS_YS;
    static_assert(((FAST_MASK >> 1) & 3) == 3 || ((FAST_MASK >> 1) & 3) == 0, "in-proj and conv/attention share the fused proj layout: both fast or both naive");
    static_assert(((FAST_MASK >> 5) & 7) == 7, "the MoE GEMM phases have no naive twin in the fp8 build");
    int li = 0;
    for (int p = 0; p < N_PHASES;) {
        if ((FAST_MASK >> p) & 1) {
            int q = p; while (q < N_PHASES && ((FAST_MASK >> q) & 1)) ++q;
            a.ph_lo = p; a.ph_hi = q; a.li = li++;
            hipLaunchKernelGGL(mega_fwd, dim3(grid), dim3(NWAVES * 64), LDS_BYTES, stream, a);
            p = q; continue;
        }
        switch (p) {
        case 0: a.ph_lo = 0; a.ph_hi = 1; a.li = li++; hipLaunchKernelGGL(mega_fwd, dim3(grid), dim3(NWAVES * 64), LDS_BYTES, stream, a);
                hipLaunchKernelGGL(nv::k_rms_in, dim3(T / 4), dim3(256), 0, stream, in[0], in[1], xn); break;
        case 1: { nv::OpIn op{xn, in[2], in[3], proj, 0, 0}; hipLaunchKernelGGL((nv::k_gemm<nv::OpIn>), dim3(INW / 128, T / 128), dim3(256), 0, stream, op, D); } break;
        case 2: hipLaunchKernelGGL(nv::k_conv, dim3(T), dim3(512), 0, stream, proj, in[4], in[9], mix);
                hipLaunchKernelGGL(nv::k_attn, dim3(T), dim3(512), 0, stream, proj, in[5], in[6], in[7], in[8], in[10], mix); break;
        case 3: { nv::OpOut op{mix, in[11], in[12], in[0], x1b, 0, 0}; hipLaunchKernelGGL((nv::k_gemm<nv::OpOut>), dim3(D / 128, T / 128), dim3(256), 0, stream, op, D); } break;
        case 4: hipLaunchKernelGGL(nv::k_router, dim3(T / 4), dim3(256), 0, stream, x1b, in[13], in[14], in[15], rstd, gate, dest, rsl, cnt); break;
        case 7:   break;
        }
        ++p;
    }
}
```
